# Optimizing an MI355X kernel written in HIP

```python
import math
import jax, jax.numpy as jnp
from jax import lax
import numpy as np

D_MODEL = 2048
BATCH = 8
SEQ = 2048
DEPTH = 1

W_A = D_MODEL // 2
DH_A = 128
H_A = W_A // DH_A
D_C = D_MODEL // 8
H_IDX = 16
D_IDX = 64
TOPK_MAX = 256
Q_BLOCK = 128
W_M = D_MODEL - W_A
H_M = 4
DV_M = W_M // H_M
DK_M = DV_M // 2
CONV_W = 4
CHUNK = 64
N_BUCKETS = 32
MAX_DIST = 128
ALPHA = (2 * DEPTH) ** 0.25
BETA = (8 * DEPTH) ** -0.25
LN_EPS = 1e-5

SPLITS = (
    W_A,
    D_C,
    W_A,
    H_IDX * D_IDX,
    D_IDX,
    H_IDX,
    H_M * DK_M,
    H_M * DK_M,
    W_M,
    H_M,
    H_M,
    W_M,
    W_M,
)
N_COLS = sum(SPLITS)

kernel_name = 'hymba_dsa_mlstm_deepnorm'


def layer_norm(x, g, b):
    xf = x.astype(jnp.float32)
    mu = jnp.mean(xf, axis=-1, keepdims=True)
    var = jnp.mean(jnp.square(xf - mu), axis=-1, keepdims=True)
    return ((xf - mu) * lax.rsqrt(var + LN_EPS) * g + b).astype(x.dtype)


def rms_norm(x, g):
    xf = x.astype(jnp.float32)
    return (xf * lax.rsqrt(jnp.mean(xf * xf, axis=-1, keepdims=True) + LN_EPS) * g).astype(x.dtype)


def causal_dwconv(x, w, b):
    T = x.shape[1]
    xp = jnp.pad(x, ((0, 0), (CONV_W - 1, 0), (0, 0)))
    return sum(w[j] * xp[:, j:j + T] for j in range(CONV_W)) + b


def t5_bucket(rel):
    max_exact = N_BUCKETS // 2
    n = jnp.maximum(rel, 0)
    nf = jnp.maximum(n, 1).astype(jnp.float32)
    large = max_exact + (jnp.log(nf / max_exact) / math.log(MAX_DIST / max_exact)
                         * (N_BUCKETS - max_exact)).astype(jnp.int32)
    large = jnp.minimum(large, N_BUCKETS - 1)
    return jnp.where(n < max_exact, n, large)


def dsa_attention(q_lat, ckv, q_idx, k_idx, w_idx, rel_bias):
    B, T = ckv.shape[:2]
    n_sel = min(TOPK_MAX, T // 4)
    nb = T // Q_BLOCK
    key_pos = jnp.arange(T)

    def block(args):
        qb, qib, wb, start = args
        qpos = start + jnp.arange(Q_BLOCK)
        sc = jnp.einsum('bqhd,bsd->bqhs', qib, k_idx)
        score = jnp.einsum('bqh,bqhs->bqs', wb, jax.nn.relu(sc)).astype(jnp.float32)
        causal = key_pos[None, :] <= qpos[:, None]
        score = jnp.where(causal[None], score, -jnp.inf)
        _, sel = lax.top_k(score, n_sel)
        c_sel = jax.vmap(lambda c, i: c[i])(ckv, sel)
        logits = jnp.einsum('bqhc,bqkc->bhqk', qb, c_sel).astype(jnp.float32) * (DH_A ** -0.5)
        rel = qpos[None, :, None] - sel
        bias = rel_bias[t5_bucket(rel)]
        logits = logits + jnp.transpose(bias, (0, 3, 1, 2)).astype(jnp.float32)
        logits = jnp.where((rel >= 0)[:, None], logits, -jnp.inf)
        p = jax.nn.softmax(logits, axis=-1).astype(ckv.dtype)
        return jnp.einsum('bhqk,bqkc->bqhc', p, c_sel)

    def to_blocks(a):
        return jnp.moveaxis(a.reshape((B, nb, Q_BLOCK) + a.shape[2:]), 1, 0)

    out = lax.map(block, (to_blocks(q_lat), to_blocks(q_idx), to_blocks(w_idx),
                          jnp.arange(nb) * Q_BLOCK))
    return jnp.moveaxis(out, 0, 1).reshape(B, T, H_A, D_C)


def mlstm_chunkwise(q, k, v, i_pre, f_pre):
    B, T, H, DK = q.shape
    DV = v.shape[-1]
    nc = T // CHUNK
    f32 = jnp.float32

    def chunks(a):
        a = a.reshape((B, nc, CHUNK, H) + a.shape[3:])
        return jnp.moveaxis(jnp.moveaxis(a, 1, 0), 3, 2)

    qc = chunks(q.astype(f32))
    kc = chunks(k.astype(f32) * (DK ** -0.5))
    vc = chunks(v.astype(f32))
    ic = chunks(i_pre.astype(f32))
    lfc = chunks(jax.nn.log_sigmoid(f_pre.astype(f32)))
    tri = jnp.tril(jnp.ones((CHUNK, CHUNK), dtype=bool))

    def step(carry, xs):
        C, n, m = carry
        qq, kk, vv, ii, lf = xs
        b = jnp.cumsum(lf, axis=-1)
        logD = jnp.where(tri, b[..., :, None] - b[..., None, :] + ii[..., None, :], -jnp.inf)
        g = b + m[..., None]
        m_t = jnp.maximum(jnp.max(logD, axis=-1), g)
        S = jnp.einsum('bhld,bhsd->bhls', qq, kk) * jnp.exp(logD - m_t[..., None])
        inter = jnp.exp(g - m_t)
        num = jnp.einsum('bhls,bhsv->bhlv', S, vv) + inter[..., None] * jnp.einsum('bhld,bhvd->bhlv', qq, C)
        den = jnp.sum(S, axis=-1) + inter * jnp.einsum('bhld,bhd->bhl', qq, n)
        h = num / jnp.maximum(jnp.abs(den), jnp.exp(-m_t))[..., None]
        bL = b[..., -1]
        a = bL[..., None] - b + ii
        m_new = jnp.maximum(bL + m, jnp.max(a, axis=-1))
        decay = jnp.exp(bL + m - m_new)
        wgt = jnp.exp(a - m_new[..., None])
        C_new = decay[..., None, None] * C + jnp.einsum('bhl,bhlv,bhld->bhvd', wgt, vv, kk)
        n_new = decay[..., None] * n + jnp.einsum('bhl,bhld->bhd', wgt, kk)
        return (C_new, n_new, m_new), h

    init = (jnp.zeros((B, H, DV, DK), f32), jnp.zeros((B, H, DK), f32), jnp.zeros((B, H), f32))
    _, hs = lax.scan(step, init, (qc, kc, vc, ic, lfc))
    return jnp.transpose(hs, (1, 0, 3, 2, 4)).reshape(B, T, H, DV).astype(q.dtype)


def setup_inputs(seed: int = 0) -> dict:
    key = jax.random.key(seed)
    ks = jax.random.split(key, 20)
    f32 = jnp.float32
    nrm = lambda k, s, sc: jax.random.normal(k, s, f32) * sc
    return {
        'x': nrm(ks[0], (BATCH, SEQ, D_MODEL), 1.0),
        'w_in': nrm(ks[1], (DEPTH, D_MODEL, N_COLS), D_MODEL ** -0.5),
        'b_igate': nrm(ks[2], (DEPTH, H_M), 0.1),
        'b_fgate': jnp.linspace(3.0, 6.0, H_M, dtype=f32)[None] + nrm(ks[3], (DEPTH, H_M), 0.1),
        'kv_norm_g': 1.0 + nrm(ks[4], (DEPTH, D_C), 0.02),
        'w_uk': nrm(ks[5], (DEPTH, H_A, DH_A, D_C), D_C ** -0.5),
        'w_uv': nrm(ks[6], (DEPTH, H_A, D_C, DH_A), D_C ** -0.5),
        'idx_k_ln_g': 1.0 + nrm(ks[7], (DEPTH, D_IDX), 0.02),
        'idx_k_ln_b': nrm(ks[8], (DEPTH, D_IDX), 0.02),
        'rel_bias': nrm(ks[9], (N_BUCKETS, H_A), 0.5),
        'conv_w': nrm(ks[10], (DEPTH, CONV_W, 2 * H_M * DK_M), CONV_W ** -0.5),
        'conv_b': nrm(ks[11], (DEPTH, 2 * H_M * DK_M), 0.01),
        'mh_norm_g': 1.0 + nrm(ks[12], (DEPTH, W_M), 0.02),
        'w_out': nrm(ks[13], (DEPTH, W_A + W_M, D_MODEL), BETA * (W_A + W_M) ** -0.5),
        'ln_g': 1.0 + nrm(ks[14], (DEPTH, D_MODEL), 0.02),
        'ln_b': nrm(ks[15], (DEPTH, D_MODEL), 0.02),
    }


def reference(x, w_in, b_igate, b_fgate, kv_norm_g, w_uk, w_uv, idx_k_ln_g, idx_k_ln_b,
              rel_bias, conv_w, conv_b, mh_norm_g, w_out, ln_g, ln_b):
    B, T, _ = x.shape
    offs = [int(o) for o in np.cumsum(SPLITS)[:-1]]
    for l in range(DEPTH):
        proj = x @ w_in[l]
        (q_a, c_kv, z_a, q_i, k_i, w_i, q_m, k_m, v_m,
         i_m, f_m, o_m, z_m) = jnp.split(proj, offs, axis=-1)

        c_kv = rms_norm(c_kv, kv_norm_g[l])
        q_lat = jnp.einsum('bthd,hdc->bthc', q_a.reshape(B, T, H_A, DH_A), w_uk[l])
        q_i = q_i.reshape(B, T, H_IDX, D_IDX) * (D_IDX ** -0.5)
        k_i = layer_norm(k_i, idx_k_ln_g[l], idx_k_ln_b[l])
        w_i = w_i * (H_IDX ** -0.5)
        o_lat = dsa_attention(q_lat, c_kv, q_i, k_i, w_i, rel_bias)
        y_a = jnp.einsum('bthc,hcd->bthd', o_lat, w_uv[l]).reshape(B, T, W_A) * jax.nn.silu(z_a)

        qk = jax.nn.silu(causal_dwconv(jnp.concatenate([q_m, k_m], axis=-1), conv_w[l], conv_b[l]))
        q_m, k_m = jnp.split(qk, 2, axis=-1)
        h_m = mlstm_chunkwise(q_m.reshape(B, T, H_M, DK_M), k_m.reshape(B, T, H_M, DK_M),
                              v_m.reshape(B, T, H_M, DV_M), i_m + b_igate[l], f_m + b_fgate[l])
        hf = h_m.astype(jnp.float32)
        mu = jnp.mean(hf, axis=-1, keepdims=True)
        var = jnp.mean(jnp.square(hf - mu), axis=-1, keepdims=True)
        h_m = ((hf - mu) * lax.rsqrt(var + LN_EPS)).reshape(B, T, W_M) * mh_norm_g[l]
        y_m = h_m.astype(x.dtype) * jax.nn.sigmoid(o_m) * jax.nn.silu(z_m)

        y = jnp.concatenate([y_a, y_m], axis=-1) @ w_out[l]
        x = layer_norm(ALPHA * x + y, ln_g[l], ln_b[l])
    return x
```

```cpp
#include <hip/hip_runtime.h>
#include <cstdio>
#include <cstdint>

#define LAS __attribute__((address_space(3)))
#define GAS __attribute__((address_space(1)))
typedef unsigned short bf16_t;
typedef short bf16x8 __attribute__((ext_vector_type(8)));
typedef float f32x4 __attribute__((ext_vector_type(4)));
typedef float f32x2 __attribute__((ext_vector_type(2)));
typedef unsigned u32x4 __attribute__((ext_vector_type(4)));
typedef unsigned u32x2 __attribute__((ext_vector_type(2)));

constexpr int BATCH = 8, SEQ = 2048, DM = 2048, M = BATCH * SEQ;
constexpr int NCOLS = 7512, NP = 7680;
constexpr int HA = 8, DHA = 128, DC = 256, HIDX = 16, DIDX = 64, NSEL = 256;
constexpr int HM = 4, DVM = 256, DKM = 128, CHUNK = 64, NCHUNK = SEQ / CHUNK;
constexpr float LN_EPS = 1e-5f;
constexpr float ALPHA = 1.189207115002721f;
constexpr float LOG2E = 1.4426950408889634f;
constexpr float QSCALE = 0.08838834764831845f * LOG2E;
constexpr int O_QA = 0, O_CKV = 1024, O_ZA = 1280, O_QI = 2304, O_KI = 3328, O_WI = 3392, O_QM = 3408, O_KM = 3920, O_VM = 4432, O_IM = 5456, O_FM = 5460, O_OM = 5464, O_ZM = 6488;
__host__ __device__ __forceinline__ int win_src(int np) {
    const int t = np >> 8, lc = np & 255;
    if (t < 4) return O_QA + np;
    if (t == 4) return O_CKV + lc;
    if (t < 9) return O_ZA + (np - 5 * 256);
    if (t < 13) return O_QI + (np - 9 * 256);
    if (t == 13) {
        if (lc < 32) return O_KI + lc;
        if (lc >= 128 && lc < 160) return O_KI + 32 + (lc - 128);
        if (lc >= 32 && lc < 48) return O_WI + (lc - 32);
        if (lc >= 48 && lc < 52) return O_IM + (lc - 48);
        if (lc >= 52 && lc < 56) return O_FM + (lc - 52);
        return -1;
    }
    if (t < 16) return O_QM + (np - 14 * 256);
    if (t < 18) return O_KM + (np - 16 * 256);
    if (t < 22) return O_VM + (np - 18 * 256);
    { const int j = t - 22; return lc < 128 ? O_OM + 128 * j + lc : O_ZM + 128 * j + (lc - 128); }
}

constexpr size_t MiB = 1u << 20;
constexpr size_t WS_CTL = 0, CTL_ZERO_BYTES = 1 * MiB;
constexpr size_t WS_XB = 1 * MiB;
constexpr size_t WS_Y = WS_XB;
constexpr size_t WS_WINT = 65 * MiB;
constexpr size_t WS_WOUTT = 95 * MiB;
constexpr size_t WS_WKVT = 103 * MiB;
constexpr size_t WS_Q = 104 * MiB;
constexpr size_t WS_C = 136 * MiB;
constexpr size_t WS_SZA = 144 * MiB;
constexpr size_t WS_QI = 176 * MiB;
constexpr size_t WS_KI = 208 * MiB;
constexpr size_t WS_WI = 210 * MiB;
constexpr size_t WS_IFG = 211 * MiB;
constexpr size_t WS_QKM = 212 * MiB;
constexpr size_t WS_VM = 244 * MiB;
constexpr size_t WS_GM = 276 * MiB;
constexpr size_t WS_MASK = 308 * MiB;
constexpr size_t WS_PAR = 312 * MiB;
constexpr int P_KVG = 0, P_LNG = 256, P_LNB = 320, P_RB = 384, P_CW = 640, P_CB = 4736, P_MHG = 5760, P_BI = 6784, P_BF = 6788, P_LG = 6800, P_LB = 8848, P_TOTAL = 10896;
constexpr size_t WS_NST = 313 * MiB;
constexpr size_t WS_DBG = 316 * MiB;
constexpr size_t WS_END = 324 * MiB;
constexpr size_t OUT_K = 64 * MiB, OUT_V = 96 * MiB;

namespace pg8 {
constexpr int BM = 256, BK = 64, HALF = 128, HTB = HALF * BK * 2, STAGE_BYTES = 8 * HTB, NXCD = 8, WGM = 8;
__host__ __device__ __forceinline__ int lds_byte(int r, int c) { const int st = (r >> 4) * 2 + (c >> 5), rr = r & 15, cc = c & 31, ob = rr * 64 + cc * 2; return st * 1024 + (ob ^ (((ob >> 9) & 1) << 5)); }
__host__ __device__ __forceinline__ void stage_rc(int b, int& R, int& C) { const int st = b / 1024, sb = b % 1024, swz = sb ^ (((sb >> 9) & 1) << 5); R = (st >> 1) * 16 + swz / 64; C = (st & 1) * 32 + (swz % 64) / 2; }
__host__ __device__ __forceinline__ int perm32(int rho) { const int n = rho >> 4, i = rho & 15; return 8 * (i >> 2) + 4 * n + (i & 3); }
struct Unit { int pm, pn; };
struct Gemm { const bf16_t* A; const bf16_t* Bt; int M, N, K; };
struct StaticOrder {
    int nM, nN, nwg, G, c;
    __host__ __device__ void init(int M_, int N_, int G_, int c_) { nM = M_ / BM; nN = N_ / BM; nwg = nM * nN; G = G_; c = c_; }
    __host__ __device__ bool next(int i, Unit& u) const {
        const long L = (long)i * G + c; if (L >= nwg) return false;
        int wgid = (int)L; { const int q = nwg / NXCD, r = nwg % NXCD, xcd = wgid % NXCD, off = wgid / NXCD; wgid = (xcd < r ? xcd * (q + 1) : r * (q + 1) + (xcd - r) * q) + off; }
        const int nig = WGM * nN, gid = wgid / nig, fm = gid * WGM, gsz = (nM - fm) < WGM ? (nM - fm) : WGM;
        u.pm = fm + ((wgid % nig) % gsz); u.pn = (wgid % nig) / gsz; return true;
    }
};
__device__ __forceinline__ unsigned cvt_pk_bf16(float lo, float hi) { unsigned r; asm volatile("v_cvt_pk_bf16_f32 %0, %1, %2" : "=v"(r) : "v"(lo), "v"(hi)); return r; }

template <class Epi, class Sched, bool ALIGN_EPI = true, bool SP2 = true>
__device__ __forceinline__ void gemm_phase(LAS unsigned char* lds, const Gemm g, const Sched& S, const Epi& E) {
    const int tid = threadIdx.x, wid = __builtin_amdgcn_readfirstlane(tid >> 6), lane = tid & 63, wr = wid >> 2, wc = wid & 3, fr = lane & 15, fq = lane >> 4;
    const int K = g.K, nt = K / BK;
    unsigned voffA[2], voffB[2];
#pragma unroll
    for (int i = 0; i < 2; ++i) { int R, C; stage_rc(tid * 16 + i * 8192, R, C); const int Rb = Epi::PERM ? ((R & ~31) + perm32(R & 31)) : R;
        voffA[i] = (unsigned)(R * K + C) * 2u; voffB[i] = (unsigned)(Rb * K + C) * 2u; }
    const size_t kstep = (size_t)(BK * 2);
    const size_t hstep = (size_t)HALF * K * 2;
    const size_t tstep = 2 * hstep;
    const unsigned ldsw = (unsigned)wid * 1024u;
    const int aoff = lds_byte(wr * 64 + fr, fq * 8), boff = lds_byte(wc * 32 + fr, fq * 8);
#define PG8_SA(b, h) (((b) * 2 + (h)) * HTB)
#define PG8_SB(b, h) ((4 + (b) * 2 + (h)) * HTB)
#define PG8_STAGE(bufoff, gbase, voff) do { _Pragma("unroll") for (int _i = 0; _i < 2; ++_i) \
        __builtin_amdgcn_global_load_lds((const unsigned*)((const char*)(gbase) + (voff)[_i]), (LAS unsigned*)(lds + (bufoff) + ldsw + _i * 8192), 16, 0, 0); } while (0)
#define PG8_LDA(dst, b, h) do { _Pragma("unroll") for (int m = 0; m < 4; ++m) _Pragma("unroll") for (int k = 0; k < 2; ++k) dst[m][k] = *(const LAS bf16x8*)(lds + PG8_SA(b, h) + aoff + m * 2048 + k * 1024); } while (0)
#define PG8_LDB(dst, b, h) do { _Pragma("unroll") for (int n = 0; n < 2; ++n) _Pragma("unroll") for (int k = 0; k < 2; ++k) dst[n][k] = *(const LAS bf16x8*)(lds + PG8_SB(b, h) + boff + n * 2048 + k * 1024); } while (0)
#define PG8_MMA(ai, bj, At, Bt) do { __builtin_amdgcn_s_setprio(1); _Pragma("unroll") for (int m = 0; m < 4; ++m) _Pragma("unroll") for (int n = 0; n < 2; ++n) _Pragma("unroll") for (int k = 0; k < 2; ++k) \
        acc[ai][bj][m][n] = __builtin_amdgcn_mfma_f32_16x16x32_bf16(Bt[n][k], At[m][k], acc[ai][bj][m][n], 0, 0, 0); __builtin_amdgcn_s_setprio(0); } while (0)
#define PG8_WAIT_V(n) asm volatile("s_waitcnt vmcnt(" #n ")" ::: "memory")
#define PG8_WAIT_L(n) asm volatile("s_waitcnt lgkmcnt(" #n ")" ::: "memory")
#define PG8_BAR __builtin_amdgcn_s_barrier()
#define PG8_SCHED __builtin_amdgcn_sched_barrier(0)
    Unit cur, nxt; int ui = 0;
    if (!S.next(0, cur)) return;
    f32x4 acc[2][2][4][2];
#pragma unroll
    for (int a = 0; a < 2; ++a)
#pragma unroll
        for (int b = 0; b < 2; ++b)
#pragma unroll
            for (int m = 0; m < 4; ++m)
#pragma unroll
                for (int n = 0; n < 2; ++n) acc[a][b][m][n] = (f32x4){0.f, 0.f, 0.f, 0.f};
    bf16x8 At[4][2], B0[2][2], B1[2][2];
    const char* cA = (const char*)g.A + (size_t)cur.pm * tstep; const char* cB = (const char*)g.Bt + (size_t)cur.pn * tstep;
    if constexpr (SP2) {
        PG8_STAGE(PG8_SB(0, 0), cB, voffB); PG8_STAGE(PG8_SB(0, 1), cB + hstep, voffB); PG8_STAGE(PG8_SA(0, 0), cA, voffA); PG8_STAGE(PG8_SA(0, 1), cA + hstep, voffA);
        if (wr == 1) PG8_BAR;
        PG8_WAIT_V(2); PG8_BAR;
        PG8_STAGE(PG8_SB(1, 0), cB + kstep, voffB); PG8_STAGE(PG8_SA(1, 0), cA + kstep, voffA); PG8_STAGE(PG8_SB(1, 1), cB + hstep + kstep, voffB);
        PG8_WAIT_V(6); PG8_BAR;
    } else {
        PG8_STAGE(PG8_SB(0, 0), cB, voffB); PG8_STAGE(PG8_SA(0, 0), cA, voffA); PG8_STAGE(PG8_SB(0, 1), cB + hstep, voffB); PG8_STAGE(PG8_SA(0, 1), cA + hstep, voffA);
        if (wr == 1) PG8_BAR;
        PG8_WAIT_V(4); PG8_BAR;
        PG8_STAGE(PG8_SB(1, 0), cB + kstep, voffB); PG8_STAGE(PG8_SA(1, 0), cA + kstep, voffA); PG8_STAGE(PG8_SB(1, 1), cB + hstep + kstep, voffB);
        PG8_WAIT_V(6); PG8_BAR;
    }
    for (;;) {
        const bool has_next = S.next(ui + 1, nxt);
        const char* nA = has_next ? (const char*)g.A + (size_t)nxt.pm * tstep : cA; const char* nB = has_next ? (const char*)g.Bt + (size_t)nxt.pn * tstep : cB;
        for (int t = 0; t < nt; t += 2) {
            const bool last = (t == nt - 2);
            const char* a1 = cA + (size_t)(t + 1) * kstep;
            const char* a2 = last ? nA : cA + (size_t)(t + 2) * kstep; const char* b2 = last ? nB : cB + (size_t)(t + 2) * kstep;
            const char* a3 = a2 + kstep; const char* b3 = b2 + kstep;
            if constexpr (SP2) {
            PG8_LDB(B0, 0, 0); PG8_LDB(B1, 0, 1); PG8_SCHED; PG8_LDA(At, 0, 0); PG8_STAGE(PG8_SA(1, 1), a1 + hstep, voffA);
            PG8_WAIT_V(8); PG8_WAIT_L(0); PG8_BAR; PG8_MMA(0, 0, At, B0); PG8_MMA(0, 1, At, B1); PG8_BAR; PG8_SCHED;
            PG8_LDA(At, 0, 1); PG8_STAGE(PG8_SB(0, 0), b2, voffB); PG8_STAGE(PG8_SB(0, 1), b2 + hstep, voffB); PG8_STAGE(PG8_SA(0, 0), a2, voffA);
            PG8_WAIT_V(8); PG8_WAIT_L(0); PG8_BAR; PG8_MMA(1, 0, At, B0); PG8_MMA(1, 1, At, B1); PG8_BAR; PG8_SCHED;
            PG8_LDB(B0, 1, 0); PG8_LDB(B1, 1, 1); PG8_SCHED; PG8_LDA(At, 1, 0); PG8_STAGE(PG8_SA(0, 1), a2 + hstep, voffA);
            PG8_WAIT_V(8); PG8_WAIT_L(0); PG8_BAR; PG8_MMA(0, 0, At, B0); PG8_MMA(0, 1, At, B1); PG8_BAR; PG8_SCHED;
            PG8_LDA(At, 1, 1); PG8_STAGE(PG8_SB(1, 0), b3, voffB); PG8_STAGE(PG8_SB(1, 1), b3 + hstep, voffB); PG8_STAGE(PG8_SA(1, 0), a3, voffA);
            PG8_WAIT_V(8); PG8_WAIT_L(0); PG8_BAR; PG8_MMA(1, 0, At, B0); PG8_MMA(1, 1, At, B1); PG8_BAR; PG8_SCHED;
            } else {
            PG8_LDB(B0, 0, 0); PG8_SCHED; PG8_LDA(At, 0, 0); PG8_STAGE(PG8_SA(1, 1), a1 + hstep, voffA);
            PG8_WAIT_L(8); PG8_BAR; PG8_WAIT_L(0); PG8_MMA(0, 0, At, B0); PG8_BAR; PG8_SCHED;
            PG8_LDB(B1, 0, 1); PG8_STAGE(PG8_SB(0, 0), b2, voffB);
            PG8_BAR; PG8_WAIT_L(0); PG8_MMA(0, 1, At, B1); PG8_BAR;
            PG8_LDA(At, 0, 1); PG8_STAGE(PG8_SA(0, 0), a2, voffA);
            PG8_BAR; PG8_WAIT_L(0); PG8_MMA(1, 0, At, B0); PG8_BAR; PG8_SCHED;
            PG8_STAGE(PG8_SB(0, 1), b2 + hstep, voffB);
            PG8_WAIT_V(6); PG8_BAR; PG8_MMA(1, 1, At, B1); PG8_BAR;
            PG8_LDB(B0, 1, 0); PG8_SCHED; PG8_LDA(At, 1, 0); PG8_STAGE(PG8_SA(0, 1), a2 + hstep, voffA);
            PG8_WAIT_L(8); PG8_BAR; PG8_WAIT_L(0); PG8_MMA(0, 0, At, B0); PG8_BAR; PG8_SCHED;
            PG8_LDB(B1, 1, 1); PG8_STAGE(PG8_SB(1, 0), b3, voffB);
            PG8_BAR; PG8_WAIT_L(0); PG8_MMA(0, 1, At, B1); PG8_BAR;
            PG8_LDA(At, 1, 1); PG8_STAGE(PG8_SA(1, 0), a3, voffA);
            PG8_BAR; PG8_WAIT_L(0); PG8_MMA(1, 0, At, B0); PG8_BAR; PG8_SCHED;
            PG8_STAGE(PG8_SB(1, 1), b3 + hstep, voffB);
            PG8_WAIT_V(6); PG8_BAR; PG8_MMA(1, 1, At, B1); PG8_BAR;
            }
        }
        if constexpr (ALIGN_EPI) { if (wr == 0) PG8_BAR; }
        E(acc, cur, wr, wc, fr, fq, lds + STAGE_BYTES);
        if (!has_next) break;
#pragma unroll
        for (int a = 0; a < 2; ++a)
#pragma unroll
            for (int b = 0; b < 2; ++b)
#pragma unroll
                for (int m = 0; m < 4; ++m)
#pragma unroll
                    for (int n = 0; n < 2; ++n) acc[a][b][m][n] = (f32x4){0.f, 0.f, 0.f, 0.f};
        cur = nxt; cA = nA; cB = nB; ++ui;
        if constexpr (ALIGN_EPI) { if (wr == 1) PG8_BAR; }
    }
    PG8_WAIT_V(0);
    if constexpr (!ALIGN_EPI) { if (wr == 0) PG8_BAR; }
    PG8_BAR;
#undef PG8_SA
#undef PG8_SB
#undef PG8_STAGE
#undef PG8_LDA
#undef PG8_LDB
#undef PG8_MMA
#undef PG8_WAIT_V
#undef PG8_WAIT_L
#undef PG8_BAR
#undef PG8_SCHED
}
}

__device__ __forceinline__ float sigmoid_f(float v) { return __builtin_amdgcn_rcpf(1.f + __expf(-v)); }
__device__ __forceinline__ float silu_f(float v) { return v * sigmoid_f(v); }
__device__ __forceinline__ unsigned f2bf(float f) { unsigned u = __builtin_bit_cast(unsigned, f); return (u + 0x7fffu + ((u >> 16) & 1u)) >> 16; }
__device__ __forceinline__ unsigned pk2(float lo, float hi) { return f2bf(lo) | (f2bf(hi) << 16); }
__device__ __forceinline__ float bf2f(bf16_t b) { return __builtin_bit_cast(float, ((unsigned)b) << 16); }
__device__ __forceinline__ int t5_bucket(int n) {
    if (n < 16) return n;
    const int l = 16 + (int)(logf((float)n * (1.f / 16.f)) * (16.f / 2.0794415416798357f));
    return l < 31 ? l : 31;
}
__device__ __forceinline__ float log_sigmoid_f(float x) { return fminf(x, 0.f) - log1pf(expf(-fabsf(x))); }

using pg8::Unit; using pg8::cvt_pk_bf16;
template <int ACT  > __device__ __forceinline__ void store_tile_bf16(const f32x4 (&acc)[2][2][4][2], bf16_t* base, int ld, float sc, int wr, int wc, int fr, int fq) {
    bf16_t* p0 = base + (size_t)(wr * 64 + fr) * ld + wc * 32 + 8 * fq;
#pragma unroll
    for (int ai = 0; ai < 2; ++ai)
#pragma unroll
        for (int m = 0; m < 4; ++m) { bf16_t* rowp = p0 + (size_t)(ai * 128 + m * 16) * ld;
#pragma unroll
            for (int bj = 0; bj < 2; ++bj) { f32x4 v0 = acc[ai][bj][m][0], v1 = acc[ai][bj][m][1];
                if (ACT == 1) {
#pragma unroll
                    for (int j = 0; j < 4; ++j) { v0[j] = silu_f(v0[j]); v1[j] = silu_f(v1[j]); } }
                else { v0 = v0 * sc; v1 = v1 * sc; }
                u32x4 w; w.x = cvt_pk_bf16(v0[0], v0[1]); w.y = cvt_pk_bf16(v0[2], v0[3]); w.z = cvt_pk_bf16(v1[0], v1[1]); w.w = cvt_pk_bf16(v1[2], v1[3]);
                *(u32x4*)(rowp + bj * 128) = w; } }
}

struct Epi1 {
    static constexpr bool PERM = true;
    unsigned char* ws;
    __device__ __forceinline__ void operator()(const f32x4 (&acc)[2][2][4][2], const Unit& u, int wr, int wc, int fr, int fq, LAS unsigned char* xl) const {
        asm volatile("" : "+v"(fr), "+v"(fq));
        const int pn = u.pn; const size_t r0 = (size_t)u.pm * 256;
        bf16_t* const Q = (bf16_t*)(ws + WS_Q); bf16_t* const C = (bf16_t*)(ws + WS_C); bf16_t* const SZA = (bf16_t*)(ws + WS_SZA); bf16_t* const QI = (bf16_t*)(ws + WS_QI);
        bf16_t* const KI = (bf16_t*)(ws + WS_KI); bf16_t* const QKM = (bf16_t*)(ws + WS_QKM); bf16_t* const VM = (bf16_t*)(ws + WS_VM); bf16_t* const GM = (bf16_t*)(ws + WS_GM);
        float* const WI = (float*)(ws + WS_WI); float* const IFG = (float*)(ws + WS_IFG);
        const float* const kvg = (const float*)(ws + WS_PAR) + P_KVG; const float* const lng = (const float*)(ws + WS_PAR) + P_LNG; const float* const lnb = (const float*)(ws + WS_PAR) + P_LNB;
        if (pn < 4) { store_tile_bf16<0>(acc, Q + r0 * 1024 + pn * 256, 1024, QSCALE, wr, wc, fr, fq); return; }
        if (pn == 4) {
            LAS float* P = (LAS float*)xl;
#pragma unroll
            for (int ai = 0; ai < 2; ++ai)
#pragma unroll
                for (int m = 0; m < 4; ++m) { float s = 0.f;
#pragma unroll
                    for (int bj = 0; bj < 2; ++bj)
#pragma unroll
                        for (int n = 0; n < 2; ++n) { const f32x4 x = acc[ai][bj][m][n]; s += (x[0] * x[0] + x[1] * x[1]) + (x[2] * x[2] + x[3] * x[3]); }
                    s += __shfl_xor(s, 16); s += __shfl_xor(s, 32);
                    if (fq == 0) P[(ai * 128 + wr * 64 + m * 16 + fr) * 4 + wc] = s; }
            asm volatile("s_waitcnt lgkmcnt(0)" ::: "memory"); __builtin_amdgcn_s_barrier(); asm volatile("" ::: "memory");
            const int c0 = wc * 32 + 8 * fq;
            f32x4 g[2][2];
#pragma unroll
            for (int bj = 0; bj < 2; ++bj) { g[bj][0] = *(const f32x4*)(kvg + bj * 128 + c0); g[bj][1] = *(const f32x4*)(kvg + bj * 128 + c0 + 4); }
#pragma unroll
            for (int ai = 0; ai < 2; ++ai)
#pragma unroll
                for (int m = 0; m < 4; ++m) { const int r = ai * 128 + wr * 64 + m * 16 + fr;
                    const f32x4 pp = *(const LAS f32x4*)(P + r * 4);
                    const float rstd = rsqrtf(((pp[0] + pp[1]) + (pp[2] + pp[3])) * (1.f / 256.f) + LN_EPS);
                    bf16_t* rowp = C + (r0 + r) * 256 + c0;
#pragma unroll
                    for (int bj = 0; bj < 2; ++bj) { const f32x4 v0 = acc[ai][bj][m][0] * rstd * g[bj][0], v1 = acc[ai][bj][m][1] * rstd * g[bj][1];
                        u32x4 w; w.x = cvt_pk_bf16(v0[0], v0[1]); w.y = cvt_pk_bf16(v0[2], v0[3]); w.z = cvt_pk_bf16(v1[0], v1[1]); w.w = cvt_pk_bf16(v1[2], v1[3]);
                        *(u32x4*)(rowp + bj * 128) = w; } }
            asm volatile("s_waitcnt lgkmcnt(0)" ::: "memory"); __builtin_amdgcn_s_barrier(); asm volatile("" ::: "memory");
            return;
        }
        if (pn < 9) { store_tile_bf16<1>(acc, SZA + r0 * 1024 + (pn - 5) * 256, 1024, 1.f, wr, wc, fr, fq); return; }
        if (pn < 13) { store_tile_bf16<0>(acc, QI + r0 * 1024 + (pn - 9) * 256, 1024, 0.125f, wr, wc, fr, fq); return; }
        if (pn == 13) {
            if (wc == 0) {
                f32x4 g[2][2], bb[2][2];
#pragma unroll
                for (int bj = 0; bj < 2; ++bj)
#pragma unroll
                    for (int n = 0; n < 2; ++n) { g[bj][n] = *(const f32x4*)(lng + 32 * bj + 8 * fq + 4 * n); bb[bj][n] = *(const f32x4*)(lnb + 32 * bj + 8 * fq + 4 * n); }
#pragma unroll
                for (int ai = 0; ai < 2; ++ai)
#pragma unroll
                    for (int m = 0; m < 4; ++m) { float s = 0.f;
#pragma unroll
                        for (int bj = 0; bj < 2; ++bj)
#pragma unroll
                            for (int n = 0; n < 2; ++n) { const f32x4 x = acc[ai][bj][m][n]; s += (x[0] + x[1]) + (x[2] + x[3]); }
                        s += __shfl_xor(s, 16); s += __shfl_xor(s, 32);
                        const float mu = s * (1.f / 64.f); float q = 0.f;
#pragma unroll
                        for (int bj = 0; bj < 2; ++bj)
#pragma unroll
                            for (int n = 0; n < 2; ++n) { const f32x4 d = acc[ai][bj][m][n] - mu; q += (d[0] * d[0] + d[1] * d[1]) + (d[2] * d[2] + d[3] * d[3]); }
                        q += __shfl_xor(q, 16); q += __shfl_xor(q, 32);
                        const float rstd = rsqrtf(q * (1.f / 64.f) + LN_EPS);
                        bf16_t* rowp = KI + (r0 + ai * 128 + wr * 64 + m * 16 + fr) * 64 + 8 * fq;
#pragma unroll
                        for (int bj = 0; bj < 2; ++bj) { const f32x4 v0 = (acc[ai][bj][m][0] - mu) * rstd * g[bj][0] + bb[bj][0], v1 = (acc[ai][bj][m][1] - mu) * rstd * g[bj][1] + bb[bj][1];
                            u32x4 w; w.x = cvt_pk_bf16(v0[0], v0[1]); w.y = cvt_pk_bf16(v0[2], v0[3]); w.z = cvt_pk_bf16(v1[0], v1[1]); w.w = cvt_pk_bf16(v1[2], v1[3]);
                            *(u32x4*)(rowp + bj * 32) = w; } }
            } else if (wc == 1) {
#pragma unroll
                for (int ai = 0; ai < 2; ++ai)
#pragma unroll
                    for (int m = 0; m < 4; ++m) { const size_t r = r0 + ai * 128 + wr * 64 + m * 16 + fr;
                        if (fq < 2) { *(f32x4*)(WI + r * 16 + 8 * fq) = acc[ai][0][m][0] * 0.25f; *(f32x4*)(WI + r * 16 + 8 * fq + 4) = acc[ai][0][m][1] * 0.25f; }
                        else if (fq == 2) { *(f32x4*)(IFG + r * 8) = acc[ai][0][m][0]; *(f32x4*)(IFG + r * 8 + 4) = acc[ai][0][m][1]; } }
            }
            return;
        }
        if (pn < 18) { store_tile_bf16<0>(acc, QKM + r0 * 1024 + (pn - 14) * 256, 1024, 1.f, wr, wc, fr, fq); return; }
        if (pn < 22) { store_tile_bf16<0>(acc, VM + r0 * 1024 + (pn - 18) * 256, 1024, 1.f, wr, wc, fr, fq); return; }
        {
            bf16_t* p0 = GM + (r0 + wr * 64 + fr) * 1024 + (pn - 22) * 128 + wc * 32 + 8 * fq;
#pragma unroll
            for (int ai = 0; ai < 2; ++ai)
#pragma unroll
                for (int m = 0; m < 4; ++m) { f32x4 v0, v1;
#pragma unroll
                    for (int j = 0; j < 4; ++j) { v0[j] = sigmoid_f(acc[ai][0][m][0][j]) * silu_f(acc[ai][1][m][0][j]); v1[j] = sigmoid_f(acc[ai][0][m][1][j]) * silu_f(acc[ai][1][m][1][j]); }
                    u32x4 w; w.x = cvt_pk_bf16(v0[0], v0[1]); w.y = cvt_pk_bf16(v0[2], v0[3]); w.z = cvt_pk_bf16(v1[0], v1[1]); w.w = cvt_pk_bf16(v1[2], v1[3]);
                    *(u32x4*)(p0 + (size_t)(ai * 128 + m * 16) * 1024) = w; }
        }
    }
};
struct EpiKV {
    static constexpr bool PERM = true;
    bf16_t *Kb, *Vb;
    __device__ __forceinline__ void operator()(const f32x4 (&acc)[2][2][4][2], const Unit& u, int wr, int wc, int fr, int fq, LAS unsigned char*) const {
        asm volatile("" : "+v"(fr), "+v"(fq));
        bf16_t* base = (u.pn < 4 ? Kb + u.pn * 256 : Vb + (u.pn - 4) * 256) + (size_t)u.pm * 256 * 1024;
        store_tile_bf16<0>(acc, base, 1024, 1.f, wr, wc, fr, fq);
    }
};
struct EpiOut {
    static constexpr bool PERM = false;
    const float* x; float* out;
    __device__ __forceinline__ void operator()(const f32x4 (&acc)[2][2][4][2], const Unit& u, int wr, int wc, int fr, int fq, LAS unsigned char*) const {
        asm volatile("" : "+v"(fr), "+v"(fq));
        const size_t off0 = ((size_t)u.pm * 256 + wr * 64 + fr) * DM + u.pn * 256 + wc * 32 + 4 * fq;
#pragma unroll
        for (int ai = 0; ai < 2; ++ai)
#pragma unroll
            for (int m = 0; m < 4; ++m) { const size_t off = off0 + (size_t)(ai * 128 + m * 16) * DM;
#pragma unroll
                for (int bj = 0; bj < 2; ++bj)
#pragma unroll
                    for (int n = 0; n < 2; ++n) { const f32x4 xv = *(const f32x4*)(x + off + bj * 128 + n * 16);
                        *(f32x4*)(out + off + bj * 128 + n * 16) = xv * ALPHA + acc[ai][bj][m][n]; } }
    }
};

constexpr int NWAVES = 8, NTHREADS = 512;
constexpr int LDS_BYTES = 147456;
struct Args {
    const float* in[16]; float* out; unsigned char* ws; int ph_lo, ph_hi;
};

template <class SrcMap>
__device__ __forceinline__ void p0_transpose_item(const float* W, int K, int Nsrc, int nblk, bf16_t* WT, int row_off, LAS float* scr, int item, int lane, SrcMap smap) {
    const int kb = item / nblk, nb = item % nblk, k0 = 64 * kb, n0 = 32 * nb;
    const int src = smap(n0 + (lane & 31));
#pragma unroll 8
    for (int i = 0; i < 32; ++i) { const int kk = 2 * i + (lane >> 5); scr[kk * 33 + (lane & 31)] = src >= 0 ? W[(size_t)(k0 + kk) * Nsrc + src] : 0.f; }
    asm volatile("s_waitcnt lgkmcnt(0)" ::: "memory");
    const int c = lane & 7;
#pragma unroll
    for (int j = 0; j < 4; ++j) { const int n = (lane >> 3) + 8 * j; const LAS float* s = scr + (8 * c) * 33 + n;
        u32x4 o; o.x = pk2(s[0 * 33], s[1 * 33]); o.y = pk2(s[2 * 33], s[3 * 33]); o.z = pk2(s[4 * 33], s[5 * 33]); o.w = pk2(s[6 * 33], s[7 * 33]);
        *(u32x4*)(WT + (size_t)(row_off + n0 + n) * K + k0 + 8 * c) = o; }
    asm volatile("s_waitcnt lgkmcnt(0)" ::: "memory");
}
struct MapIdent { __device__ __forceinline__ int operator()(int n) const { return n; } };
struct MapWin { __device__ __forceinline__ int operator()(int n) const { return win_src(n); } };

__global__ void __launch_bounds__(NTHREADS, 2) skel_fwd(Args args) {
    extern __shared__ __attribute__((aligned(16))) unsigned char lds_raw[];
    LAS unsigned char* lds = (LAS unsigned char*)lds_raw;
#define FRESH_TID() ({ int t_ = threadIdx.x; asm volatile("" : "+v"(t_)); t_; })
    const int wave = __builtin_amdgcn_readfirstlane(threadIdx.x >> 6);
    const int G = gridDim.x, bx = blockIdx.x;
    const int vcu = (G % 8 == 0) ? (bx % 8) * (G / 8) + bx / 8 : bx;
    unsigned char* ws = args.ws;
    const int lo = args.ph_lo, hi = args.ph_hi;
#define IN(k) (lo <= (k) && (k) < hi)
#define XB ((bf16_t*)(ws + WS_XB))
#define WINT ((bf16_t*)(ws + WS_WINT))
#define WOUTT ((bf16_t*)(ws + WS_WOUTT))
#define WKVT ((bf16_t*)(ws + WS_WKVT))
#define PARF ((float*)(ws + WS_PAR))

    if (IN(0)) {
        const int tid = FRESH_TID(), lane = tid & 63;
        const int gw = vcu * NWAVES + wave, NGW = G * NWAVES;
        LAS float* scr = (LAS float*)(lds + wave * 16384);
        const float* x = args.in[0];
        for (int it = gw; it < M * DM / 512; it += NGW) {
            const f32x4 a = *(const f32x4*)(x + (size_t)it * 512 + lane * 8), b = *(const f32x4*)(x + (size_t)it * 512 + lane * 8 + 4);
            u32x4 o; o.x = pk2(a[0], a[1]); o.y = pk2(a[2], a[3]); o.z = pk2(b[0], b[1]); o.w = pk2(b[2], b[3]);
            *(u32x4*)(XB + (size_t)it * 512 + lane * 8) = o;
        }
        constexpr int I_IN = (DM / 64) * (NP / 32), I_OUT = (DM / 64) * (DM / 32), I_UV = (DC / 64) * (DHA / 32);
        for (int it = gw; it < I_IN + I_OUT + HA * I_UV; it += NGW) {
            int r = it;
            if (r < I_IN) { p0_transpose_item(args.in[1], DM, NCOLS, NP / 32, WINT, 0, scr, r, lane, MapWin()); continue; } r -= I_IN;
            if (r < I_OUT) { p0_transpose_item(args.in[13], DM, DM, DM / 32, WOUTT, 0, scr, r, lane, MapIdent()); continue; } r -= I_OUT;
            { const int h = r / I_UV; p0_transpose_item(args.in[6] + (size_t)h * DC * DHA, DC, DHA, DHA / 32, WKVT, 1024 + h * DHA, scr, r % I_UV, lane, MapIdent()); }
        }
        {
            const int gt = vcu * NTHREADS + tid, NGT = G * NTHREADS;
            for (int i = gt; i < P_TOTAL; i += NGT) { float v = 0.f;
                if (i < P_LNG) v = args.in[4][i - P_KVG]; else if (i < P_LNB) v = args.in[7][i - P_LNG]; else if (i < P_RB) v = args.in[8][i - P_LNB];
                else if (i < P_CW) v = args.in[9][i - P_RB]; else if (i < P_CB) v = args.in[10][i - P_CW]; else if (i < P_MHG) v = args.in[11][i - P_CB];
                else if (i < P_BI) v = args.in[12][i - P_MHG]; else if (i < P_BI + 4) v = args.in[2][i - P_BI]; else if (i < P_BF + 4) v = args.in[3][i - P_BF];
                else if (i >= P_LG && i < P_LB) v = args.in[14][i - P_LG]; else if (i >= P_LB) v = args.in[15][i - P_LB];
                PARF[i] = v; }
        }
        const float* wuk = args.in[5];
        for (int it = gw; it < 1024 * 256 / 512; it += NGW) {
            const f32x4 a = *(const f32x4*)(wuk + (size_t)it * 512 + lane * 8), b = *(const f32x4*)(wuk + (size_t)it * 512 + lane * 8 + 4);
            u32x4 o; o.x = pk2(a[0], a[1]); o.y = pk2(a[2], a[3]); o.z = pk2(b[0], b[1]); o.w = pk2(b[2], b[3]);
            *(u32x4*)(WKVT + (size_t)it * 512 + lane * 8) = o;
        }
    }
    if (IN(1)) {
        pg8::Gemm g{XB, WINT, M, NP, DM}; pg8::StaticOrder S; S.init(M, NP, G, bx);
        Epi1 E{ws};
        pg8::gemm_phase<Epi1, pg8::StaticOrder>(lds, g, S, E);
    }
    if (IN(2)) {
        pg8::Gemm g{(bf16_t*)(ws + WS_C), WKVT, M, 2048, DC}; pg8::StaticOrder S; S.init(M, 2048, G, bx);
        EpiKV E{(bf16_t*)((unsigned char*)args.out + OUT_K), (bf16_t*)((unsigned char*)args.out + OUT_V)};
        pg8::gemm_phase<EpiKV, pg8::StaticOrder>(lds, g, S, E);
    }
    if (IN(4)) {
        pg8::Gemm g{(bf16_t*)(ws + WS_Y), WOUTT, M, DM, DM}; pg8::StaticOrder S; S.init(M, DM, G, bx);
        EpiOut E{args.in[0], args.out};
        pg8::gemm_phase<EpiOut, pg8::StaticOrder>(lds, g, S, E);
    }
    if (IN(5)) {
        const int lane = FRESH_TID() & 63;
        const int gw = vcu * NWAVES + wave, NGW = G * NWAVES;
        const float* lg = PARF + P_LG; const float* lb = PARF + P_LB;
        for (int r = gw; r < M; r += NGW) {
            f32x4* p = (f32x4*)(args.out + (size_t)r * DM) + lane;
            f32x4 v[8]; float s = 0.f;
#pragma unroll
            for (int j = 0; j < 8; ++j) { v[j] = p[64 * j]; s += (v[j][0] + v[j][1]) + (v[j][2] + v[j][3]); }
#pragma unroll
            for (int o = 1; o < 64; o <<= 1) s += __shfl_xor(s, o);
            const float mu = s * (1.f / DM); float q = 0.f;
#pragma unroll
            for (int j = 0; j < 8; ++j) { v[j] = v[j] - mu; q += (v[j][0] * v[j][0] + v[j][1] * v[j][1]) + (v[j][2] * v[j][2] + v[j][3] * v[j][3]); }
#pragma unroll
            for (int o = 1; o < 64; o <<= 1) q += __shfl_xor(q, o);
            const float rstd = rsqrtf(q * (1.f / DM) + LN_EPS);
#pragma unroll
            for (int j = 0; j < 8; ++j) { const f32x4 gg = *((const f32x4*)lg + lane + 64 * j), bb = *((const f32x4*)lb + lane + 64 * j); p[64 * j] = v[j] * rstd * gg + bb; }
        }
    }
#undef IN
}

__device__ __forceinline__ unsigned mono_key(float s) { s = s + 0.0f; const unsigned u = __builtin_bit_cast(unsigned, s); return (u & 0x80000000u) ? ~u : (u | 0x80000000u); }

__global__ void __launch_bounds__(256) naive_topk(const bf16_t* __restrict__ QI, const bf16_t* __restrict__ KI, const float* __restrict__ WI, unsigned long long* __restrict__ mask) {
    __shared__ float qi[HIDX * DIDX]; __shared__ float w[HIDX]; __shared__ unsigned keys[SEQ]; __shared__ unsigned cnt; __shared__ unsigned Tsh;
    const int row = blockIdx.x, b = row / SEQ, t = row % SEQ, tid = threadIdx.x;
    for (int i = tid; i < HIDX * DIDX; i += 256) qi[i] = bf2f(QI[(size_t)row * 1024 + i]);
    if (tid < HIDX) w[tid] = WI[(size_t)row * 16 + tid];
    __syncthreads();
    for (int s = tid; s < SEQ; s += 256) {
        unsigned key = 0u;
        if (s <= t) {
            const bf16_t* kr = KI + ((size_t)b * SEQ + s) * DIDX; float kf[DIDX];
#pragma unroll
            for (int d = 0; d < DIDX; ++d) kf[d] = bf2f(kr[d]);
            float sc = 0.f;
            for (int h = 0; h < HIDX; ++h) { float a = 0.f;
#pragma unroll
                for (int d = 0; d < DIDX; ++d) a = fmaf(qi[h * DIDX + d], kf[d], a);
                sc = fmaf(fmaxf(a, 0.f), w[h], sc); }
            key = mono_key(sc);
        }
        keys[s] = key;
    }
    __syncthreads();
    if (t >= NSEL) {
        unsigned T = 0u;
        for (int bit = 31; bit >= 0; --bit) {
            const unsigned cand = T | (1u << bit);
            if (tid == 0) cnt = 0u;
            __syncthreads();
            unsigned c = 0u;
            for (int s = tid; s < SEQ; s += 256) c += keys[s] >= cand ? 1u : 0u;
            atomicAdd(&cnt, c);
            __syncthreads();
            if (cnt >= (unsigned)NSEL) T = cand;
            __syncthreads();
        }
        if (tid == 0) {
            unsigned gt = 0u; for (int s = 0; s < SEQ; ++s) gt += keys[s] > T ? 1u : 0u;
            unsigned need = NSEL - gt;
            for (int s = 0; s < SEQ; ++s) if (keys[s] == T) { if (need > 0u) --need; else keys[s] = 0u; }
            Tsh = T;
        }
        __syncthreads();
    } else { if (tid == 0) Tsh = 1u; __syncthreads(); }
    if (tid < 32) {
        const unsigned T = Tsh; unsigned long long wv = 0ull;
        for (int l = 0; l < 64; ++l) if (keys[tid * 64 + l] >= T) wv |= 1ull << l;
        mask[((size_t)b * 32 + tid) * SEQ + t] = wv;
    }
}

__global__ void __launch_bounds__(256) naive_attn(const bf16_t* __restrict__ Qb, const bf16_t* __restrict__ Kb, const bf16_t* __restrict__ Vb, const bf16_t* __restrict__ SZA,
                                                  const unsigned long long* __restrict__ mask, const float* __restrict__ rel_bias, bf16_t* __restrict__ Y) {
    __shared__ int sel[NSEL]; __shared__ int nsel_s; __shared__ float q[1024]; __shared__ float p[NSEL]; __shared__ float red[8]; __shared__ int pre[33];
    const int row = blockIdx.x, b = row / SEQ, t = row % SEQ, tid = threadIdx.x;
    for (int i = tid; i < 1024; i += 256) q[i] = bf2f(Qb[(size_t)row * 1024 + i]);
    if (tid == 0) { int a = 0; for (int g = 0; g < 32; ++g) { pre[g] = a; a += __popcll(mask[((size_t)b * 32 + g) * SEQ + t]); } pre[32] = a; nsel_s = a; }
    __syncthreads();
    if (tid < 32) { unsigned long long wv = mask[((size_t)b * 32 + tid) * SEQ + t]; int o = pre[tid]; while (wv) { const int l = __ffsll((long long)wv) - 1; wv &= wv - 1; if (o < NSEL) sel[o] = tid * 64 + l; ++o; } }
    __syncthreads();
    const int nsel = nsel_s < NSEL ? nsel_s : NSEL;
    for (int h = 0; h < HA; ++h) {
        float lg = -1e30f;
        if (tid < nsel) { const int s = sel[tid]; const bf16_t* kr = Kb + ((size_t)b * SEQ + s) * 1024 + h * DHA; float a = 0.f;
            for (int d = 0; d < DHA; ++d) a = fmaf(q[h * DHA + d], bf2f(kr[d]), a);
            lg = a + rel_bias[t5_bucket(t - s) * HA + h] * LOG2E; }
        float mx = lg;
        for (int o = 1; o < 64; o <<= 1) mx = fmaxf(mx, __shfl_xor(mx, o));
        if ((tid & 63) == 0) red[tid >> 6] = mx;
        __syncthreads();
        mx = fmaxf(fmaxf(red[0], red[1]), fmaxf(red[2], red[3]));
        const float pe = tid < nsel ? exp2f(lg - mx) : 0.f;
        p[tid] = pe;
        float sm = pe;
        for (int o = 1; o < 64; o <<= 1) sm += __shfl_xor(sm, o);
        if ((tid & 63) == 0) red[4 + (tid >> 6)] = sm;
        __syncthreads();
        const float l = (red[4] + red[5]) + (red[6] + red[7]);
        if (tid < DHA) { float o = 0.f;
            for (int j = 0; j < nsel; ++j) o = fmaf(p[j], bf2f(Vb[((size_t)b * SEQ + sel[j]) * 1024 + h * DHA + tid]), o);
            const float y = o / l * bf2f(SZA[(size_t)row * 1024 + h * DHA + tid]);
            Y[(size_t)row * 2048 + h * DHA + tid] = (bf16_t)f2bf(y); }
        __syncthreads();
    }
}

__global__ void __launch_bounds__(512) naive_mlstm(const bf16_t* __restrict__ QKM, const bf16_t* __restrict__ VM, const bf16_t* __restrict__ GM, const float* __restrict__ IFG,
                                                   const float* __restrict__ conv_w, const float* __restrict__ conv_b, const float* __restrict__ b_i, const float* __restrict__ b_f,
                                                   const float* __restrict__ mhg, float* __restrict__ Cst, float* __restrict__ hbuf, bf16_t* __restrict__ Y) {
    extern __shared__ float dsm[]; float* qs = dsm; float* ks = dsm + CHUNK * DKM; float* Ss = dsm + 2 * CHUNK * DKM;
    __shared__ float bcs[CHUNK], ii[CHUNK], mt[CHUNK], inter[CHUNK], den[CHUNK], wgt[CHUNK], nvec[DKM], qn[CHUNK]; __shared__ float m_s, decay_s;
    const int bh = blockIdx.x, b = bh / HM, h = bh % HM, tid = threadIdx.x;
    float* C = Cst + (size_t)bh * DVM * DKM; float* hb = hbuf + (size_t)bh * CHUNK * DVM;
    for (int i = tid; i < DVM * DKM; i += 512) C[i] = 0.f;
    if (tid < DKM) nvec[tid] = 0.f;
    if (tid == 0) m_s = 0.f;
    __syncthreads();
    for (int kc = 0; kc < NCHUNK; ++kc) {
        const int t0 = kc * CHUNK; const size_t rb = (size_t)b * SEQ;
        _Pragma("unroll 1") for (int i = tid; i < CHUNK * DKM * 2; i += 512) {
            const int isk = i >= CHUNK * DKM, e = isk ? i - CHUNK * DKM : i, l = e / DKM, d = e % DKM, c = (isk ? 512 : 0) + h * DKM + d, t = t0 + l;
            float a = conv_b[c];
            for (int j = 0; j < 4; ++j) { const int tt = t - 3 + j; if (tt >= 0) a = fmaf(conv_w[j * 1024 + c], bf2f(QKM[(rb + tt) * 1024 + c]), a); }
            a = silu_f(a);
            if (isk) ks[e] = a * 0.08838834764831845f; else qs[e] = a;
        }
        if (tid == 0) { float cs = 0.f;
            _Pragma("unroll 1") for (int l = 0; l < CHUNK; ++l) { const float* g = IFG + (rb + t0 + l) * 8; cs += log_sigmoid_f(g[4 + h] + b_f[h]); bcs[l] = cs; ii[l] = g[h] + b_i[h]; }
            float rm = -1e30f; const float mp = m_s;
            _Pragma("unroll 1") for (int l = 0; l < CHUNK; ++l) { rm = fmaxf(rm, ii[l] - bcs[l]); const float gl = bcs[l] + mp; const float m = fmaxf(bcs[l] + rm, gl); mt[l] = m; inter[l] = expf(gl - m); } }
        __syncthreads();
        _Pragma("unroll 1") for (int i = tid; i < CHUNK * CHUNK; i += 512) { const int l = i / CHUNK, s = i % CHUNK; float v = 0.f;
            if (s <= l) { float a = 0.f; _Pragma("unroll 4") for (int d = 0; d < DKM; ++d) a = fmaf(qs[l * DKM + d], ks[s * DKM + d], a); v = a * expf(bcs[l] - bcs[s] + ii[s] - mt[l]); }
            Ss[i] = v; }
        if (tid < CHUNK) { float a = 0.f; _Pragma("unroll 4") for (int d = 0; d < DKM; ++d) a = fmaf(qs[tid * DKM + d], nvec[d], a); qn[tid] = a; }
        __syncthreads();
        if (tid < CHUNK) { float a = 0.f; _Pragma("unroll 4") for (int s = 0; s < CHUNK; ++s) a += Ss[tid * CHUNK + s]; den[tid] = a + inter[tid] * qn[tid]; }
        __syncthreads();
        { const int v = tid % DVM, lh = tid / DVM;
            _Pragma("unroll 1") for (int lq = 0; lq < 2; ++lq) { float acc[16]; const int l0 = lh * 32 + lq * 16;
#pragma unroll
                for (int l = 0; l < 16; ++l) acc[l] = 0.f;
_Pragma("unroll 2")
                for (int d = 0; d < DKM; ++d) { const float c = C[v * DKM + d];
#pragma unroll
                    for (int l = 0; l < 16; ++l) acc[l] = fmaf(qs[(l0 + l) * DKM + d], c, acc[l]); }
#pragma unroll
                for (int l = 0; l < 16; ++l) acc[l] *= inter[l0 + l];
_Pragma("unroll 2")
                for (int s = 0; s < CHUNK; ++s) { const float vv = bf2f(VM[(rb + t0 + s) * 1024 + h * DVM + v]);
#pragma unroll
                    for (int l = 0; l < 16; ++l) acc[l] = fmaf(Ss[(l0 + l) * CHUNK + s], vv, acc[l]); }
#pragma unroll
                for (int l = 0; l < 16; ++l) { const int L = l0 + l; hb[L * DVM + v] = acc[l] / fmaxf(fabsf(den[L]), expf(-mt[L])); } } }
        __syncthreads();
        { const int wv = tid >> 6, ln = tid & 63;
            _Pragma("unroll 1") for (int l = wv; l < CHUNK; l += 8) { float x[4]; float s = 0.f;
                for (int j = 0; j < 4; ++j) { x[j] = hb[l * DVM + ln + 64 * j]; s += x[j]; }
                for (int o = 1; o < 64; o <<= 1) s += __shfl_xor(s, o);
                const float mu = s * (1.f / DVM); float q = 0.f;
                for (int j = 0; j < 4; ++j) { x[j] -= mu; q += x[j] * x[j]; }
                for (int o = 1; o < 64; o <<= 1) q += __shfl_xor(q, o);
                const float rstd = rsqrtf(q * (1.f / DVM) + LN_EPS);
                for (int j = 0; j < 4; ++j) { const int c = h * DVM + ln + 64 * j; const float y = x[j] * rstd * mhg[c] * bf2f(GM[(rb + t0 + l) * 1024 + c]);
                    Y[(rb + t0 + l) * 2048 + 1024 + c] = (bf16_t)f2bf(y); } } }
        if (tid == 0) { const float bL = bcs[CHUNK - 1], mp = m_s; float ma = -1e30f;
            _Pragma("unroll 1") for (int l = 0; l < CHUNK; ++l) ma = fmaxf(ma, bL - bcs[l] + ii[l]);
            const float mn = fmaxf(bL + mp, ma); decay_s = expf(bL + mp - mn);
            _Pragma("unroll 1") for (int l = 0; l < CHUNK; ++l) wgt[l] = expf(bL - bcs[l] + ii[l] - mn);
            m_s = mn; }
        __syncthreads();
        { const int v = tid % DVM, dh = tid / DVM; const float dc = decay_s;
            _Pragma("unroll 1") for (int dq = 0; dq < 4; ++dq) { float acc[16]; const int d0 = dh * 64 + dq * 16;
#pragma unroll
                for (int d = 0; d < 16; ++d) acc[d] = C[v * DKM + d0 + d] * dc;
_Pragma("unroll 2")
                for (int l = 0; l < CHUNK; ++l) { const float wvv = wgt[l] * bf2f(VM[(rb + t0 + l) * 1024 + h * DVM + v]);
#pragma unroll
                    for (int d = 0; d < 16; ++d) acc[d] = fmaf(wvv, ks[l * DKM + d0 + d], acc[d]); }
#pragma unroll
                for (int d = 0; d < 16; ++d) C[v * DKM + d0 + d] = acc[d]; } }
        if (tid < DKM) { float a = nvec[tid] * decay_s; _Pragma("unroll 4") for (int l = 0; l < CHUNK; ++l) a = fmaf(wgt[l], ks[l * DKM + tid], a); nvec[tid] = a; }
        __syncthreads();
    }
}

constexpr int NAIVE_MLSTM_LDS = (2 * CHUNK * DKM + CHUNK * CHUNK) * 4;
extern "C" void kernel_launch(void* const* d_in, const int* in_sizes, int n_in, void* d_out, int out_size, void* d_ws, size_t ws_size, hipStream_t stream) {
    static int grid = 0;
    if (grid == 0) {
        if (n_in != 16 || in_sizes[0] != M * DM || out_size != M * DM || ws_size < WS_END) { fprintf(stderr, "kernel_launch: unexpected shapes (n_in %d, in0 %d, out %d, ws %zu)\n", n_in, n_in > 0 ? in_sizes[0] : -1, out_size, ws_size); grid = -1; return; }
        int dev = 0, cus = 0, per_cu = 0;
        if (hipGetDevice(&dev) != hipSuccess || hipDeviceGetAttribute(&cus, hipDeviceAttributeMultiprocessorCount, dev) != hipSuccess) { grid = -1; return; }
        if (hipFuncSetAttribute((const void*)skel_fwd, hipFuncAttributeMaxDynamicSharedMemorySize, LDS_BYTES) != hipSuccess) { fprintf(stderr, "kernel_launch: hipFuncSetAttribute failed\n"); grid = -1; return; }
        if (hipOccupancyMaxActiveBlocksPerMultiprocessor(&per_cu, (const void*)skel_fwd, NTHREADS, LDS_BYTES) != hipSuccess || per_cu < 1) fprintf(stderr, "kernel_launch: occupancy query says %d\n", per_cu);
        (void)hipFuncSetAttribute((const void*)naive_mlstm, hipFuncAttributeMaxDynamicSharedMemorySize, NAIVE_MLSTM_LDS);
        (void)hipGetLastError();
        grid = cus;
    }
    if (grid < 0) return;
    Args a{};
    for (int i = 0; i < 16; ++i) a.in[i] = (const float*)d_in[i];
    a.out = (float*)d_out; a.ws = (unsigned char*)d_ws;
    unsigned char* ws = (unsigned char*)d_ws;
    auto launch = [&](int lo, int hi) { a.ph_lo = lo; a.ph_hi = hi; hipLaunchKernelGGL(skel_fwd, dim3(grid), dim3(NTHREADS), LDS_BYTES, stream, a); };
    launch(0, 1);
    launch(1, 2);
    launch(2, 3);
    bf16_t* Kb = (bf16_t*)((unsigned char*)d_out + OUT_K); bf16_t* Vb = (bf16_t*)((unsigned char*)d_out + OUT_V);
    hipLaunchKernelGGL(naive_topk, dim3(M), dim3(256), 0, stream, (const bf16_t*)(ws + WS_QI), (const bf16_t*)(ws + WS_KI), (const float*)(ws + WS_WI), (unsigned long long*)(ws + WS_MASK));
    hipLaunchKernelGGL(naive_attn, dim3(M), dim3(256), 0, stream, (const bf16_t*)(ws + WS_Q), (const bf16_t*)Kb, (const bf16_t*)Vb, (const bf16_t*)(ws + WS_SZA),
                       (const unsigned long long*)(ws + WS_MASK), (const float*)d_in[9], (bf16_t*)(ws + WS_Y));
    hipLaunchKernelGGL(naive_mlstm, dim3(BATCH * HM), dim3(512), NAIVE_MLSTM_LDS, stream, (const bf16_t*)(ws + WS_QKM), (const bf16_t*)(ws + WS_VM), (const bf16_t*)(ws + WS_GM), (const float*)(ws + WS_IFG),
                       (const float*)d_in[10], (const float*)d_in[11], (const float*)d_in[2], (const float*)d_in[3], (const float*)d_in[12],
                       (float*)(ws + WS_DBG), (float*)(ws + WS_DBG + 4 * MiB), (bf16_t*)(ws + WS_Y));
    launch(4, 5);
    launch(5, 6);
}
```

```cpp
#include <hip/hip_runtime.h>
#include <cstdio>
#include <cstdint>

#define LAS __attribute__((address_space(3)))
#define GAS __attribute__((address_space(1)))
typedef unsigned short bf16_t;
typedef short bf16x8 __attribute__((ext_vector_type(8)));
typedef float f32x4 __attribute__((ext_vector_type(4)));
typedef float f32x2 __attribute__((ext_vector_type(2)));
typedef unsigned u32x4 __attribute__((ext_vector_type(4)));
typedef unsigned u32x2 __attribute__((ext_vector_type(2)));

constexpr int BATCH = 8, SEQ = 2048, DM = 2048, M = BATCH * SEQ;
constexpr int NCOLS = 7512, NP = 7680;
constexpr int HA = 8, DHA = 128, DC = 256, HIDX = 16, DIDX = 64, NSEL = 256;
constexpr int HM = 4, DVM = 256, DKM = 128, CHUNK = 64, NCHUNK = SEQ / CHUNK;
constexpr float LN_EPS = 1e-5f;
constexpr float ALPHA = 1.189207115002721f;
constexpr float LOG2E = 1.4426950408889634f;
constexpr float QSCALE = 0.08838834764831845f * LOG2E;
constexpr int O_QA = 0, O_CKV = 1024, O_ZA = 1280, O_QI = 2304, O_KI = 3328, O_WI = 3392, O_QM = 3408, O_KM = 3920, O_VM = 4432, O_IM = 5456, O_FM = 5460, O_OM = 5464, O_ZM = 6488;
__host__ __device__ __forceinline__ int win_src(int np) {
    const int t = np >> 8, lc = np & 255;
    if (t < 4) return O_QA + np;
    if (t == 4) return O_CKV + lc;
    if (t < 9) return O_ZA + (np - 5 * 256);
    if (t < 13) return O_QI + (np - 9 * 256);
    if (t == 13) {
        if (lc < 32) return O_KI + lc;
        if (lc >= 128 && lc < 160) return O_KI + 32 + (lc - 128);
        if (lc >= 32 && lc < 48) return O_WI + (lc - 32);
        if (lc >= 48 && lc < 52) return O_IM + (lc - 48);
        if (lc >= 52 && lc < 56) return O_FM + (lc - 52);
        return -1;
    }
    if (t < 16) return O_QM + (np - 14 * 256);
    if (t < 18) return O_KM + (np - 16 * 256);
    if (t < 22) return O_VM + (np - 18 * 256);
    { const int j = t - 22; return lc < 128 ? O_OM + 128 * j + lc : O_ZM + 128 * j + (lc - 128); }
}

constexpr size_t MiB = 1u << 20;
constexpr size_t WS_CTL = 0, CTL_ZERO_BYTES = 1 * MiB;
constexpr size_t WS_XB = 1 * MiB;
constexpr size_t WS_Y = WS_XB;
constexpr size_t WS_WINT = 65 * MiB;
constexpr size_t WS_WOUTT = 95 * MiB;
constexpr size_t WS_WKVT = 103 * MiB;
constexpr size_t WS_Q = 104 * MiB;
constexpr size_t WS_C = 136 * MiB;
constexpr size_t WS_SZA = 144 * MiB;
constexpr size_t WS_QI = 176 * MiB;
constexpr size_t WS_KI = 208 * MiB;
constexpr size_t WS_WI = 210 * MiB;
constexpr size_t WS_IFG = 211 * MiB;
constexpr size_t WS_QKM = 212 * MiB;
constexpr size_t WS_VM = 244 * MiB;
constexpr size_t WS_GM = 276 * MiB;
constexpr size_t WS_MASK = 308 * MiB;
constexpr size_t WS_PAR = 312 * MiB;
constexpr int P_KVG = 0, P_LNG = 256, P_LNB = 320, P_RB = 384, P_CW = 640, P_CB = 4736, P_MHG = 5760, P_BI = 6784, P_BF = 6788, P_LG = 6800, P_LB = 8848, P_TOTAL = 10896;
constexpr size_t WS_NST = 313 * MiB;
constexpr size_t WS_DBG = 316 * MiB;
constexpr size_t WS_END = 324 * MiB;
constexpr size_t OUT_K = 64 * MiB, OUT_V = 96 * MiB;

__device__ __forceinline__ int lane_id_() { return (int)__builtin_amdgcn_mbcnt_hi(~0u, __builtin_amdgcn_mbcnt_lo(~0u, 0u)); }
namespace pg8 {
constexpr int BM = 256, BK = 64, HALF = 128, HTB = HALF * BK * 2, STAGE_BYTES = 8 * HTB, NXCD = 8, WGM = 8;
__host__ __device__ __forceinline__ int lds_byte(int r, int c) { const int st = (r >> 4) * 2 + (c >> 5), rr = r & 15, cc = c & 31, ob = rr * 64 + cc * 2; return st * 1024 + (ob ^ (((ob >> 9) & 1) << 5)); }
__host__ __device__ __forceinline__ void stage_rc(int b, int& R, int& C) { const int st = b / 1024, sb = b % 1024, swz = sb ^ (((sb >> 9) & 1) << 5); R = (st >> 1) * 16 + swz / 64; C = (st & 1) * 32 + (swz % 64) / 2; }
__host__ __device__ __forceinline__ int perm32(int rho) { const int n = rho >> 4, i = rho & 15; return 8 * (i >> 2) + 4 * n + (i & 3); }
struct Unit { int pm, pn; };
struct Gemm { const bf16_t* A; const bf16_t* Bt; int M, N, K; };
struct StaticOrder {
    int nM, nN, nwg, G, c;
    __host__ __device__ void init(int M_, int N_, int G_, int c_) { nM = M_ / BM; nN = N_ / BM; nwg = nM * nN; G = G_; c = c_; }
    __host__ __device__ bool next(int i, Unit& u) const {
        const long L = (long)i * G + c; if (L >= nwg) return false;
        int wgid = (int)L; { const int q = nwg / NXCD, r = nwg % NXCD, xcd = wgid % NXCD, off = wgid / NXCD; wgid = (xcd < r ? xcd * (q + 1) : r * (q + 1) + (xcd - r) * q) + off; }
        const int nig = WGM * nN, gid = wgid / nig, fm = gid * WGM, gsz = (nM - fm) < WGM ? (nM - fm) : WGM;
        u.pm = fm + ((wgid % nig) % gsz); u.pn = (wgid % nig) / gsz; return true;
    }
};
typedef float f32x2_t_ __attribute__((ext_vector_type(2))); typedef __bf16 bf16x2_t_ __attribute__((ext_vector_type(2)));
__device__ __forceinline__ unsigned cvt_pk_bf16(float lo, float hi) { f32x2_t_ v = {lo, hi}; bf16x2_t_ b = __builtin_convertvector(v, bf16x2_t_); return __builtin_bit_cast(unsigned, b); }

template <class Epi, class Sched, bool ALIGN_EPI = true, bool SP2 = true>
__device__ __forceinline__ void gemm_phase(LAS unsigned char* lds, const Gemm g, const Sched& S, const Epi& E, int wave_) {
    int tid = wave_ * 64 + lane_id_(); asm volatile("" : "+v"(tid));
    const int wid = __builtin_amdgcn_readfirstlane(tid >> 6), lane = tid & 63, wr = wid >> 2, wc = wid & 3, fr = lane & 15, fq = lane >> 4;
    const int K = g.K, nt = K / BK;
    unsigned voffA[2], voffB[2];
#pragma unroll
    for (int i = 0; i < 2; ++i) { int R, C; stage_rc(tid * 16 + i * 8192, R, C); const int Rb = Epi::PERM ? ((R & ~31) + perm32(R & 31)) : R;
        voffA[i] = (unsigned)(R * K + C) * 2u; voffB[i] = (unsigned)(Rb * K + C) * 2u; }
    const size_t kstep = (size_t)(BK * 2);
    const size_t hstep = (size_t)HALF * K * 2;
    const size_t tstep = 2 * hstep;
    const unsigned ldsw = (unsigned)wid * 1024u;
    const int aoff = lds_byte(wr * 64 + fr, fq * 8), boff = lds_byte(wc * 32 + fr, fq * 8);
#define PG8_SA(b, h) (((b) * 2 + (h)) * HTB)
#define PG8_SB(b, h) ((4 + (b) * 2 + (h)) * HTB)
#define PG8_STAGE(bufoff, gbase, voff) do { _Pragma("unroll") for (int _i = 0; _i < 2; ++_i) \
        __builtin_amdgcn_global_load_lds((const unsigned*)((const char*)(gbase) + (voff)[_i]), (LAS unsigned*)(lds + (bufoff) + ldsw + _i * 8192), 16, 0, 0); } while (0)
#define PG8_LDA(dst, b, h) do { _Pragma("unroll") for (int m = 0; m < 4; ++m) _Pragma("unroll") for (int k = 0; k < 2; ++k) dst[m][k] = *(const LAS bf16x8*)(lds + PG8_SA(b, h) + aoff + m * 2048 + k * 1024); } while (0)
#define PG8_LDB(dst, b, h) do { _Pragma("unroll") for (int n = 0; n < 2; ++n) _Pragma("unroll") for (int k = 0; k < 2; ++k) dst[n][k] = *(const LAS bf16x8*)(lds + PG8_SB(b, h) + boff + n * 2048 + k * 1024); } while (0)
#define PG8_MMA(ai, bj, At, Bt) do { __builtin_amdgcn_s_setprio(1); _Pragma("unroll") for (int m = 0; m < 4; ++m) _Pragma("unroll") for (int n = 0; n < 2; ++n) _Pragma("unroll") for (int k = 0; k < 2; ++k) \
        acc[ai][bj][m][n] = __builtin_amdgcn_mfma_f32_16x16x32_bf16(Bt[n][k], At[m][k], acc[ai][bj][m][n], 0, 0, 0); __builtin_amdgcn_s_setprio(0); } while (0)
#define PG8_WAIT_V(n) asm volatile("s_waitcnt vmcnt(" #n ")" ::: "memory")
#define PG8_WAIT_L(n) asm volatile("s_waitcnt lgkmcnt(" #n ")" ::: "memory")
#define PG8_BAR __builtin_amdgcn_s_barrier()
#define PG8_SCHED __builtin_amdgcn_sched_barrier(0)
    Unit cur, nxt; int ui = 0;
    if (!S.next(0, cur)) return;
    f32x4 acc[2][2][4][2];
#pragma unroll
    for (int a = 0; a < 2; ++a)
#pragma unroll
        for (int b = 0; b < 2; ++b)
#pragma unroll
            for (int m = 0; m < 4; ++m)
#pragma unroll
                for (int n = 0; n < 2; ++n) acc[a][b][m][n] = (f32x4){0.f, 0.f, 0.f, 0.f};
    bf16x8 At[4][2], B0[2][2], B1[2][2];
    const char* cA = (const char*)g.A + (size_t)cur.pm * tstep; const char* cB = (const char*)g.Bt + (size_t)cur.pn * tstep;
    if constexpr (SP2) {
        PG8_STAGE(PG8_SB(0, 0), cB, voffB); PG8_STAGE(PG8_SB(0, 1), cB + hstep, voffB); PG8_STAGE(PG8_SA(0, 0), cA, voffA); PG8_STAGE(PG8_SA(0, 1), cA + hstep, voffA);
        if (wr == 1) PG8_BAR;
        PG8_WAIT_V(2); PG8_BAR;
        PG8_STAGE(PG8_SB(1, 0), cB + kstep, voffB); PG8_STAGE(PG8_SA(1, 0), cA + kstep, voffA); PG8_STAGE(PG8_SB(1, 1), cB + hstep + kstep, voffB);
        PG8_WAIT_V(6); PG8_BAR;
    } else {
        PG8_STAGE(PG8_SB(0, 0), cB, voffB); PG8_STAGE(PG8_SA(0, 0), cA, voffA); PG8_STAGE(PG8_SB(0, 1), cB + hstep, voffB); PG8_STAGE(PG8_SA(0, 1), cA + hstep, voffA);
        if (wr == 1) PG8_BAR;
        PG8_WAIT_V(4); PG8_BAR;
        PG8_STAGE(PG8_SB(1, 0), cB + kstep, voffB); PG8_STAGE(PG8_SA(1, 0), cA + kstep, voffA); PG8_STAGE(PG8_SB(1, 1), cB + hstep + kstep, voffB);
        PG8_WAIT_V(6); PG8_BAR;
    }
    for (;;) {
        const bool has_next = S.next(ui + 1, nxt);
        const char* nA = has_next ? (const char*)g.A + (size_t)nxt.pm * tstep : cA; const char* nB = has_next ? (const char*)g.Bt + (size_t)nxt.pn * tstep : cB;
#pragma unroll 1
        for (int t = 0; t < nt; t += 2) {
            const bool last = (t == nt - 2);
            const char* a1 = cA + (size_t)(t + 1) * kstep;
            const char* a2 = last ? nA : cA + (size_t)(t + 2) * kstep; const char* b2 = last ? nB : cB + (size_t)(t + 2) * kstep;
            const char* a3 = a2 + kstep; const char* b3 = b2 + kstep;
            if constexpr (SP2) {
            PG8_LDB(B0, 0, 0); PG8_LDB(B1, 0, 1); PG8_SCHED; PG8_LDA(At, 0, 0); PG8_STAGE(PG8_SA(1, 1), a1 + hstep, voffA);
            PG8_WAIT_V(8); PG8_WAIT_L(0); PG8_BAR; PG8_MMA(0, 0, At, B0); PG8_MMA(0, 1, At, B1); PG8_BAR; PG8_SCHED;
            PG8_LDA(At, 0, 1); PG8_STAGE(PG8_SB(0, 0), b2, voffB); PG8_STAGE(PG8_SB(0, 1), b2 + hstep, voffB); PG8_STAGE(PG8_SA(0, 0), a2, voffA);
            PG8_WAIT_V(8); PG8_WAIT_L(0); PG8_BAR; PG8_MMA(1, 0, At, B0); PG8_MMA(1, 1, At, B1); PG8_BAR; PG8_SCHED;
            PG8_LDB(B0, 1, 0); PG8_LDB(B1, 1, 1); PG8_SCHED; PG8_LDA(At, 1, 0); PG8_STAGE(PG8_SA(0, 1), a2 + hstep, voffA);
            PG8_WAIT_V(8); PG8_WAIT_L(0); PG8_BAR; PG8_MMA(0, 0, At, B0); PG8_MMA(0, 1, At, B1); PG8_BAR; PG8_SCHED;
            PG8_LDA(At, 1, 1); PG8_STAGE(PG8_SB(1, 0), b3, voffB); PG8_STAGE(PG8_SB(1, 1), b3 + hstep, voffB); PG8_STAGE(PG8_SA(1, 0), a3, voffA);
            PG8_WAIT_V(8); PG8_WAIT_L(0); PG8_BAR; PG8_MMA(1, 0, At, B0); PG8_MMA(1, 1, At, B1); PG8_BAR; PG8_SCHED;
            } else {
            PG8_LDB(B0, 0, 0); PG8_SCHED; PG8_LDA(At, 0, 0); PG8_STAGE(PG8_SA(1, 1), a1 + hstep, voffA);
            PG8_WAIT_L(8); PG8_BAR; PG8_WAIT_L(0); PG8_MMA(0, 0, At, B0); PG8_BAR; PG8_SCHED;
            PG8_LDB(B1, 0, 1); PG8_STAGE(PG8_SB(0, 0), b2, voffB);
            PG8_BAR; PG8_WAIT_L(0); PG8_MMA(0, 1, At, B1); PG8_BAR;
            PG8_LDA(At, 0, 1); PG8_STAGE(PG8_SA(0, 0), a2, voffA);
            PG8_BAR; PG8_WAIT_L(0); PG8_MMA(1, 0, At, B0); PG8_BAR; PG8_SCHED;
            PG8_STAGE(PG8_SB(0, 1), b2 + hstep, voffB);
            PG8_WAIT_V(6); PG8_BAR; PG8_MMA(1, 1, At, B1); PG8_BAR;
            PG8_LDB(B0, 1, 0); PG8_SCHED; PG8_LDA(At, 1, 0); PG8_STAGE(PG8_SA(0, 1), a2 + hstep, voffA);
            PG8_WAIT_L(8); PG8_BAR; PG8_WAIT_L(0); PG8_MMA(0, 0, At, B0); PG8_BAR; PG8_SCHED;
            PG8_LDB(B1, 1, 1); PG8_STAGE(PG8_SB(1, 0), b3, voffB);
            PG8_BAR; PG8_WAIT_L(0); PG8_MMA(0, 1, At, B1); PG8_BAR;
            PG8_LDA(At, 1, 1); PG8_STAGE(PG8_SA(1, 0), a3, voffA);
            PG8_BAR; PG8_WAIT_L(0); PG8_MMA(1, 0, At, B0); PG8_BAR; PG8_SCHED;
            PG8_STAGE(PG8_SB(1, 1), b3 + hstep, voffB);
            PG8_WAIT_V(6); PG8_BAR; PG8_MMA(1, 1, At, B1); PG8_BAR;
            }
        }
        if constexpr (ALIGN_EPI) { if (wr == 0) PG8_BAR; }
        E(acc, cur, wr, wc, fr, fq, lds + STAGE_BYTES);
        if (!has_next) break;
#pragma unroll
        for (int a = 0; a < 2; ++a)
#pragma unroll
            for (int b = 0; b < 2; ++b)
#pragma unroll
                for (int m = 0; m < 4; ++m)
#pragma unroll
                    for (int n = 0; n < 2; ++n) acc[a][b][m][n] = (f32x4){0.f, 0.f, 0.f, 0.f};
        cur = nxt; cA = nA; cB = nB; ++ui;
        if constexpr (ALIGN_EPI) { if (wr == 1) PG8_BAR; }
    }
    PG8_WAIT_V(0);
    if constexpr (!ALIGN_EPI) { if (wr == 0) PG8_BAR; }
    PG8_BAR;
    asm volatile("" ::: "memory");
#undef PG8_SA
#undef PG8_SB
#undef PG8_STAGE
#undef PG8_LDA
#undef PG8_LDB
#undef PG8_MMA
#undef PG8_WAIT_V
#undef PG8_WAIT_L
#undef PG8_BAR
#undef PG8_SCHED
}
}

__device__ __forceinline__ int lane_id() { return (int)__builtin_amdgcn_mbcnt_hi(~0u, __builtin_amdgcn_mbcnt_lo(~0u, 0u)); }
__device__ __forceinline__ float sigmoid_f(float v) { return __builtin_amdgcn_rcpf(1.f + __expf(-v)); }
__device__ __forceinline__ float silu_f(float v) { return v * sigmoid_f(v); }
__device__ __forceinline__ unsigned f2bf(float f) { unsigned u = __builtin_bit_cast(unsigned, f); return (u + 0x7fffu + ((u >> 16) & 1u)) >> 16; }
__device__ __forceinline__ unsigned pk2(float lo, float hi) { return f2bf(lo) | (f2bf(hi) << 16); }
__device__ __forceinline__ float bf2f(bf16_t b) { return __builtin_bit_cast(float, ((unsigned)b) << 16); }
__device__ __forceinline__ int t5_bucket(int n) {
    if (n < 16) return n;
    const int l = 16 + (int)(logf((float)n * (1.f / 16.f)) * (16.f / 2.0794415416798357f));
    return l < 31 ? l : 31;
}
__device__ __forceinline__ float log_sigmoid_f(float x) { return fminf(x, 0.f) - log1pf(expf(-fabsf(x))); }

using pg8::Unit; using pg8::cvt_pk_bf16;
template <int ACT  > __device__ __forceinline__ void store_tile_bf16(const f32x4 (&acc)[2][2][4][2], bf16_t* base, int ld, float sc, int wr, int wc, int fr, int fq) {
    bf16_t* p0 = base + (size_t)(wr * 64 + fr) * ld + wc * 32 + 8 * fq;
#pragma unroll
    for (int ai = 0; ai < 2; ++ai)
#pragma unroll
        for (int m = 0; m < 4; ++m) { bf16_t* rowp = p0 + (size_t)(ai * 128 + m * 16) * ld;
#pragma unroll
            for (int bj = 0; bj < 2; ++bj) { f32x4 v0 = acc[ai][bj][m][0], v1 = acc[ai][bj][m][1];
                if (ACT == 1) {
#pragma unroll
                    for (int j = 0; j < 4; ++j) { v0[j] = silu_f(v0[j]); v1[j] = silu_f(v1[j]); } }
                else { v0 = v0 * sc; v1 = v1 * sc; }
                u32x4 w; w.x = cvt_pk_bf16(v0[0], v0[1]); w.y = cvt_pk_bf16(v0[2], v0[3]); w.z = cvt_pk_bf16(v1[0], v1[1]); w.w = cvt_pk_bf16(v1[2], v1[3]);
                *(u32x4*)(rowp + bj * 128) = w; } }
}

struct Epi1 {
    static constexpr bool PERM = true;
    unsigned char* ws;
    __device__ __forceinline__ void operator()(const f32x4 (&acc)[2][2][4][2], const Unit& u, int wr, int wc, int fr, int fq, LAS unsigned char* xl) const {
        { int l_ = lane_id(); asm volatile("" : "+v"(l_)); fr = l_ & 15; fq = (l_ >> 4) & 3; }
        const int pn = u.pn; const size_t r0 = (size_t)u.pm * 256;
        bf16_t* const Q = (bf16_t*)(ws + WS_Q); bf16_t* const C = (bf16_t*)(ws + WS_C); bf16_t* const SZA = (bf16_t*)(ws + WS_SZA); bf16_t* const QI = (bf16_t*)(ws + WS_QI);
        bf16_t* const KI = (bf16_t*)(ws + WS_KI); bf16_t* const QKM = (bf16_t*)(ws + WS_QKM); bf16_t* const VM = (bf16_t*)(ws + WS_VM); bf16_t* const GM = (bf16_t*)(ws + WS_GM);
        float* const WI = (float*)(ws + WS_WI); float* const IFG = (float*)(ws + WS_IFG);
        const float* const kvg = (const float*)(ws + WS_PAR) + P_KVG; const float* const lng = (const float*)(ws + WS_PAR) + P_LNG; const float* const lnb = (const float*)(ws + WS_PAR) + P_LNB;
        if (pn < 4) { store_tile_bf16<0>(acc, Q + r0 * 1024 + pn * 256, 1024, QSCALE, wr, wc, fr, fq); return; }
        if (pn == 4) {
            LAS float* P = (LAS float*)xl;
#pragma unroll
            for (int ai = 0; ai < 2; ++ai)
#pragma unroll
                for (int m = 0; m < 4; ++m) { float s = 0.f;
#pragma unroll
                    for (int bj = 0; bj < 2; ++bj)
#pragma unroll
                        for (int n = 0; n < 2; ++n) { const f32x4 x = acc[ai][bj][m][n]; s += (x[0] * x[0] + x[1] * x[1]) + (x[2] * x[2] + x[3] * x[3]); }
                    s += __shfl_xor(s, 16); s += __shfl_xor(s, 32);
                    if (fq == 0) P[(ai * 128 + wr * 64 + m * 16 + fr) * 4 + wc] = s; }
            asm volatile("s_waitcnt lgkmcnt(0)" ::: "memory"); __builtin_amdgcn_s_barrier(); asm volatile("" ::: "memory");
            const int c0 = wc * 32 + 8 * fq;
            f32x4 g[2][2];
#pragma unroll
            for (int bj = 0; bj < 2; ++bj) { g[bj][0] = *(const f32x4*)(kvg + bj * 128 + c0); g[bj][1] = *(const f32x4*)(kvg + bj * 128 + c0 + 4); }
#pragma unroll
            for (int ai = 0; ai < 2; ++ai)
#pragma unroll
                for (int m = 0; m < 4; ++m) { const int r = ai * 128 + wr * 64 + m * 16 + fr;
                    const f32x4 pp = *(const LAS f32x4*)(P + r * 4);
                    const float rstd = rsqrtf(((pp[0] + pp[1]) + (pp[2] + pp[3])) * (1.f / 256.f) + LN_EPS);
                    bf16_t* rowp = C + (r0 + r) * 256 + c0;
#pragma unroll
                    for (int bj = 0; bj < 2; ++bj) { const f32x4 v0 = acc[ai][bj][m][0] * rstd * g[bj][0], v1 = acc[ai][bj][m][1] * rstd * g[bj][1];
                        u32x4 w; w.x = cvt_pk_bf16(v0[0], v0[1]); w.y = cvt_pk_bf16(v0[2], v0[3]); w.z = cvt_pk_bf16(v1[0], v1[1]); w.w = cvt_pk_bf16(v1[2], v1[3]);
                        *(u32x4*)(rowp + bj * 128) = w; } }
            asm volatile("s_waitcnt lgkmcnt(0)" ::: "memory"); __builtin_amdgcn_s_barrier(); asm volatile("" ::: "memory");
            return;
        }
        if (pn < 9) { store_tile_bf16<1>(acc, SZA + r0 * 1024 + (pn - 5) * 256, 1024, 1.f, wr, wc, fr, fq); return; }
        if (pn < 13) { store_tile_bf16<0>(acc, QI + r0 * 1024 + (pn - 9) * 256, 1024, 0.125f, wr, wc, fr, fq); return; }
        if (pn == 13) {
            if (wc == 0) {
                f32x4 g[2][2], bb[2][2];
#pragma unroll
                for (int bj = 0; bj < 2; ++bj)
#pragma unroll
                    for (int n = 0; n < 2; ++n) { g[bj][n] = *(const f32x4*)(lng + 32 * bj + 8 * fq + 4 * n); bb[bj][n] = *(const f32x4*)(lnb + 32 * bj + 8 * fq + 4 * n); }
#pragma unroll
                for (int ai = 0; ai < 2; ++ai)
#pragma unroll
                    for (int m = 0; m < 4; ++m) { float s = 0.f;
#pragma unroll
                        for (int bj = 0; bj < 2; ++bj)
#pragma unroll
                            for (int n = 0; n < 2; ++n) { const f32x4 x = acc[ai][bj][m][n]; s += (x[0] + x[1]) + (x[2] + x[3]); }
                        s += __shfl_xor(s, 16); s += __shfl_xor(s, 32);
                        const float mu = s * (1.f / 64.f); float q = 0.f;
#pragma unroll
                        for (int bj = 0; bj < 2; ++bj)
#pragma unroll
                            for (int n = 0; n < 2; ++n) { const f32x4 d = acc[ai][bj][m][n] - mu; q += (d[0] * d[0] + d[1] * d[1]) + (d[2] * d[2] + d[3] * d[3]); }
                        q += __shfl_xor(q, 16); q += __shfl_xor(q, 32);
                        const float rstd = rsqrtf(q * (1.f / 64.f) + LN_EPS);
                        bf16_t* rowp = KI + (r0 + ai * 128 + wr * 64 + m * 16 + fr) * 64 + 8 * fq;
#pragma unroll
                        for (int bj = 0; bj < 2; ++bj) { const f32x4 v0 = (acc[ai][bj][m][0] - mu) * rstd * g[bj][0] + bb[bj][0], v1 = (acc[ai][bj][m][1] - mu) * rstd * g[bj][1] + bb[bj][1];
                            u32x4 w; w.x = cvt_pk_bf16(v0[0], v0[1]); w.y = cvt_pk_bf16(v0[2], v0[3]); w.z = cvt_pk_bf16(v1[0], v1[1]); w.w = cvt_pk_bf16(v1[2], v1[3]);
                            *(u32x4*)(rowp + bj * 32) = w; } }
            } else if (wc == 1) {
#pragma unroll
                for (int ai = 0; ai < 2; ++ai)
#pragma unroll
                    for (int m = 0; m < 4; ++m) { const size_t r = r0 + ai * 128 + wr * 64 + m * 16 + fr;
                        if (fq < 2) { *(f32x4*)(WI + r * 16 + 8 * fq) = acc[ai][0][m][0] * 0.25f; *(f32x4*)(WI + r * 16 + 8 * fq + 4) = acc[ai][0][m][1] * 0.25f; }
                        else if (fq == 2) { *(f32x4*)(IFG + r * 8) = acc[ai][0][m][0]; *(f32x4*)(IFG + r * 8 + 4) = acc[ai][0][m][1]; } }
            }
            return;
        }
        if (pn < 18) { store_tile_bf16<0>(acc, QKM + r0 * 1024 + (pn - 14) * 256, 1024, 1.f, wr, wc, fr, fq); return; }
        if (pn < 22) { store_tile_bf16<0>(acc, VM + r0 * 1024 + (pn - 18) * 256, 1024, 1.f, wr, wc, fr, fq); return; }
        {
            bf16_t* p0 = GM + (r0 + wr * 64 + fr) * 1024 + (pn - 22) * 128 + wc * 32 + 8 * fq;
#pragma unroll
            for (int ai = 0; ai < 2; ++ai)
#pragma unroll
                for (int m = 0; m < 4; ++m) { f32x4 v0, v1;
#pragma unroll
                    for (int j = 0; j < 4; ++j) { v0[j] = sigmoid_f(acc[ai][0][m][0][j]) * silu_f(acc[ai][1][m][0][j]); v1[j] = sigmoid_f(acc[ai][0][m][1][j]) * silu_f(acc[ai][1][m][1][j]); }
                    u32x4 w; w.x = cvt_pk_bf16(v0[0], v0[1]); w.y = cvt_pk_bf16(v0[2], v0[3]); w.z = cvt_pk_bf16(v1[0], v1[1]); w.w = cvt_pk_bf16(v1[2], v1[3]);
                    *(u32x4*)(p0 + (size_t)(ai * 128 + m * 16) * 1024) = w; }
        }
    }
};
struct EpiKV {
    static constexpr bool PERM = true;
    bf16_t *Kb, *Vb;
    __device__ __forceinline__ void operator()(const f32x4 (&acc)[2][2][4][2], const Unit& u, int wr, int wc, int fr, int fq, LAS unsigned char*) const {
        { int l_ = lane_id(); asm volatile("" : "+v"(l_)); fr = l_ & 15; fq = (l_ >> 4) & 3; }
        bf16_t* base = (u.pn < 4 ? Kb + u.pn * 256 : Vb + (u.pn - 4) * 256) + (size_t)u.pm * 256 * 1024;
        store_tile_bf16<0>(acc, base, 1024, 1.f, wr, wc, fr, fq);
    }
};
struct EpiOut {
    static constexpr bool PERM = false;
    const float* x; float* out;
    __device__ __forceinline__ void operator()(const f32x4 (&acc)[2][2][4][2], const Unit& u, int wr, int wc, int fr, int fq, LAS unsigned char*) const {
        { int l_ = lane_id(); asm volatile("" : "+v"(l_)); fr = l_ & 15; fq = (l_ >> 4) & 3; }
        const size_t off0 = ((size_t)u.pm * 256 + wr * 64 + fr) * DM + u.pn * 256 + wc * 32 + 4 * fq;
#pragma unroll
        for (int ai = 0; ai < 2; ++ai)
#pragma unroll
            for (int m = 0; m < 4; ++m) { const size_t off = off0 + (size_t)(ai * 128 + m * 16) * DM;
#pragma unroll
                for (int bj = 0; bj < 2; ++bj)
#pragma unroll
                    for (int n = 0; n < 2; ++n) { const f32x4 xv = *(const f32x4*)(x + off + bj * 128 + n * 16);
                        *(f32x4*)(out + off + bj * 128 + n * 16) = xv * ALPHA + acc[ai][bj][m][n]; } }
    }
};


#define XB_TMO      128
#define XB_XCNT(j)  (256  + 64 * (j))
#define XB_XSUB(j)  (1280 + 64 * (j))
#define XB_XGEN(j)  (2304 + 64 * (j))
#define XB_TOP      3328
#define XB_TOPGEN   3392
#define XCD_BAR_WORDS 3456
#define XB_SPIN_CAP (1u << 18)
__device__ __forceinline__ unsigned xb_ld(unsigned* p)              { return __hip_atomic_load(p, __ATOMIC_RELAXED, __HIP_MEMORY_SCOPE_AGENT); }
__device__ __forceinline__ unsigned xb_add(unsigned* p, unsigned v) { return __hip_atomic_fetch_add(p, v, __ATOMIC_RELAXED, __HIP_MEMORY_SCOPE_AGENT); }
__device__ __forceinline__ unsigned xb_xcc_id() { return (unsigned)__builtin_amdgcn_s_getreg((3 << 11) | 20) & 0xFu; }
#define XB_SPIN(cond, bar) do { unsigned _sp = 0; while (cond) { __builtin_amdgcn_s_sleep(1); \
    if ((++_sp & 255u) == 0u) { if (xb_ld(&(bar)[XB_TMO])) break; if (_sp > XB_SPIN_CAP) { atomicAdd(&(bar)[XB_TMO], 1u); break; } } } } while (0)
struct XcdBarrier { unsigned* bar; unsigned x; volatile LAS unsigned* st; };
__device__ __forceinline__ XcdBarrier xcd_barrier_post(unsigned* bar, volatile LAS unsigned* st) {
    XcdBarrier b; b.bar = bar; b.x = xb_xcc_id(); b.st = st;
    if (threadIdx.x == 0) (void)xb_add(&bar[XB_XCNT(b.x)], 1u);
    return b;
}
__device__ __forceinline__ void xcd_barrier_complete(unsigned* bar, unsigned x, unsigned& nloc, unsigned& nx) {
    const unsigned G = gridDim.x * gridDim.y * gridDim.z;
    unsigned sum, cnt, mine, sp = 0u;
    for (;;) {
        sum = 0u; cnt = 0u; mine = 0u;
#pragma unroll
        for (unsigned j = 0; j < 16; ++j) { const unsigned c = xb_ld(&bar[XB_XCNT(j)]); sum += c; cnt += (c > 0u) ? 1u : 0u; mine = (j == x) ? c : mine; }
        if (sum == G) break;
        __builtin_amdgcn_s_sleep(1);
        if ((++sp & 255u) == 0u) { if (xb_ld(&bar[XB_TMO])) break; if (sp > XB_SPIN_CAP) { atomicAdd(&bar[XB_TMO], 1u); break; } }
    }
    nloc = mine > 0u ? mine : 1u; nx = cnt > 0u ? cnt : 1u;
}
__device__ __forceinline__ void xcd_barrier(const XcdBarrier& b, int wave_) {
    asm volatile("s_waitcnt vmcnt(0)" ::: "memory");
    __syncthreads();
    if (wave_ == 0 && lane_id() == 0) {
        unsigned* bar = b.bar;
        __builtin_amdgcn_s_waitcnt(0);
        unsigned nloc = b.st[0], nx = b.st[1];
        if (nloc == 0u) { xcd_barrier_complete(bar, b.x, nloc, nx); b.st[0] = nloc; b.st[1] = nx; }
        const unsigned old = xb_add(&bar[XB_XSUB(b.x)], 1u);
        const unsigned gen = old / nloc;
        if (old + 1u == (gen + 1u) * nloc) {
            __builtin_amdgcn_fence(__ATOMIC_RELEASE, "agent");
            asm volatile("s_waitcnt vmcnt(0)" ::: "memory");
            const unsigned og = xb_add(&bar[XB_TOP], 1u);
            const unsigned tg = og / nx;
            if (og + 1u == (tg + 1u) * nx) xb_add(&bar[XB_TOPGEN], 1u);
            else XB_SPIN(xb_ld(&bar[XB_TOPGEN]) == tg, bar);
            __builtin_amdgcn_fence(__ATOMIC_ACQUIRE, "agent");
            xb_add(&bar[XB_XGEN(b.x)], 1u);
            asm volatile("s_waitcnt vmcnt(0)" ::: "memory");
        } else {
            XB_SPIN(xb_ld(&bar[XB_XGEN(b.x)]) == gen, bar);
            __builtin_amdgcn_fence(__ATOMIC_ACQUIRE, "agent");
            asm volatile("s_waitcnt vmcnt(0)" ::: "memory");
        }
    }
    __syncthreads();
}

typedef float f32x16 __attribute__((ext_vector_type(16)));
__device__ __forceinline__ unsigned mono_key(float s) { s = s + 0.0f; const unsigned u = __builtin_bit_cast(unsigned, s); return (u & 0x80000000u) ? ~u : (u | 0x80000000u); }
__device__ __forceinline__ float swap_add(float a, float b) {
    auto rr = __builtin_amdgcn_permlane32_swap(__builtin_bit_cast(unsigned, a), __builtin_bit_cast(unsigned, b), false, false);
    return __builtin_bit_cast(float, (unsigned)rr[0]) + __builtin_bit_cast(float, (unsigned)rr[1]);
}
#define WRITELANE(dst, sval, ln) asm volatile("v_writelane_b32 %0, %1, %2" : "+v"(dst) : "s"(__builtin_amdgcn_readfirstlane((int)(sval))), "i"(ln))
__device__ __forceinline__ void select_store(const unsigned (&K)[32], int t, unsigned long long* mrow, int lane, LAS unsigned long long* wl) {
    unsigned T = 0u; bool exact = false;
    for (int bit = 31; bit >= 0; --bit) {
        const unsigned cand = T | (1u << bit);
        int cnt = 0;
#pragma unroll
        for (int g = 0; g < 32; ++g) cnt += __popcll(__ballot(K[g] >= cand));
        if (cnt >= NSEL) T = cand;
        if (cnt == NSEL) { exact = true; break; }
    }
    if (exact) {
#pragma unroll
        for (int g = 0; g < 32; ++g) { const unsigned long long w = __ballot(K[g] >= T);
            if (lane == 0) wl[g] = w; }
    } else {
        int gt = 0;
#pragma unroll
        for (int g = 0; g < 32; ++g) gt += __popcll(__ballot(K[g] > T));
        int need = NSEL - gt;
#pragma unroll
        for (int g = 0; g < 32; ++g) {
            const unsigned long long gtm = __ballot(K[g] > T); unsigned long long m = __ballot(K[g] == T);
            const int c = __popcll(m), take = c < need ? c : need;
            while (__popcll(m) > take) m &= ~(1ull << (63 - __clzll((long long)m)));
            need -= take;
            const unsigned long long w = gtm | m;
            if (lane == 0) wl[g] = w;
        }
    }
    asm volatile("s_waitcnt lgkmcnt(0)" ::: "memory");
    if (lane < 32) mrow[(size_t)lane * SEQ + t] = wl[lane];
    asm volatile("s_waitcnt lgkmcnt(0)" ::: "memory");
}
__device__ __forceinline__ void topk_unit(const bf16_t* __restrict__ QI, const bf16_t* __restrict__ KI, const float* __restrict__ WI, unsigned long long* mask, int b, int i, int wave, int lane, LAS unsigned long long* wl) {
    const int t0 = i * 16, tq = t0 + 2 * wave;
    const size_t rb = (size_t)b * SEQ;
    unsigned long long* mrow = mask + (size_t)b * 32 * SEQ;
    if (t0 + 15 < NSEL) {
        const int g = lane & 31, t = tq + (lane >> 5), n = t - 64 * g + 1;
        mrow[(size_t)g * SEQ + t] = n >= 64 ? ~0ull : (n <= 0 ? 0ull : ((1ull << n) - 1ull));
        return;
    }
    const int r = lane & 31, hi = lane >> 5;
    bf16x8 A[4];
    { const bf16_t* qp = QI + (rb + tq + (r >> 4)) * 1024 + (r & 15) * 64 + hi * 8;
#pragma unroll
      for (int ks = 0; ks < 4; ++ks) A[ks] = *(const bf16x8*)(qp + ks * 16); }
    float wv[16];
#pragma unroll
    for (int reg = 0; reg < 16; ++reg) { const int hh = (reg & 3) + 8 * ((reg >> 2) & 1) + 4 * hi; wv[reg] = WI[(rb + tq + (reg >> 3)) * 16 + hh]; }
    const int ng = (t0 + 15) / 64 + 1;
    unsigned K0[32], K1[32];
    const GAS bf16_t* kp = (const GAS bf16_t*)KI + (rb + r) * 64 + hi * 8;
#pragma unroll
    for (int g = 0; g < 32; ++g) {
        if (g < ng) {
            bf16x8 B0[4], B1[4];
            asm volatile("" : "+v"(kp));
            const GAS bf16_t* kp1 = kp + 32 * 64;
#pragma unroll
            for (int ks = 0; ks < 4; ++ks) { B0[ks] = *(const GAS bf16x8*)(kp + ks * 16); B1[ks] = *(const GAS bf16x8*)(kp1 + ks * 16); }
            kp += 64 * 64;
            f32x16 a0 = {}, a1 = {};
#pragma unroll
            for (int ks = 0; ks < 4; ++ks) { a0 = __builtin_amdgcn_mfma_f32_32x32x16_bf16(A[ks], B0[ks], a0, 0, 0, 0); a1 = __builtin_amdgcn_mfma_f32_32x32x16_bf16(A[ks], B1[ks], a1, 0, 0, 0); }
            float p00 = 0.f, p01 = 0.f, p10 = 0.f, p11 = 0.f;
#pragma unroll
            for (int reg = 0; reg < 8; ++reg) { p00 = fmaf(fmaxf(a0[reg], 0.f), wv[reg], p00); p10 = fmaf(fmaxf(a1[reg], 0.f), wv[reg], p10);
                                                p01 = fmaf(fmaxf(a0[reg + 8], 0.f), wv[reg + 8], p01); p11 = fmaf(fmaxf(a1[reg + 8], 0.f), wv[reg + 8], p11); }
            const float sA = swap_add(p00, p01), sB = swap_add(p10, p11);
            auto rr = __builtin_amdgcn_permlane32_swap(__builtin_bit_cast(unsigned, sA), __builtin_bit_cast(unsigned, sB), false, false);
            const float s0 = __builtin_bit_cast(float, (unsigned)rr[0]), s1 = __builtin_bit_cast(float, (unsigned)rr[1]);
            const int kidx = 64 * g + lane;
            K0[g] = kidx <= tq ? mono_key(s0) : 0u; K1[g] = kidx <= tq + 1 ? mono_key(s1) : 0u;
        } else { K0[g] = 0u; K1[g] = 0u; }
    }
    select_store(K0, tq, mrow, lane, wl);
    select_store(K1, tq + 1, mrow, lane, wl);
}

namespace att {
constexpr int NW = 8, QBLK = 32, KVBLK = 64, QB = NW * QBLK, D = 128, RS = 1024, OS = 2048;
constexpr int SHM_V = KVBLK * D * 2, SHM_K = KVBLK * D * 2;
constexpr int LDS_WS = 2 * SHM_V + 2 * SHM_K, LDS_LUT = LDS_WS + NW * 64 * 4, LDS_TOTAL = LDS_LUT + 512;
constexpr float THRL = 11.5f;
typedef short s16x4 __attribute__((ext_vector_type(4)));
#define KSWZ(row, colB) ((row) * 256 + ((colB) ^ (((row) & 7) << 4)))
#define SBAR() __builtin_amdgcn_sched_barrier(0)
__device__ __forceinline__ int v_st(int k, int c) { const int kk = (k & ~0xC) | ((k & 4) << 1) | ((k & 8) >> 1); return ((kk >> 3) * 4 + (c >> 5)) * 512 + ((kk & 7) * 32 + (c & 31)) * 2; }
__device__ __forceinline__ int v_rd_base(int lane) { return ((lane & 3) << 3) | (((lane >> 2) & 3) << 6) | (((lane >> 4) & 1) << 5) | (((lane >> 5) & 1) << 8); }
constexpr int v_rd_off(int d0, int ks, int half) { return d0 * 512 + ks * 4096 + half * 2048; }
__device__ __forceinline__ int crow(int r, int hi) { return (r & 3) + 8 * (r >> 2) + 4 * hi; }
__device__ __forceinline__ unsigned cvtpk(float lo, float hi) { return pg8::cvt_pk_bf16(lo, hi); }
__device__ __forceinline__ bf16x8 ld8(const bf16_t* p) { return *reinterpret_cast<const bf16x8*>(p); }
__device__ __forceinline__ void apply_mask(f32x16& p0, f32x16& p1, unsigned long long mw, int hi) {
    const unsigned a = (unsigned)mw >> (4 * hi), b = (unsigned)(mw >> 32) >> (4 * hi);
#pragma unroll
    for (int r = 0; r < 16; ++r) { const int c = (r & 3) + 8 * (r >> 2);
        p0[r] = (a & (1u << c)) ? p0[r] : -__builtin_inff();
        p1[r] = (b & (1u << c)) ? p1[r] : -__builtin_inff(); }
}
__device__ __forceinline__ void add_bias(f32x16& p0, f32x16& p1, const float* lut, int dq) {
#pragma unroll
    for (int r = 0; r < 16; ++r) { const int c = (r & 3) + 8 * (r >> 2);
        int i0 = dq - c, i1 = dq - c - 32; i0 = i0 < 0 ? 0 : (i0 > 127 ? 127 : i0); i1 = i1 < 0 ? 0 : (i1 > 127 ? 127 : i1);
        p0[r] += lut[i0]; p1[r] += lut[i1]; }
}
__device__ __forceinline__ void partialSM(f32x16& p0, f32x16& p1, float& m_reg, float& mn, float& alpha) {
    float pmax = p0[0];
#pragma unroll
    for (int r = 1; r < 16; ++r) pmax = fmaxf(pmax, p0[r]);
#pragma unroll
    for (int r = 0; r < 16; ++r) pmax = fmaxf(pmax, p1[r]);
    { auto rr = __builtin_amdgcn_permlane32_swap(__float_as_uint(pmax), __float_as_uint(pmax), false, false);
      pmax = fmaxf(__uint_as_float(rr[0]), __uint_as_float(rr[1])); }
    if (__builtin_expect(__all(pmax - m_reg <= THRL), 1)) { mn = m_reg; alpha = 1.f; }
    else { mn = fmaxf(m_reg, pmax); alpha = __builtin_amdgcn_exp2f(m_reg - mn); m_reg = mn; }
#pragma unroll
    for (int r = 0; r < 16; ++r) { p0[r] = p0[r] - mn; p1[r] = p1[r] - mn; }
#pragma unroll
    for (int r = 0; r < 16; ++r) p0[r] = __builtin_amdgcn_exp2f(p0[r]);
}
__device__ __forceinline__ void finishSM(f32x16& p0, f32x16& p1, float alpha, float& l_reg, bf16x8& pa0, bf16x8& pa1, bf16x8& pa2, bf16x8& pa3) {
#pragma unroll
    for (int r = 0; r < 16; ++r) p1[r] = __builtin_amdgcn_exp2f(p1[r]);
    float ps = 0;
#pragma unroll
    for (int r = 0; r < 16; ++r) ps += p0[r];
#pragma unroll
    for (int r = 0; r < 16; ++r) ps += p1[r];
    { auto rr = __builtin_amdgcn_permlane32_swap(__float_as_uint(ps), __float_as_uint(ps), false, false);
      ps = __uint_as_float(rr[0]) + __uint_as_float(rr[1]); }
    l_reg = l_reg * alpha + ps;
#define PK4(P, B_, OUT) do { unsigned a0 = cvtpk(P[B_+0], P[B_+1]), a1 = cvtpk(P[B_+2], P[B_+3]);                          \
        unsigned b0 = cvtpk(P[B_+4], P[B_+5]), b1 = cvtpk(P[B_+6], P[B_+7]);                                             \
        auto r0 = __builtin_amdgcn_permlane32_swap(a0, b0, false, false); auto r1 = __builtin_amdgcn_permlane32_swap(a1, b1, false, false); \
        u32x4 w = {r0[0], r1[0], r0[1], r1[1]}; OUT = *reinterpret_cast<bf16x8*>(&w); } while (0)
    PK4(p0, 0, pa0); PK4(p0, 8, pa1); PK4(p1, 0, pa2); PK4(p1, 8, pa3);
#undef PK4
}
template <int KB>
__device__ __forceinline__ void qkt(f32x16& p0, f32x16& p1, const char* K_lds, int r32, int hi, const bf16x8* qr) {
    p0 = f32x16{}; p1 = f32x16{};
    const char* kb[4];
#pragma unroll
    for (int dd = 0; dd < 4; ++dd) kb[dd] = K_lds + KB * SHM_K + KSWZ(r32, (dd * 16 + hi * 8) * 2);
#pragma unroll
    for (int d0 = 0; d0 < 8; ++d0) { const char* a = kb[d0 & 3] + (d0 >> 2) * 128;
        bf16x8 b0 = *reinterpret_cast<const bf16x8*>(a);
        bf16x8 b1 = *reinterpret_cast<const bf16x8*>(a + 32 * 256);
        p0 = __builtin_amdgcn_mfma_f32_32x32x16_bf16(b0, qr[d0], p0, 0, 0, 0);
        p1 = __builtin_amdgcn_mfma_f32_32x32x16_bf16(b1, qr[d0], p1, 0, 0, 0); }
}
template <int VB>
__device__ __forceinline__ void pv_tile(f32x16* o, int vb0, bf16x8 pa0, bf16x8 pa1, bf16x8 pa2, bf16x8 pa3) {
#define TRRD(dst, off) asm volatile("ds_read_b64_tr_b16 %0, %1 offset:%2" : "=&v"(dst) : "v"(vb0), "i"(off) : "memory")
#define PV_D0(d0) do { s16x4 l0, l1, l2, l3, h0, h1, h2, h3; constexpr int b_ = VB * SHM_V + v_rd_off(d0, 0, 0); \
        TRRD(l0, b_); TRRD(h0, b_ + 2048); TRRD(l1, b_ + 4096); TRRD(h1, b_ + 6144); TRRD(l2, b_ + 8192); TRRD(h2, b_ + 10240); TRRD(l3, b_ + 12288); TRRD(h3, b_ + 14336); \
        asm volatile("s_waitcnt lgkmcnt(0)" ::: "memory"); SBAR();   \
        o[d0] = __builtin_amdgcn_mfma_f32_32x32x16_bf16(pa0, (bf16x8){l0[0], l0[1], l0[2], l0[3], h0[0], h0[1], h0[2], h0[3]}, o[d0], 0, 0, 0);   \
        o[d0] = __builtin_amdgcn_mfma_f32_32x32x16_bf16(pa1, (bf16x8){l1[0], l1[1], l1[2], l1[3], h1[0], h1[1], h1[2], h1[3]}, o[d0], 0, 0, 0);   \
        o[d0] = __builtin_amdgcn_mfma_f32_32x32x16_bf16(pa2, (bf16x8){l2[0], l2[1], l2[2], l2[3], h2[0], h2[1], h2[2], h2[3]}, o[d0], 0, 0, 0);   \
        o[d0] = __builtin_amdgcn_mfma_f32_32x32x16_bf16(pa3, (bf16x8){l3[0], l3[1], l3[2], l3[3], h3[0], h3[1], h3[2], h3[3]}, o[d0], 0, 0, 0); } while (0)
    PV_D0(0); PV_D0(1); PV_D0(2); PV_D0(3);
#undef PV_D0
#undef TRRD
}
struct BlockRef { const bf16_t* Q; const bf16_t* K; const bf16_t* V; bf16_t* O; const bf16_t* Z; const unsigned long long* MK; int P0; };
struct Seam { bf16x8 qr[8]; bf16x8 st_v0, st_v1, st_k0, st_k1; };
#define ROW(p, k0, rr) ((p) + (size_t)((k0) + (rr)) * RS + sc)
#define VMW() asm volatile("s_waitcnt vmcnt(0)" ::: "memory")
#define VMWN(n) asm volatile("s_waitcnt vmcnt(%0)" :: "i"(n) : "memory")
#define SLOAD_H(Kp, Vp, k0) do { unsigned o_ = soff; asm volatile("" : "+v"(o_)); const char* kp_ = (const char*)(Kp) + (size_t)(k0) * (RS * 2); const char* vp_ = (const char*)(Vp) + (size_t)(k0) * (RS * 2); \
        S.st_v0 = *(const bf16x8*)(vp_ + o_); S.st_v1 = *(const bf16x8*)(vp_ + o_ + 32 * RS * 2); S.st_k0 = *(const bf16x8*)(kp_ + o_); S.st_k1 = *(const bf16x8*)(kp_ + o_ + 32 * RS * 2); } while (0)
#define QLOAD(Qp) do { unsigned o_ = qoff; asm volatile("" : "+v"(o_)); const char* qp_ = (const char*)(Qp); _Pragma("unroll") for (int d0 = 0; d0 < 8; ++d0) S.qr[d0] = *(const bf16x8*)(qp_ + o_ + d0 * 32); } while (0)
#define MLOAD(t) ({ unsigned o_ = moff; asm volatile("" : "+v"(o_)); *(const unsigned long long*)((const char*)cur.MK + (size_t)(t) * (SEQ * 8) + o_); })
#define SWRITE_HK(bf) do { *(bf16x8*)(K_lds + (bf) * SHM_K + kws) = S.st_k0; *(bf16x8*)(K_lds + (bf) * SHM_K + kws + 32 * 256) = S.st_k1; } while (0)
#define SWRITE_HV(bf) do { *(bf16x8*)(V_lds + (bf) * SHM_V + vst0) = S.st_v0; *(bf16x8*)(V_lds + (bf) * SHM_V + vst1) = S.st_v1; } while (0)
#define SWRITE_H(bf) do { SWRITE_HV(bf); SWRITE_HK(bf); } while (0)
__device__ __forceinline__ void prime(const BlockRef& cur, char* lds, Seam& S, const float* rel_bias, int h, int wid) {
    const int lane = lane_id(), tid = wid * 64 + lane, r32 = lane & 31, hi = lane >> 5;
    const int sr = tid >> 4, sc = (tid & 15) * 8, kws = KSWZ(sr, sc * 2); char* K_lds = lds + 2 * SHM_V;
    const unsigned soff = (unsigned)(sr * RS + sc) * 2u, qoff = (unsigned)((wid * QBLK + r32) * RS + hi * 8) * 2u;
    if (tid < 128) ((float*)(lds + LDS_LUT))[tid] = (rel_bias[t5_bucket(tid) * HA + h] - rel_bias[31 * HA + h]) * LOG2E;
    QLOAD(cur.Q);
    SLOAD_H(cur.K, cur.V, 0); VMW(); SWRITE_HK(0);
    __syncthreads();
}
__device__ __forceinline__ void block(const BlockRef& cur, const BlockRef& nxt, char* lds, Seam& S, int wid) {
    int tid = wid * 64 + lane_id(); asm volatile("" : "+v"(tid));
    const int lane = tid & 63, r32 = lane & 31, hi = lane >> 5;
    const int NT = cur.P0 / KVBLK + 4;
    const int qlo = cur.P0 + wid * QBLK, qrow = qlo + r32, qm = qrow - 4 * hi;
    char* V_lds = lds; char* K_lds = lds + 2 * SHM_V;
    float* ws = (float*)(lds + LDS_WS) + wid * 64; float* li_l = ws, * al_l = ws + 32;
    const float* lut = (const float*)(lds + LDS_LUT);
    float m_reg = -1e30f, l_reg = 0; f32x16 o[4] = {};
    const int sr = tid >> 4, sc = (tid & 15) * 8, vst0 = v_st(sr, sc), vst1 = v_st(32 + sr, sc), kws = KSWZ(sr, sc * 2);
    const int vb0 = (int)(uintptr_t)V_lds + v_rd_base(lane);
    const bf16_t* Kh = cur.K; const bf16_t* Vh = cur.V;
    const unsigned soff = (unsigned)(sr * RS + sc) * 2u, qoff = (unsigned)((wid * QBLK + r32) * RS + hi * 8) * 2u, moff = (unsigned)(wid * QBLK + r32) * 8u;
#define RESC(a) do { if (__any((a) < 1.f)) { if (hi == 0) al_l[r32] = (a); asm volatile("s_waitcnt lgkmcnt(0)" ::: "memory");              \
                     for (int d_ = 0; d_ < 4; ++d_) for (int r = 0; r < 16; ++r) o[d_][r] *= al_l[crow(r, hi)]; } } while (0)
#define KBASE(t) ((t) * KVBLK)
#define MASKT(P0_, P1_, mw, t) do { const int kb_ = KBASE(t); if (kb_ + 176 > qlo) add_bias(P0_, P1_, lut, qm - kb_); apply_mask(P0_, P1_, mw, hi); } while (0)
#define SEAM_K0() do { VMWN(8); SWRITE_HK(0); SBAR(); } while (0)
    f32x16 pA0, pA1, pB0, pB1; float mnA, mnB, alA, alB; bf16x8 pa0, pa1, pa2, pa3; unsigned long long mwA, mwB;
    SWRITE_HV(0); SBAR();
    mwA = MLOAD(0);
    if (NT > 1) SLOAD_H(Kh, Vh, KBASE(1));
    SBAR(); qkt<0>(pA0, pA1, K_lds, r32, hi, S.qr);
    MASKT(pA0, pA1, mwA, 0); partialSM(pA0, pA1, m_reg, mnA, alA);
    if (NT > 1) { VMW(); SWRITE_H(1); }
    __syncthreads();
#define HALF_STEP(PX0, PX1, mnX, alX, mwX, PY0, PY1, alY, t, KB, VB, SB) do {                                                 \
        SBAR(); mwX = MLOAD(t); qkt<KB>(PX0, PX1, K_lds, r32, hi, S.qr);                                          \
        finishSM(PY0, PY1, alY, l_reg, pa0, pa1, pa2, pa3); SBAR();                                                           \
        if ((t) + 1 < NT) { SLOAD_H(Kh, Vh, KBASE((t) + 1)); SBAR(); }                                                        \
        pv_tile<VB>(o, vb0, pa0, pa1, pa2, pa3); MASKT(PX0, PX1, mwX, (t)); partialSM(PX0, PX1, m_reg, mnX, alX);             \
        __syncthreads();                                                                                                      \
        if ((t) + 1 < NT) { VMW(); SWRITE_H(SB); }                                                                            \
        RESC(alX); __syncthreads(); } while (0)
    for (int t = 1; t + 1 < NT; t += 2) {
        HALF_STEP(pB0, pB1, mnB, alB, mwB, pA0, pA1, alA, t, 1, 0, 0);
        HALF_STEP(pA0, pA1, mnA, alA, mwA, pB0, pB1, alB, t + 1, 0, 1, 1);
    }
    SBAR(); mwB = MLOAD(NT - 1); qkt<1>(pB0, pB1, K_lds, r32, hi, S.qr); SBAR();
    SLOAD_H(nxt.K, nxt.V, 0); SBAR();
    QLOAD(nxt.Q);
    SBAR();
    finishSM(pA0, pA1, alA, l_reg, pa0, pa1, pa2, pa3); SBAR();
    pv_tile<0>(o, vb0, pa0, pa1, pa2, pa3);
    MASKT(pB0, pB1, mwB, NT - 1); partialSM(pB0, pB1, m_reg, mnB, alB); __syncthreads(); RESC(alB);
    finishSM(pB0, pB1, alB, l_reg, pa0, pa1, pa2, pa3); SBAR(); pv_tile<1>(o, vb0, pa0, pa1, pa2, pa3);
    SBAR(); SEAM_K0();
    if (hi == 0) li_l[r32] = l_reg; asm volatile("s_waitcnt lgkmcnt(0)" ::: "memory");
    float rli[16];
#pragma unroll
    for (int r = 0; r < 16; ++r) rli[r] = __builtin_amdgcn_rcpf(li_l[crow(r, hi)]);
    { int l2 = lane_id(); asm volatile("" : "+v"(l2)); const int e32 = l2 & 31, ehi = (l2 >> 5) & 1;
      const char* Zw = (const char*)cur.Z + (size_t)(wid * QBLK) * (RS * 2); char* Ow = (char*)cur.O + (size_t)(wid * QBLK) * (OS * 2);
      const unsigned zo = (unsigned)(4 * ehi * RS + e32) * 2u, oo = (unsigned)(4 * ehi * OS + e32) * 2u;
#pragma unroll
      for (int r = 0; r < 16; ++r) { const int c = (r & 3) + 8 * (r >> 2);
#pragma unroll
        for (int d0 = 0; d0 < 4; ++d0) { float v = o[d0][r] * rli[r]; float vn = __builtin_bit_cast(float, __builtin_amdgcn_mov_dpp(__builtin_bit_cast(int, v), 0xB1, 0xF, 0xF, true));
            if ((e32 & 1) == 0) { const unsigned zz = *(const unsigned*)(Zw + zo + (c * RS + d0 * 32) * 2);
                v *= __uint_as_float(zz << 16); vn *= __uint_as_float(zz & 0xffff0000u);
                *(unsigned*)(Ow + oo + (c * OS + d0 * 32) * 2) = cvtpk(v, vn); } } } }
    __syncthreads();
#undef RESC
#undef KBASE
#undef MASKT
#undef SEAM_K0
#undef HALF_STEP
}
#undef ROW
#undef VMW
#undef VMWN
#undef SLOAD_H
#undef QLOAD
#undef MLOAD
#undef SWRITE_HK
#undef SWRITE_HV
#undef SWRITE_H
#undef KSWZ
#undef SBAR
}

namespace ml {
constexpr int RSK = 272, RSV = 80, RSS = 144;
typedef short v4i16 __attribute__((ext_vector_type(4)));
__device__ __forceinline__ v4i16 trd(const LAS unsigned char* p) { return __builtin_amdgcn_ds_read_tr16_b64_v4i16((LAS v4i16*)p); }
__device__ __forceinline__ bf16x8 frag_tr(const LAS unsigned char* img, int rs, int kbase, int col0, int lane) {
    const int i = lane & 15, q = i >> 2, p = i & 3, grp = lane >> 4;
    const LAS unsigned char* a = img + (kbase + 8 * grp + q) * rs + (col0 + 4 * p) * 2;
    const v4i16 lo = trd(a), hi = trd(a + 4 * rs);
    return (bf16x8){lo[0], lo[1], lo[2], lo[3], hi[0], hi[1], hi[2], hi[3]};
}
__device__ __forceinline__ float wave_incl_sum(float v, int lane) {
#pragma unroll
    for (int o = 1; o < 64; o <<= 1) { const float t = __shfl_up(v, o); if (lane >= o) v += t; }
    return v;
}
__device__ __forceinline__ float wave_incl_max(float v, int lane) {
#pragma unroll
    for (int o = 1; o < 64; o <<= 1) { const float t = __shfl_up(v, o); if (lane >= o) v = fmaxf(v, t); }
    return v;
}
__device__ __forceinline__ float wave_max(float v) {
#pragma unroll
    for (int o = 1; o < 64; o <<= 1) v = fmaxf(v, __shfl_xor(v, o));
    return v;
}
__device__ __forceinline__ void conv2(const u32x4 (&X)[5], const float (&cw)[4][8], const float (&cb)[8], float (&y0)[8], float (&y1)[8]) {
#pragma unroll
    for (int c = 0; c < 8; ++c) { float x[5];
#pragma unroll
        for (int j = 0; j < 5; ++j) { const unsigned w = X[j][c >> 1]; x[j] = __builtin_bit_cast(float, (c & 1) ? (w & 0xffff0000u) : (w << 16)); }
        float a0 = cb[c], a1 = cb[c];
#pragma unroll
        for (int j = 0; j < 4; ++j) { a0 = fmaf(cw[j][c], x[j], a0); a1 = fmaf(cw[j][c], x[j + 1], a1); }
        y0[c] = silu_f(a0); y1[c] = silu_f(a1); }
}
__device__ __forceinline__ u32x4 pack8f(const float (&y)[8]) { u32x4 w; w.x = pg8::cvt_pk_bf16(y[0], y[1]); w.y = pg8::cvt_pk_bf16(y[2], y[3]); w.z = pg8::cvt_pk_bf16(y[4], y[5]); w.w = pg8::cvt_pk_bf16(y[6], y[7]); return w; }
__device__ __forceinline__ void load5(u32x4 (&X)[5], const bf16_t* QKM, size_t rb, int t, int c) {
#pragma unroll
    for (int j = 0; j < 5; ++j) { const int tt = t - 3 + j; X[j] = tt >= 0 ? *(const u32x4*)(QKM + (rb + tt) * 1024 + c) : (u32x4){0u, 0u, 0u, 0u}; }
}

__device__ __forceinline__ void state_phase(unsigned char* ws, unsigned char* outb, LAS unsigned char* lds, int wave, int vcu) {
    const int lane = lane_id(), tid = wave * 64 + lane, fr = lane & 15, fq = lane >> 4;
    const int b = vcu >> 5, h = (vcu >> 3) & 3, vs = vcu & 7, bh = b * 4 + h;
    const size_t rb = (size_t)b * SEQ;
    const bf16_t* QKM = (const bf16_t*)(ws + WS_QKM); const bf16_t* VM = (const bf16_t*)(ws + WS_VM); const float* IFG = (const float*)(ws + WS_IFG);
    const float* par = (const float*)(ws + WS_PAR);
    bf16_t* CstT = (bf16_t*)outb; float* nst = (float*)(ws + WS_NST + 65536); float* mst = (float*)(ws + WS_NST);
    LAS float* AG = (LAS float*)lds; LAS float* BL = (LAS float*)(lds + 8192); LAS float* ML = BL + 32; LAS float* MM = BL + 64; LAS float* DEC = BL + 96;
    LAS unsigned char* Kimg = lds + 16384; LAS unsigned char* Vimg = lds + 16384 + 64 * RSK;
    const float bi = par[P_BI + h], bfg = par[P_BF + h];
#pragma unroll 1
    for (int j = 0; j < 4; ++j) { const int k = wave + 8 * j; const float* g = IFG + (rb + 64 * k + lane) * 8;
        const float lf = log_sigmoid_f(g[4 + h] + bfg), ii = g[h] + bi;
        const float bcs = wave_incl_sum(lf, lane), bL = __shfl(bcs, 63), a = bL - bcs + ii, mloc = wave_max(a);
        AG[k * 64 + lane] = a; if (lane == 0) { BL[k] = bL; ML[k] = mloc; } }
    __syncthreads();
    if (tid == 0) { float m = 0.f; if (vs == 0) mst[bh * 32] = 0.f;
        for (int k = 0; k < 32; ++k) { const float mn = fmaxf(BL[k] + m, ML[k]); DEC[k] = __expf(BL[k] + m - mn); MM[k] = mn; m = mn; if (vs == 0 && k < 31) mst[bh * 32 + k + 1] = mn; } }
    __syncthreads();
    for (int i = tid; i < 2048; i += 512) AG[i] = __expf(AG[i] - MM[i >> 6]);
    { bf16_t* c0 = CstT + ((size_t)(bh * 32) * 256 + vs * 32) * 128; *(u32x4*)(c0 + tid * 8) = (u32x4){0u, 0u, 0u, 0u};
      if (vs == 0 && tid < 128) nst[(size_t)(bh * 32) * 128 + tid] = 0.f; }
    __syncthreads();
    const int dg = tid & 15, lg = tid >> 4, ck = 512 + h * 128 + 8 * dg;
    float cw[4][8], cb[8];
#pragma unroll
    for (int c = 0; c < 8; ++c) { cb[c] = par[P_CB + ck + c];
#pragma unroll
        for (int j = 0; j < 4; ++j) cw[j][c] = par[P_CW + j * 1024 + ck + c]; }
    f32x4 acc[2] = {{0.f, 0.f, 0.f, 0.f}, {0.f, 0.f, 0.f, 0.f}}, accn = {0.f, 0.f, 0.f, 0.f};
    const bf16x8 ones = {0x3F80, 0x3F80, 0x3F80, 0x3F80, 0x3F80, 0x3F80, 0x3F80, 0x3F80};
    u32x4 X[5], Vr;
    load5(X, QKM, rb, 2 * lg, ck);
    Vr = tid < 256 ? *(const u32x4*)(VM + (rb + (tid >> 2)) * 1024 + h * 256 + vs * 32 + (tid & 3) * 8) : (u32x4){0u, 0u, 0u, 0u};
#pragma unroll 1
    for (int k = 0; k < 31; ++k) {
        const int t0 = 64 * k;
        { float y0[8], y1[8]; conv2(X, cw, cb, y0, y1);
          const float w0 = AG[k * 64 + 2 * lg] * 0.08838834764831845f, w1 = AG[k * 64 + 2 * lg + 1] * 0.08838834764831845f;
#pragma unroll
          for (int c = 0; c < 8; ++c) { y0[c] *= w0; y1[c] *= w1; }
          *(LAS u32x4*)(Kimg + (2 * lg) * RSK + dg * 16) = pack8f(y0); *(LAS u32x4*)(Kimg + (2 * lg + 1) * RSK + dg * 16) = pack8f(y1);
          if (tid < 256) *(LAS u32x4*)(Vimg + (tid >> 2) * RSV + (tid & 3) * 16) = Vr; }
        __syncthreads();
        if (k + 1 < 31) { load5(X, QKM, rb, t0 + 64 + 2 * lg, ck);
            if (tid < 256) Vr = *(const u32x4*)(VM + (rb + t0 + 64 + (tid >> 2)) * 1024 + h * 256 + vs * 32 + (tid & 3) * 8); }
        const float dec = DEC[k];
        acc[0] = acc[0] * dec; acc[1] = acc[1] * dec; accn = accn * dec;
#pragma unroll
        for (int ks = 0; ks < 2; ++ks) { const bf16x8 ak = frag_tr(Kimg, RSK, 32 * ks, 16 * wave, lane);
            const bf16x8 v0 = frag_tr(Vimg, RSV, 32 * ks, 0, lane), v1 = frag_tr(Vimg, RSV, 32 * ks, 16, lane);
            acc[0] = __builtin_amdgcn_mfma_f32_16x16x32_bf16(ak, v0, acc[0], 0, 0, 0);
            acc[1] = __builtin_amdgcn_mfma_f32_16x16x32_bf16(ak, v1, acc[1], 0, 0, 0);
            accn = __builtin_amdgcn_mfma_f32_16x16x32_bf16(ak, ones, accn, 0, 0, 0); }
        { bf16_t* cst = CstT + ((size_t)(bh * 32 + k + 1) * 256 + vs * 32) * 128;
#pragma unroll
          for (int vt = 0; vt < 2; ++vt) { u32x2 w; w.x = pg8::cvt_pk_bf16(acc[vt][0], acc[vt][1]); w.y = pg8::cvt_pk_bf16(acc[vt][2], acc[vt][3]);
              *(u32x2*)(cst + (size_t)(16 * vt + fr) * 128 + 16 * wave + 4 * fq) = w; }
          if (vs == 0 && fr == 0) *(f32x4*)(nst + (size_t)(bh * 32 + k + 1) * 128 + 16 * wave + 4 * fq) = accn; }
        __syncthreads();
    }
}

__device__ __forceinline__ void out_unit(unsigned char* ws, unsigned char* outb, LAS unsigned char* lds, int wave, int b, int h, int k) {
    const int lane = lane_id(), tid = wave * 64 + lane, fr = lane & 15, fq = lane >> 4;
    const int bh = b * 4 + h, t0 = 64 * k; const size_t rb = (size_t)b * SEQ;
    const bf16_t* QKM = (const bf16_t*)(ws + WS_QKM); const bf16_t* VM = (const bf16_t*)(ws + WS_VM); const bf16_t* GM = (const bf16_t*)(ws + WS_GM); const float* IFG = (const float*)(ws + WS_IFG);
    const float* par = (const float*)(ws + WS_PAR);
    const bf16_t* CstT = (const bf16_t*)outb + (size_t)(bh * 32 + k) * 256 * 128; const float* nst = (const float*)(ws + WS_NST + 65536) + (size_t)(bh * 32 + k) * 128; const float* mst = (const float*)(ws + WS_NST);
    bf16_t* Y = (bf16_t*)(ws + WS_Y);
    LAS unsigned char* Qimg = lds; LAS unsigned char* Qs = lds + 64 * RSK; LAS unsigned char* Kimg = lds + 2 * 64 * RSK; LAS unsigned char* Simg = lds + 3 * 64 * RSK;
    LAS unsigned char* Vw = lds + 3 * 64 * RSK + 64 * RSS + wave * (64 * RSV);
    LAS float* SC = (LAS float*)(lds + 3 * 64 * RSK + 64 * RSS + 8 * 64 * RSV);
    LAS float* PART = SC + 256;
    float inter;
    { const float* g = IFG + (rb + t0 + lane) * 8;
      const float lf = log_sigmoid_f(g[4 + h] + par[P_BF + h]), ii = g[h] + par[P_BI + h];
      const float bcs = wave_incl_sum(lf, lane), u = ii - bcs, pm = wave_incl_max(u, lane), mp = mst[bh * 32 + k];
      const float gl = bcs + mp, mt = fmaxf(bcs + pm, gl);
      inter = __expf(gl - mt);
      if (wave == 0) { SC[lane] = bcs - mt; SC[64 + lane] = u; SC[128 + lane] = __expf(-mt); } }
    { const int dg = tid & 15, lg = tid >> 4, r0 = 2 * lg;
      const float in0 = __shfl(inter, r0), in1 = __shfl(inter, r0 + 1);
#pragma unroll 1
      for (int isk = 0; isk < 2; ++isk) { const int cc = (isk ? 512 : 0) + h * 128 + 8 * dg;
          float cw[4][8], cb[8];
#pragma unroll
          for (int c = 0; c < 8; ++c) { cb[c] = par[P_CB + cc + c];
#pragma unroll
              for (int j = 0; j < 4; ++j) cw[j][c] = par[P_CW + j * 1024 + cc + c]; }
          u32x4 X[5]; load5(X, QKM, rb, t0 + r0, cc);
          float y0[8], y1[8]; conv2(X, cw, cb, y0, y1);
          if (isk) {
#pragma unroll
              for (int c = 0; c < 8; ++c) { y0[c] *= 0.08838834764831845f; y1[c] *= 0.08838834764831845f; }
              *(LAS u32x4*)(Kimg + r0 * RSK + dg * 16) = pack8f(y0); *(LAS u32x4*)(Kimg + (r0 + 1) * RSK + dg * 16) = pack8f(y1);
          } else {
              *(LAS u32x4*)(Qimg + r0 * RSK + dg * 16) = pack8f(y0); *(LAS u32x4*)(Qimg + (r0 + 1) * RSK + dg * 16) = pack8f(y1);
#pragma unroll
              for (int c = 0; c < 8; ++c) { y0[c] *= in0; y1[c] *= in1; }
              *(LAS u32x4*)(Qs + r0 * RSK + dg * 16) = pack8f(y0); *(LAS u32x4*)(Qs + (r0 + 1) * RSK + dg * 16) = pack8f(y1);
          } }
#pragma unroll
      for (int i = 0; i < 4; ++i) { const int l = 16 * i + (lane >> 2), pc = lane & 3;
          *(LAS u32x4*)(Vw + l * RSV + pc * 16) = *(const u32x4*)(VM + (rb + t0 + l) * 1024 + h * 256 + 32 * wave + pc * 8); } }
    __syncthreads();
    { const int lt = wave >> 1; const float rt = SC[16 * lt + fr];
#pragma unroll
      for (int si = 0; si < 2; ++si) { const int st = 2 * (wave & 1) + si; u32x2 w = {0u, 0u};
          if (st <= lt) { f32x4 sacc = {0.f, 0.f, 0.f, 0.f};
#pragma unroll
              for (int ks = 0; ks < 4; ++ks) { const bf16x8 kf = *(const LAS bf16x8*)(Kimg + (16 * st + fr) * RSK + (32 * ks + 8 * fq) * 2), qf = *(const LAS bf16x8*)(Qimg + (16 * lt + fr) * RSK + (32 * ks + 8 * fq) * 2);
                  sacc = __builtin_amdgcn_mfma_f32_16x16x32_bf16(kf, qf, sacc, 0, 0, 0); }
              const int l = 16 * lt + fr; float e[4];
#pragma unroll
              for (int j = 0; j < 4; ++j) { const int sidx = 16 * st + 4 * fq + j; e[j] = sidx <= l ? sacc[j] * __expf(rt + SC[64 + sidx]) : 0.f; }
              w.x = pg8::cvt_pk_bf16(e[0], e[1]); w.y = pg8::cvt_pk_bf16(e[2], e[3]); }
          *(LAS u32x2*)(Simg + (16 * lt + fr) * RSS + (16 * st + 4 * fq) * 2) = w; } }
    __syncthreads();
    const bf16x8 ones = {0x3F80, 0x3F80, 0x3F80, 0x3F80, 0x3F80, 0x3F80, 0x3F80, 0x3F80};
    if (wave < 4) { f32x4 dacc = {0.f, 0.f, 0.f, 0.f};
#pragma unroll
        for (int ks = 0; ks < 2; ++ks) { const bf16x8 sf = *(const LAS bf16x8*)(Simg + (16 * wave + fr) * RSS + (32 * ks + 8 * fq) * 2); dacc = __builtin_amdgcn_mfma_f32_16x16x32_bf16(ones, sf, dacc, 0, 0, 0); }
#pragma unroll
        for (int ks = 0; ks < 4; ++ks) { const f32x4 n0 = *(const f32x4*)(nst + 32 * ks + 8 * fq), n1 = *(const f32x4*)(nst + 32 * ks + 8 * fq + 4);
            u32x4 nw; nw.x = pg8::cvt_pk_bf16(n0[0], n0[1]); nw.y = pg8::cvt_pk_bf16(n0[2], n0[3]); nw.z = pg8::cvt_pk_bf16(n1[0], n1[1]); nw.w = pg8::cvt_pk_bf16(n1[2], n1[3]);
            const bf16x8 qf = *(const LAS bf16x8*)(Qs + (16 * wave + fr) * RSK + (32 * ks + 8 * fq) * 2);
            dacc = __builtin_amdgcn_mfma_f32_16x16x32_bf16(__builtin_bit_cast(bf16x8, nw), qf, dacc, 0, 0, 0); }
        if (fq == 0) SC[192 + 16 * wave + fr] = dacc[0]; }
    f32x4 acc[4][2];
#pragma unroll
    for (int lt = 0; lt < 4; ++lt) { acc[lt][0] = (f32x4){0.f, 0.f, 0.f, 0.f}; acc[lt][1] = (f32x4){0.f, 0.f, 0.f, 0.f}; }
#pragma unroll
    for (int ks = 0; ks < 2; ++ks) { const bf16x8 v0 = frag_tr(Vw, RSV, 32 * ks, 0, lane), v1 = frag_tr(Vw, RSV, 32 * ks, 16, lane);
#pragma unroll
        for (int lt = 0; lt < 4; ++lt) { const bf16x8 sf = *(const LAS bf16x8*)(Simg + (16 * lt + fr) * RSS + (32 * ks + 8 * fq) * 2);
            acc[lt][0] = __builtin_amdgcn_mfma_f32_16x16x32_bf16(v0, sf, acc[lt][0], 0, 0, 0); acc[lt][1] = __builtin_amdgcn_mfma_f32_16x16x32_bf16(v1, sf, acc[lt][1], 0, 0, 0); } }
#pragma unroll
    for (int ks = 0; ks < 4; ++ks) { const bf16x8 c0 = *(const bf16x8*)(CstT + (size_t)(32 * wave + fr) * 128 + 32 * ks + 8 * fq), c1 = *(const bf16x8*)(CstT + (size_t)(32 * wave + 16 + fr) * 128 + 32 * ks + 8 * fq);
#pragma unroll
        for (int lt = 0; lt < 4; ++lt) { const bf16x8 qf = *(const LAS bf16x8*)(Qs + (16 * lt + fr) * RSK + (32 * ks + 8 * fq) * 2);
            acc[lt][0] = __builtin_amdgcn_mfma_f32_16x16x32_bf16(c0, qf, acc[lt][0], 0, 0, 0); acc[lt][1] = __builtin_amdgcn_mfma_f32_16x16x32_bf16(c1, qf, acc[lt][1], 0, 0, 0); } }
    __syncthreads();
#pragma unroll
    for (int lt = 0; lt < 4; ++lt) { const int l = 16 * lt + fr; const float sc = 1.f / fmaxf(fabsf(SC[192 + l]), SC[128 + l]);
        acc[lt][0] = acc[lt][0] * sc; acc[lt][1] = acc[lt][1] * sc;
        float s1 = 0.f, s2 = 0.f;
#pragma unroll
        for (int vt = 0; vt < 2; ++vt)
#pragma unroll
            for (int j = 0; j < 4; ++j) { const float x = acc[lt][vt][j]; s1 += x; s2 = fmaf(x, x, s2); }
        s1 += __shfl_xor(s1, 16); s1 += __shfl_xor(s1, 32); s2 += __shfl_xor(s2, 16); s2 += __shfl_xor(s2, 32);
        if (fq == 0) { PART[(l * 8 + wave) * 2] = s1; PART[(l * 8 + wave) * 2 + 1] = s2; } }
    __syncthreads();
#pragma unroll
    for (int lt = 0; lt < 4; ++lt) { const int l = 16 * lt + fr; float s1 = 0.f, s2 = 0.f;
#pragma unroll
        for (int w = 0; w < 8; ++w) { s1 += PART[(l * 8 + w) * 2]; s2 += PART[(l * 8 + w) * 2 + 1]; }
        const float mu = s1 * (1.f / DVM), var = fmaxf(s2 * (1.f / DVM) - mu * mu, 0.f), rstd = rsqrtf(var + LN_EPS);
#pragma unroll
        for (int vt = 0; vt < 2; ++vt) { const int c = h * 256 + 32 * wave + 16 * vt + 4 * fq; const size_t row = rb + t0 + l;
            const f32x4 gg = *(const f32x4*)(par + P_MHG + c); const u32x2 gm = *(const u32x2*)(GM + row * 1024 + c);
            const float g0 = __builtin_bit_cast(float, gm.x << 16), g1 = __builtin_bit_cast(float, gm.x & 0xffff0000u), g2 = __builtin_bit_cast(float, gm.y << 16), g3 = __builtin_bit_cast(float, gm.y & 0xffff0000u);
            const f32x4 x = acc[lt][vt];
            u32x2 w; w.x = pg8::cvt_pk_bf16((x[0] - mu) * rstd * gg[0] * g0, (x[1] - mu) * rstd * gg[1] * g1); w.y = pg8::cvt_pk_bf16((x[2] - mu) * rstd * gg[2] * g2, (x[3] - mu) * rstd * gg[3] * g3);
            *(u32x2*)(Y + row * 2048 + 1024 + c) = w; } }
    __syncthreads();
}
}

constexpr int NWAVES = 8, NTHREADS = 512;
constexpr int LDS_BYTES = 147456;
constexpr int MISC_OFF = 131072 + 8192;
constexpr int CW_BAR = 4096;
struct Args {
    const float* in[16]; float* out; unsigned char* ws; int ph_lo, ph_hi, li, pad;
};

template <class SrcMap>
__device__ __forceinline__ void p0_transpose_item(const float* W, int K, int Nsrc, int nblk, bf16_t* WT, int row_off, LAS float* scr, int item, int lane, SrcMap smap) {
    const int kb = item / nblk, nb = item % nblk, k0 = 64 * kb, n0 = 32 * nb;
    const int src = smap(n0 + (lane & 31));
#pragma unroll 8
    for (int i = 0; i < 32; ++i) { const int kk = 2 * i + (lane >> 5); scr[kk * 33 + (lane & 31)] = src >= 0 ? W[(size_t)(k0 + kk) * Nsrc + src] : 0.f; }
    asm volatile("s_waitcnt lgkmcnt(0)" ::: "memory");
    const int c = lane & 7;
#pragma unroll
    for (int j = 0; j < 4; ++j) { const int n = (lane >> 3) + 8 * j; const LAS float* s = scr + (8 * c) * 33 + n;
        u32x4 o; o.x = pk2(s[0 * 33], s[1 * 33]); o.y = pk2(s[2 * 33], s[3 * 33]); o.z = pk2(s[4 * 33], s[5 * 33]); o.w = pk2(s[6 * 33], s[7 * 33]);
        *(u32x4*)(WT + (size_t)(row_off + n0 + n) * K + k0 + 8 * c) = o; }
    asm volatile("s_waitcnt lgkmcnt(0)" ::: "memory");
}
struct MapIdent { __device__ __forceinline__ int operator()(int n) const { return n; } };
struct MapWin { __device__ __forceinline__ int operator()(int n) const { return win_src(n); } };

__global__ void __launch_bounds__(NTHREADS, 2) skel_fwd(Args args) {
    extern __shared__ __attribute__((aligned(16))) unsigned char lds_raw[];
    LAS unsigned char* lds = (LAS unsigned char*)lds_raw;
#define FRESH_TID() ({ int t_ = wave * 64 + lane_id(); asm volatile("" : "+v"(t_)); t_; })
    const int wave = __builtin_amdgcn_readfirstlane(threadIdx.x >> 6);
    const int G = gridDim.x, bx = blockIdx.x;
    const int vcu = (G % 8 == 0) ? (bx % 8) * (G / 8) + bx / 8 : bx;
    unsigned char* ws = args.ws;
    const int lo = args.ph_lo, hi = args.ph_hi;
#define IN(k) (lo <= (k) && (k) < hi)
#define BOTH(k) (IN(k) && IN((k) + 1))
    volatile LAS unsigned* MISC = (volatile LAS unsigned*)(lds + MISC_OFF);
    if (threadIdx.x < 32) MISC[threadIdx.x] = 0u;
    __syncthreads();
    XcdBarrier bar = xcd_barrier_post((unsigned*)(ws + WS_CTL) + CW_BAR + args.li * XCD_BAR_WORDS, MISC + 8);
#define GRID_BAR() xcd_barrier(bar, wave)
#define XB ((bf16_t*)(ws + WS_XB))
#define WINT ((bf16_t*)(ws + WS_WINT))
#define WOUTT ((bf16_t*)(ws + WS_WOUTT))
#define WKVT ((bf16_t*)(ws + WS_WKVT))
#define PARF ((float*)(ws + WS_PAR))

    if (IN(0)) {
        const int tid = FRESH_TID(), lane = tid & 63;
        const int gw = vcu * NWAVES + wave, NGW = G * NWAVES;
        LAS float* scr = (LAS float*)(lds + wave * 16384);
        const float* x = args.in[0];
        for (int it = gw; it < M * DM / 512; it += NGW) {
            const f32x4 a = *(const f32x4*)(x + (size_t)it * 512 + lane * 8), b = *(const f32x4*)(x + (size_t)it * 512 + lane * 8 + 4);
            u32x4 o; o.x = pk2(a[0], a[1]); o.y = pk2(a[2], a[3]); o.z = pk2(b[0], b[1]); o.w = pk2(b[2], b[3]);
            *(u32x4*)(XB + (size_t)it * 512 + lane * 8) = o;
        }
        constexpr int I_IN = (DM / 64) * (NP / 32), I_OUT = (DM / 64) * (DM / 32), I_UV = (DC / 64) * (DHA / 32);
        for (int it = gw; it < I_IN + I_OUT + HA * I_UV; it += NGW) {
            int r = it;
            if (r < I_IN) { p0_transpose_item(args.in[1], DM, NCOLS, NP / 32, WINT, 0, scr, r, lane, MapWin()); continue; } r -= I_IN;
            if (r < I_OUT) { p0_transpose_item(args.in[13], DM, DM, DM / 32, WOUTT, 0, scr, r, lane, MapIdent()); continue; } r -= I_OUT;
            { const int h = r / I_UV; p0_transpose_item(args.in[6] + (size_t)h * DC * DHA, DC, DHA, DHA / 32, WKVT, 1024 + h * DHA, scr, r % I_UV, lane, MapIdent()); }
        }
        {
            const int gt = vcu * NTHREADS + tid, NGT = G * NTHREADS;
            for (int i = gt; i < P_TOTAL; i += NGT) { float v = 0.f;
                if (i < P_LNG) v = args.in[4][i - P_KVG]; else if (i < P_LNB) v = args.in[7][i - P_LNG]; else if (i < P_RB) v = args.in[8][i - P_LNB];
                else if (i < P_CW) v = args.in[9][i - P_RB]; else if (i < P_CB) v = args.in[10][i - P_CW]; else if (i < P_MHG) v = args.in[11][i - P_CB];
                else if (i < P_BI) v = args.in[12][i - P_MHG]; else if (i < P_BI + 4) v = args.in[2][i - P_BI]; else if (i < P_BF + 4) v = args.in[3][i - P_BF];
                else if (i >= P_LG && i < P_LB) v = args.in[14][i - P_LG]; else if (i >= P_LB) v = args.in[15][i - P_LB];
                PARF[i] = v; }
        }
        const float* wuk = args.in[5];
        for (int it = gw; it < 1024 * 256 / 512; it += NGW) {
            const f32x4 a = *(const f32x4*)(wuk + (size_t)it * 512 + lane * 8), b = *(const f32x4*)(wuk + (size_t)it * 512 + lane * 8 + 4);
            u32x4 o; o.x = pk2(a[0], a[1]); o.y = pk2(a[2], a[3]); o.z = pk2(b[0], b[1]); o.w = pk2(b[2], b[3]);
            *(u32x4*)(WKVT + (size_t)it * 512 + lane * 8) = o;
        }
        if (BOTH(0)) GRID_BAR();
    }
    if (IN(1)) {
        pg8::Gemm g{XB, WINT, M, NP, DM}; pg8::StaticOrder S; S.init(M, NP, G, bx);
        Epi1 E{ws};
        pg8::gemm_phase<Epi1, pg8::StaticOrder>(lds, g, S, E, wave);
        if (BOTH(1)) GRID_BAR();
    }
    if (IN(2)) {
        {
            const int lane = FRESH_TID() & 63, b = vcu >> 5, j = vcu & 31;
#pragma unroll 1
            for (int u = 0; u < 4; ++u) { const int gi = (u & 1) ? ((u & 2) ? j : 64 + j) : ((u & 2) ? 63 - j : 127 - j);
                topk_unit((const bf16_t*)(ws + WS_QI), (const bf16_t*)(ws + WS_KI), (const float*)(ws + WS_WI), (unsigned long long*)(ws + WS_MASK), b, gi, wave, lane, (LAS unsigned long long*)(lds + 131072 + 4096 + wave * 256)); }
        }
        pg8::Gemm g{(bf16_t*)(ws + WS_C), WKVT, M, 2048, DC}; pg8::StaticOrder S; S.init(M, 2048, G, bx);
        EpiKV E{(bf16_t*)((unsigned char*)args.out + OUT_K), (bf16_t*)((unsigned char*)args.out + OUT_V)};
        pg8::gemm_phase<EpiKV, pg8::StaticOrder>(lds, g, S, E, wave);
        ml::state_phase(ws, (unsigned char*)args.out, lds, wave, vcu);
        if (BOTH(2)) GRID_BAR();
    }
    if (IN(3)) {
        const int b = vcu >> 5, h = (vcu >> 2) & 7, x = vcu & 3;
        const bf16_t* Qh = (const bf16_t*)(ws + WS_Q) + (size_t)b * SEQ * 1024 + h * DHA;
        const bf16_t* Kh = (const bf16_t*)((unsigned char*)args.out + OUT_K) + (size_t)b * SEQ * 1024 + h * DHA;
        const bf16_t* Vh = (const bf16_t*)((unsigned char*)args.out + OUT_V) + (size_t)b * SEQ * 1024 + h * DHA;
        bf16_t* Yh = (bf16_t*)(ws + WS_Y) + (size_t)b * SEQ * 2048 + h * DHA;
        const bf16_t* Zh = (const bf16_t*)(ws + WS_SZA) + (size_t)b * SEQ * 1024 + h * DHA;
        const unsigned long long* MKb = (const unsigned long long*)(ws + WS_MASK) + (size_t)b * 32 * SEQ;
        const int q0 = x * 256, q1 = (7 - x) * 256;
        att::BlockRef r0{Qh + (size_t)q0 * 1024, Kh, Vh, Yh + (size_t)q0 * 2048, Zh + (size_t)q0 * 1024, MKb + q0, q0};
        att::BlockRef r1{Qh + (size_t)q1 * 1024, Kh, Vh, Yh + (size_t)q1 * 2048, Zh + (size_t)q1 * 1024, MKb + q1, q1};
        att::Seam S;
        att::prime(r0, (char*)lds_raw, S, PARF + P_RB, h, wave);
#pragma unroll 1
        for (int pass = 0; pass < 2; ++pass) { const att::BlockRef cur = pass ? r1 : r0; att::block(cur, r1, (char*)lds_raw, S, wave); }
#pragma unroll 1
        for (int i = 0; i < 4; ++i) { const int u = vcu * 4 + i; ml::out_unit(ws, (unsigned char*)args.out, lds, wave, u >> 7, (u >> 5) & 3, u & 31); }
        if (BOTH(3)) GRID_BAR();
    }
    if (IN(4)) {
        pg8::Gemm g{(bf16_t*)(ws + WS_Y), WOUTT, M, DM, DM}; pg8::StaticOrder S; S.init(M, DM, G, bx);
        EpiOut E{args.in[0], args.out};
        pg8::gemm_phase<EpiOut, pg8::StaticOrder>(lds, g, S, E, wave);
        if (BOTH(4)) GRID_BAR();
    }
    if (IN(5)) {
        const int lane = FRESH_TID() & 63;
        const int gw = vcu * NWAVES + wave, NGW = G * NWAVES;
        const float* lg = PARF + P_LG; const float* lb = PARF + P_LB;
        for (int r = gw; r < M; r += NGW) {
            f32x4* p = (f32x4*)(args.out + (size_t)r * DM) + lane;
            f32x4 v[8]; float s = 0.f;
#pragma unroll
            for (int j = 0; j < 8; ++j) { v[j] = p[64 * j]; s += (v[j][0] + v[j][1]) + (v[j][2] + v[j][3]); }
#pragma unroll
            for (int o = 1; o < 64; o <<= 1) s += __shfl_xor(s, o);
            const float mu = s * (1.f / DM); float q = 0.f;
#pragma unroll
            for (int j = 0; j < 8; ++j) { v[j] = v[j] - mu; q += (v[j][0] * v[j][0] + v[j][1] * v[j][1]) + (v[j][2] * v[j][2] + v[j][3] * v[j][3]); }
#pragma unroll
            for (int o = 1; o < 64; o <<= 1) q += __shfl_xor(q, o);
            const float rstd = rsqrtf(q * (1.f / DM) + LN_EPS);
#pragma unroll
            for (int j = 0; j < 8; ++j) { const f32x4 gg = *((const f32x4*)lg + lane + 64 * j), bb = *((const f32x4*)lb + lane + 64 * j); p[64 * j] = v[j] * rstd * gg + bb; }
        }
    }
#undef IN
#undef BOTH
}


__global__ void __launch_bounds__(256) naive_topk(const bf16_t* __restrict__ QI, const bf16_t* __restrict__ KI, const float* __restrict__ WI, unsigned long long* __restrict__ mask) {
    __shared__ float qi[HIDX * DIDX]; __shared__ float w[HIDX]; __shared__ unsigned keys[SEQ]; __shared__ unsigned cnt; __shared__ unsigned Tsh;
    const int row = blockIdx.x, b = row / SEQ, t = row % SEQ, tid = threadIdx.x;
    for (int i = tid; i < HIDX * DIDX; i += 256) qi[i] = bf2f(QI[(size_t)row * 1024 + i]);
    if (tid < HIDX) w[tid] = WI[(size_t)row * 16 + tid];
    __syncthreads();
    for (int s = tid; s < SEQ; s += 256) {
        unsigned key = 0u;
        if (s <= t) {
            const bf16_t* kr = KI + ((size_t)b * SEQ + s) * DIDX; float kf[DIDX];
#pragma unroll
            for (int d = 0; d < DIDX; ++d) kf[d] = bf2f(kr[d]);
            float sc = 0.f;
            for (int h = 0; h < HIDX; ++h) { float a = 0.f;
#pragma unroll
                for (int d = 0; d < DIDX; ++d) a = fmaf(qi[h * DIDX + d], kf[d], a);
                sc = fmaf(fmaxf(a, 0.f), w[h], sc); }
            key = mono_key(sc);
        }
        keys[s] = key;
    }
    __syncthreads();
    if (t >= NSEL) {
        unsigned T = 0u;
        for (int bit = 31; bit >= 0; --bit) {
            const unsigned cand = T | (1u << bit);
            if (tid == 0) cnt = 0u;
            __syncthreads();
            unsigned c = 0u;
            for (int s = tid; s < SEQ; s += 256) c += keys[s] >= cand ? 1u : 0u;
            atomicAdd(&cnt, c);
            __syncthreads();
            if (cnt >= (unsigned)NSEL) T = cand;
            __syncthreads();
        }
        if (tid == 0) {
            unsigned gt = 0u; for (int s = 0; s < SEQ; ++s) gt += keys[s] > T ? 1u : 0u;
            unsigned need = NSEL - gt;
            for (int s = 0; s < SEQ; ++s) if (keys[s] == T) { if (need > 0u) --need; else keys[s] = 0u; }
            Tsh = T;
        }
        __syncthreads();
    } else { if (tid == 0) Tsh = 1u; __syncthreads(); }
    if (tid < 32) {
        const unsigned T = Tsh; unsigned long long wv = 0ull;
        for (int l = 0; l < 64; ++l) if (keys[tid * 64 + l] >= T) wv |= 1ull << l;
        mask[((size_t)b * 32 + tid) * SEQ + t] = wv;
    }
}

__global__ void __launch_bounds__(256) naive_attn(const bf16_t* __restrict__ Qb, const bf16_t* __restrict__ Kb, const bf16_t* __restrict__ Vb, const bf16_t* __restrict__ SZA,
                                                  const unsigned long long* __restrict__ mask, const float* __restrict__ rel_bias, bf16_t* __restrict__ Y) {
    __shared__ int sel[NSEL]; __shared__ int nsel_s; __shared__ float q[1024]; __shared__ float p[NSEL]; __shared__ float red[8]; __shared__ int pre[33];
    const int row = blockIdx.x, b = row / SEQ, t = row % SEQ, tid = threadIdx.x;
    for (int i = tid; i < 1024; i += 256) q[i] = bf2f(Qb[(size_t)row * 1024 + i]);
    if (tid == 0) { int a = 0; for (int g = 0; g < 32; ++g) { pre[g] = a; a += __popcll(mask[((size_t)b * 32 + g) * SEQ + t]); } pre[32] = a; nsel_s = a; }
    __syncthreads();
    if (tid < 32) { unsigned long long wv = mask[((size_t)b * 32 + tid) * SEQ + t]; int o = pre[tid]; while (wv) { const int l = __ffsll((long long)wv) - 1; wv &= wv - 1; if (o < NSEL) sel[o] = tid * 64 + l; ++o; } }
    __syncthreads();
    const int nsel = nsel_s < NSEL ? nsel_s : NSEL;
    for (int h = 0; h < HA; ++h) {
        float lg = -1e30f;
        if (tid < nsel) { const int s = sel[tid]; const bf16_t* kr = Kb + ((size_t)b * SEQ + s) * 1024 + h * DHA; float a = 0.f;
            for (int d = 0; d < DHA; ++d) a = fmaf(q[h * DHA + d], bf2f(kr[d]), a);
            lg = (t - s >= 0) ? a + rel_bias[t5_bucket(t - s) * HA + h] * LOG2E : -1e30f; }
        float mx = lg;
        for (int o = 1; o < 64; o <<= 1) mx = fmaxf(mx, __shfl_xor(mx, o));
        if ((tid & 63) == 0) red[tid >> 6] = mx;
        __syncthreads();
        mx = fmaxf(fmaxf(red[0], red[1]), fmaxf(red[2], red[3]));
        const float pe = tid < nsel ? exp2f(lg - mx) : 0.f;
        p[tid] = pe;
        float sm = pe;
        for (int o = 1; o < 64; o <<= 1) sm += __shfl_xor(sm, o);
        if ((tid & 63) == 0) red[4 + (tid >> 6)] = sm;
        __syncthreads();
        const float l = (red[4] + red[5]) + (red[6] + red[7]);
        if (tid < DHA) { float o = 0.f;
            for (int j = 0; j < nsel; ++j) o = fmaf(p[j], bf2f(Vb[((size_t)b * SEQ + sel[j]) * 1024 + h * DHA + tid]), o);
            const float y = o / l * bf2f(SZA[(size_t)row * 1024 + h * DHA + tid]);
            Y[(size_t)row * 2048 + h * DHA + tid] = (bf16_t)f2bf(y); }
        __syncthreads();
    }
}

__global__ void __launch_bounds__(512) naive_mlstm(const bf16_t* __restrict__ QKM, const bf16_t* __restrict__ VM, const bf16_t* __restrict__ GM, const float* __restrict__ IFG,
                                                   const float* __restrict__ conv_w, const float* __restrict__ conv_b, const float* __restrict__ b_i, const float* __restrict__ b_f,
                                                   const float* __restrict__ mhg, float* __restrict__ Cst, float* __restrict__ hbuf, bf16_t* __restrict__ Y) {
    extern __shared__ float dsm[]; float* qs = dsm; float* ks = dsm + CHUNK * DKM; float* Ss = dsm + 2 * CHUNK * DKM;
    __shared__ float bcs[CHUNK], ii[CHUNK], mt[CHUNK], inter[CHUNK], den[CHUNK], wgt[CHUNK], nvec[DKM], qn[CHUNK]; __shared__ float m_s, decay_s;
    const int bh = blockIdx.x, b = bh / HM, h = bh % HM, tid = threadIdx.x;
    float* C = Cst + (size_t)bh * DVM * DKM; float* hb = hbuf + (size_t)bh * CHUNK * DVM;
    for (int i = tid; i < DVM * DKM; i += 512) C[i] = 0.f;
    if (tid < DKM) nvec[tid] = 0.f;
    if (tid == 0) m_s = 0.f;
    __syncthreads();
    for (int kc = 0; kc < NCHUNK; ++kc) {
        const int t0 = kc * CHUNK; const size_t rb = (size_t)b * SEQ;
        _Pragma("unroll 1") for (int i = tid; i < CHUNK * DKM * 2; i += 512) {
            const int isk = i >= CHUNK * DKM, e = isk ? i - CHUNK * DKM : i, l = e / DKM, d = e % DKM, c = (isk ? 512 : 0) + h * DKM + d, t = t0 + l;
            float a = conv_b[c];
            for (int j = 0; j < 4; ++j) { const int tt = t - 3 + j; if (tt >= 0) a = fmaf(conv_w[j * 1024 + c], bf2f(QKM[(rb + tt) * 1024 + c]), a); }
            a = silu_f(a);
            if (isk) ks[e] = a * 0.08838834764831845f; else qs[e] = a;
        }
        if (tid == 0) { float cs = 0.f;
            _Pragma("unroll 1") for (int l = 0; l < CHUNK; ++l) { const float* g = IFG + (rb + t0 + l) * 8; cs += log_sigmoid_f(g[4 + h] + b_f[h]); bcs[l] = cs; ii[l] = g[h] + b_i[h]; }
            float rm = -1e30f; const float mp = m_s;
            _Pragma("unroll 1") for (int l = 0; l < CHUNK; ++l) { rm = fmaxf(rm, ii[l] - bcs[l]); const float gl = bcs[l] + mp; const float m = fmaxf(bcs[l] + rm, gl); mt[l] = m; inter[l] = expf(gl - m); } }
        __syncthreads();
        _Pragma("unroll 1") for (int i = tid; i < CHUNK * CHUNK; i += 512) { const int l = i / CHUNK, s = i % CHUNK; float v = 0.f;
            if (s <= l) { float a = 0.f; _Pragma("unroll 4") for (int d = 0; d < DKM; ++d) a = fmaf(qs[l * DKM + d], ks[s * DKM + d], a); v = a * expf(bcs[l] - bcs[s] + ii[s] - mt[l]); }
            Ss[i] = v; }
        if (tid < CHUNK) { float a = 0.f; _Pragma("unroll 4") for (int d = 0; d < DKM; ++d) a = fmaf(qs[tid * DKM + d], nvec[d], a); qn[tid] = a; }
        __syncthreads();
        if (tid < CHUNK) { float a = 0.f; _Pragma("unroll 4") for (int s = 0; s < CHUNK; ++s) a += Ss[tid * CHUNK + s]; den[tid] = a + inter[tid] * qn[tid]; }
        __syncthreads();
        { const int v = tid % DVM, lh = tid / DVM;
            _Pragma("unroll 1") for (int lq = 0; lq < 2; ++lq) { float acc[16]; const int l0 = lh * 32 + lq * 16;
#pragma unroll
                for (int l = 0; l < 16; ++l) acc[l] = 0.f;
_Pragma("unroll 2")
                for (int d = 0; d < DKM; ++d) { const float c = C[v * DKM + d];
#pragma unroll
                    for (int l = 0; l < 16; ++l) acc[l] = fmaf(qs[(l0 + l) * DKM + d], c, acc[l]); }
#pragma unroll
                for (int l = 0; l < 16; ++l) acc[l] *= inter[l0 + l];
_Pragma("unroll 2")
                for (int s = 0; s < CHUNK; ++s) { const float vv = bf2f(VM[(rb + t0 + s) * 1024 + h * DVM + v]);
#pragma unroll
                    for (int l = 0; l < 16; ++l) acc[l] = fmaf(Ss[(l0 + l) * CHUNK + s], vv, acc[l]); }
#pragma unroll
                for (int l = 0; l < 16; ++l) { const int L = l0 + l; hb[L * DVM + v] = acc[l] / fmaxf(fabsf(den[L]), expf(-mt[L])); } } }
        __syncthreads();
        { const int wv = tid >> 6, ln = tid & 63;
            _Pragma("unroll 1") for (int l = wv; l < CHUNK; l += 8) { float x[4]; float s = 0.f;
                for (int j = 0; j < 4; ++j) { x[j] = hb[l * DVM + ln + 64 * j]; s += x[j]; }
                for (int o = 1; o < 64; o <<= 1) s += __shfl_xor(s, o);
                const float mu = s * (1.f / DVM); float q = 0.f;
                for (int j = 0; j < 4; ++j) { x[j] -= mu; q += x[j] * x[j]; }
                for (int o = 1; o < 64; o <<= 1) q += __shfl_xor(q, o);
                const float rstd = rsqrtf(q * (1.f / DVM) + LN_EPS);
                for (int j = 0; j < 4; ++j) { const int c = h * DVM + ln + 64 * j; const float y = x[j] * rstd * mhg[c] * bf2f(GM[(rb + t0 + l) * 1024 + c]);
                    Y[(rb + t0 + l) * 2048 + 1024 + c] = (bf16_t)f2bf(y); } } }
        if (tid == 0) { const float bL = bcs[CHUNK - 1], mp = m_s; float ma = -1e30f;
            _Pragma("unroll 1") for (int l = 0; l < CHUNK; ++l) ma = fmaxf(ma, bL - bcs[l] + ii[l]);
            const float mn = fmaxf(bL + mp, ma); decay_s = expf(bL + mp - mn);
            _Pragma("unroll 1") for (int l = 0; l < CHUNK; ++l) wgt[l] = expf(bL - bcs[l] + ii[l] - mn);
            m_s = mn; }
        __syncthreads();
        { const int v = tid % DVM, dh = tid / DVM; const float dc = decay_s;
            _Pragma("unroll 1") for (int dq = 0; dq < 4; ++dq) { float acc[16]; const int d0 = dh * 64 + dq * 16;
#pragma unroll
                for (int d = 0; d < 16; ++d) acc[d] = C[v * DKM + d0 + d] * dc;
_Pragma("unroll 2")
                for (int l = 0; l < CHUNK; ++l) { const float wvv = wgt[l] * bf2f(VM[(rb + t0 + l) * 1024 + h * DVM + v]);
#pragma unroll
                    for (int d = 0; d < 16; ++d) acc[d] = fmaf(wvv, ks[l * DKM + d0 + d], acc[d]); }
#pragma unroll
                for (int d = 0; d < 16; ++d) C[v * DKM + d0 + d] = acc[d]; } }
        if (tid < DKM) { float a = nvec[tid] * decay_s; _Pragma("unroll 4") for (int l = 0; l < CHUNK; ++l) a = fmaf(wgt[l], ks[l * DKM + tid], a); nvec[tid] = a; }
        __syncthreads();
    }
}

constexpr int NAIVE_MLSTM_LDS = (2 * CHUNK * DKM + CHUNK * CHUNK) * 4;
extern "C" void kernel_launch(void* const* d_in, const int* in_sizes, int n_in, void* d_out, int out_size, void* d_ws, size_t ws_size, hipStream_t stream) {
    static int grid = 0;
    if (grid == 0) {
        if (n_in != 16 || in_sizes[0] != M * DM || out_size != M * DM || ws_size < WS_END) { fprintf(stderr, "kernel_launch: unexpected shapes (n_in %d, in0 %d, out %d, ws %zu)\n", n_in, n_in > 0 ? in_sizes[0] : -1, out_size, ws_size); grid = -1; return; }
        int dev = 0, cus = 0, per_cu = 0;
        if (hipGetDevice(&dev) != hipSuccess || hipDeviceGetAttribute(&cus, hipDeviceAttributeMultiprocessorCount, dev) != hipSuccess) { grid = -1; return; }
        if (hipFuncSetAttribute((const void*)skel_fwd, hipFuncAttributeMaxDynamicSharedMemorySize, LDS_BYTES) != hipSuccess) { fprintf(stderr, "kernel_launch: hipFuncSetAttribute failed\n"); grid = -1; return; }
        if (hipOccupancyMaxActiveBlocksPerMultiprocessor(&per_cu, (const void*)skel_fwd, NTHREADS, LDS_BYTES) != hipSuccess || per_cu < 1) fprintf(stderr, "kernel_launch: occupancy query says %d\n", per_cu);
        (void)hipFuncSetAttribute((const void*)naive_mlstm, hipFuncAttributeMaxDynamicSharedMemorySize, NAIVE_MLSTM_LDS);
        (void)hipGetLastError();
        grid = cus;
    }
    if (grid < 0) return;
    Args a{};
    for (int i = 0; i < 16; ++i) a.in[i] = (const float*)d_in[i];
    a.out = (float*)d_out; a.ws = (unsigned char*)d_ws;
    unsigned char* ws = (unsigned char*)d_ws;
    if (hipMemsetAsync((char*)d_ws + WS_CTL, 0, CTL_ZERO_BYTES, stream) != hipSuccess) { fprintf(stderr, "kernel_launch: memset failed\n"); return; }
    int li = 0;
    auto launch = [&](int lo, int hi) { a.ph_lo = lo; a.ph_hi = hi; a.li = li++; hipLaunchKernelGGL(skel_fwd, dim3(grid), dim3(NTHREADS), LDS_BYTES, stream, a); };
    launch(0, 6);
}
```

```cpp
#include <hip/hip_runtime.h>
#include <cstdio>
#include <cstdint>

#define LAS __attribute__((address_space(3)))
#define GAS __attribute__((address_space(1)))
typedef unsigned short bf16_t;
typedef short bf16x8 __attribute__((ext_vector_type(8)));
typedef float f32x4 __attribute__((ext_vector_type(4)));
typedef float f32x2 __attribute__((ext_vector_type(2)));
typedef unsigned u32x4 __attribute__((ext_vector_type(4)));
typedef unsigned u32x2 __attribute__((ext_vector_type(2)));

constexpr int BATCH = 8, SEQ = 2048, DM = 2048, M = BATCH * SEQ;
constexpr int NCOLS = 7512, NP = 7680;
constexpr int HA = 8, DHA = 128, DC = 256, HIDX = 16, DIDX = 64, NSEL = 256;
constexpr int HM = 4, DVM = 256, DKM = 128, CHUNK = 64, NCHUNK = SEQ / CHUNK;
constexpr float LN_EPS = 1e-5f;
constexpr float ALPHA = 1.189207115002721f;
constexpr float LOG2E = 1.4426950408889634f;
constexpr float QSCALE = 0.08838834764831845f * LOG2E;
constexpr int O_QA = 0, O_CKV = 1024, O_ZA = 1280, O_QI = 2304, O_KI = 3328, O_WI = 3392, O_QM = 3408, O_KM = 3920, O_VM = 4432, O_IM = 5456, O_FM = 5460, O_OM = 5464, O_ZM = 6488;
__host__ __device__ __forceinline__ int win_src(int np) {
    const int t = np >> 8, lc = np & 255;
    if (t < 4) return O_QA + np;
    if (t == 4) return O_CKV + lc;
    if (t < 9) return O_ZA + (np - 5 * 256);
    if (t < 13) return O_QI + (np - 9 * 256);
    if (t == 13) {
        if (lc < 32) return O_KI + lc;
        if (lc >= 128 && lc < 160) return O_KI + 32 + (lc - 128);
        if (lc >= 32 && lc < 48) return O_WI + (lc - 32);
        if (lc >= 48 && lc < 52) return O_IM + (lc - 48);
        if (lc >= 52 && lc < 56) return O_FM + (lc - 52);
        return -1;
    }
    if (t < 16) return O_QM + (np - 14 * 256);
    if (t < 18) return O_KM + (np - 16 * 256);
    if (t < 22) return O_VM + (np - 18 * 256);
    { const int j = t - 22; return lc < 128 ? O_OM + 128 * j + lc : O_ZM + 128 * j + (lc - 128); }
}

constexpr size_t MiB = 1u << 20;
constexpr size_t WS_CTL = 0, CTL_ZERO_BYTES = 1 * MiB;
constexpr size_t WS_XB = 1 * MiB;
constexpr size_t WS_Y = WS_XB;
constexpr size_t WS_WINT = 65 * MiB;
constexpr size_t WS_WOUTT = 95 * MiB;
constexpr size_t WS_WKVT = 103 * MiB;
constexpr size_t WS_Q = 104 * MiB;
constexpr size_t WS_C = 136 * MiB;
constexpr size_t WS_SZA = 144 * MiB;
constexpr size_t WS_QI = 176 * MiB;
constexpr size_t WS_KI = 208 * MiB;
constexpr size_t WS_WI = 210 * MiB;
constexpr size_t WS_IFG = 211 * MiB;
constexpr size_t WS_QKM = 212 * MiB;
constexpr size_t WS_VM = 244 * MiB;
constexpr size_t WS_GM = 276 * MiB;
constexpr size_t WS_MASK = 308 * MiB;
constexpr size_t WS_PAR = 312 * MiB;
constexpr int P_KVG = 0, P_LNG = 256, P_LNB = 320, P_RB = 384, P_CW = 640, P_CB = 4736, P_MHG = 5760, P_BI = 6784, P_BF = 6788, P_LG = 6800, P_LB = 8848, P_TOTAL = 10896;
constexpr size_t WS_NST = 313 * MiB;
constexpr size_t WS_DBG = 316 * MiB;
constexpr size_t WS_END = 324 * MiB;
constexpr size_t OUT_K = 64 * MiB, OUT_V = 96 * MiB;

__device__ __forceinline__ int lane_id_() { return (int)__builtin_amdgcn_mbcnt_hi(~0u, __builtin_amdgcn_mbcnt_lo(~0u, 0u)); }
namespace pg8 {
constexpr int BM = 256, BK = 64, HALF = 128, HTB = HALF * BK * 2, STAGE_BYTES = 8 * HTB, NXCD = 8, WGM = 8;
__host__ __device__ __forceinline__ int lds_byte(int r, int c) { const int st = (r >> 4) * 2 + (c >> 5), rr = r & 15, cc = c & 31, ob = rr * 64 + cc * 2; return st * 1024 + (ob ^ (((ob >> 9) & 1) << 5)); }
__host__ __device__ __forceinline__ void stage_rc(int b, int& R, int& C) { const int st = b / 1024, sb = b % 1024, swz = sb ^ (((sb >> 9) & 1) << 5); R = (st >> 1) * 16 + swz / 64; C = (st & 1) * 32 + (swz % 64) / 2; }
__host__ __device__ __forceinline__ int perm32(int rho) { const int n = rho >> 4, i = rho & 15; return 8 * (i >> 2) + 4 * n + (i & 3); }
struct Unit { int pm, pn; };
struct Gemm { const bf16_t* A; const bf16_t* Bt; int M, N, K; };
struct StaticOrder {
    int nM, nN, nwg, G, c;
    __host__ __device__ void init(int M_, int N_, int G_, int c_) { nM = M_ / BM; nN = N_ / BM; nwg = nM * nN; G = G_; c = c_; }
    __host__ __device__ bool next(int i, Unit& u) const {
        const long L = (long)i * G + c; if (L >= nwg) return false;
        int wgid = (int)L; { const int q = nwg / NXCD, r = nwg % NXCD, xcd = wgid % NXCD, off = wgid / NXCD; wgid = (xcd < r ? xcd * (q + 1) : r * (q + 1) + (xcd - r) * q) + off; }
        const int nig = WGM * nN, gid = wgid / nig, fm = gid * WGM, gsz = (nM - fm) < WGM ? (nM - fm) : WGM;
        u.pm = fm + ((wgid % nig) % gsz); u.pn = (wgid % nig) / gsz; return true;
    }
};
typedef float f32x2_t_ __attribute__((ext_vector_type(2))); typedef __bf16 bf16x2_t_ __attribute__((ext_vector_type(2)));
__device__ __forceinline__ unsigned cvt_pk_bf16(float lo, float hi) { f32x2_t_ v = {lo, hi}; bf16x2_t_ b = __builtin_convertvector(v, bf16x2_t_); return __builtin_bit_cast(unsigned, b); }

template <class Epi, class Sched, bool ALIGN_EPI = true, bool SP2 = true>
__device__ __forceinline__ void gemm_phase(LAS unsigned char* lds, const Gemm g, const Sched& S, const Epi& E, int wave_) {
    int tid = wave_ * 64 + lane_id_(); asm volatile("" : "+v"(tid));
    const int wid = __builtin_amdgcn_readfirstlane(tid >> 6), lane = tid & 63, wr = wid >> 2, wc = wid & 3, fr = lane & 15, fq = lane >> 4;
    const int K = g.K, nt = K / BK;
    unsigned voffA[2], voffB[2];
#pragma unroll
    for (int i = 0; i < 2; ++i) { int R, C; stage_rc(tid * 16 + i * 8192, R, C); const int Rb = Epi::PERM ? ((R & ~31) + perm32(R & 31)) : R;
        voffA[i] = (unsigned)(R * K + C) * 2u; voffB[i] = (unsigned)(Rb * K + C) * 2u; }
    const size_t kstep = (size_t)(BK * 2);
    const size_t hstep = (size_t)HALF * K * 2;
    const size_t tstep = 2 * hstep;
    const unsigned ldsw = (unsigned)wid * 1024u;
    const int aoff = lds_byte(wr * 64 + fr, fq * 8), boff = lds_byte(wc * 32 + fr, fq * 8);
#define PG8_SA(b, h) (((b) * 2 + (h)) * HTB)
#define PG8_SB(b, h) ((4 + (b) * 2 + (h)) * HTB)
#define PG8_STAGE(bufoff, gbase, voff) do { _Pragma("unroll") for (int _i = 0; _i < 2; ++_i) \
        __builtin_amdgcn_global_load_lds((const unsigned*)((const char*)(gbase) + (voff)[_i]), (LAS unsigned*)(lds + (bufoff) + ldsw + _i * 8192), 16, 0, 0); } while (0)
#define PG8_LDA(dst, b, h) do { _Pragma("unroll") for (int m = 0; m < 4; ++m) _Pragma("unroll") for (int k = 0; k < 2; ++k) dst[m][k] = *(const LAS bf16x8*)(lds + PG8_SA(b, h) + aoff + m * 2048 + k * 1024); } while (0)
#define PG8_LDB(dst, b, h) do { _Pragma("unroll") for (int n = 0; n < 2; ++n) _Pragma("unroll") for (int k = 0; k < 2; ++k) dst[n][k] = *(const LAS bf16x8*)(lds + PG8_SB(b, h) + boff + n * 2048 + k * 1024); } while (0)
#define PG8_MMA(ai, bj, At, Bt) do { __builtin_amdgcn_s_setprio(1); _Pragma("unroll") for (int m = 0; m < 4; ++m) _Pragma("unroll") for (int n = 0; n < 2; ++n) _Pragma("unroll") for (int k = 0; k < 2; ++k) \
        acc[ai][bj][m][n] = __builtin_amdgcn_mfma_f32_16x16x32_bf16(Bt[n][k], At[m][k], acc[ai][bj][m][n], 0, 0, 0); __builtin_amdgcn_s_setprio(0); } while (0)
#define PG8_WAIT_V(n) asm volatile("s_waitcnt vmcnt(" #n ")" ::: "memory")
#define PG8_WAIT_L(n) asm volatile("s_waitcnt lgkmcnt(" #n ")" ::: "memory")
#define PG8_BAR __builtin_amdgcn_s_barrier()
#define PG8_SCHED __builtin_amdgcn_sched_barrier(0)
    Unit cur, nxt; int ui = 0;
    if (!S.next(0, cur)) return;
    f32x4 acc[2][2][4][2];
#pragma unroll
    for (int a = 0; a < 2; ++a)
#pragma unroll
        for (int b = 0; b < 2; ++b)
#pragma unroll
            for (int m = 0; m < 4; ++m)
#pragma unroll
                for (int n = 0; n < 2; ++n) acc[a][b][m][n] = (f32x4){0.f, 0.f, 0.f, 0.f};
    bf16x8 At[4][2], B0[2][2], B1[2][2];
    const char* cA = (const char*)g.A + (size_t)cur.pm * tstep; const char* cB = (const char*)g.Bt + (size_t)cur.pn * tstep;
    if constexpr (SP2) {
        PG8_STAGE(PG8_SB(0, 0), cB, voffB); PG8_STAGE(PG8_SB(0, 1), cB + hstep, voffB); PG8_STAGE(PG8_SA(0, 0), cA, voffA); PG8_STAGE(PG8_SA(0, 1), cA + hstep, voffA);
        if (wr == 1) PG8_BAR;
        PG8_WAIT_V(2); PG8_BAR;
        PG8_STAGE(PG8_SB(1, 0), cB + kstep, voffB); PG8_STAGE(PG8_SA(1, 0), cA + kstep, voffA); PG8_STAGE(PG8_SB(1, 1), cB + hstep + kstep, voffB);
        PG8_WAIT_V(6); PG8_BAR;
    } else {
        PG8_STAGE(PG8_SB(0, 0), cB, voffB); PG8_STAGE(PG8_SA(0, 0), cA, voffA); PG8_STAGE(PG8_SB(0, 1), cB + hstep, voffB); PG8_STAGE(PG8_SA(0, 1), cA + hstep, voffA);
        if (wr == 1) PG8_BAR;
        PG8_WAIT_V(4); PG8_BAR;
        PG8_STAGE(PG8_SB(1, 0), cB + kstep, voffB); PG8_STAGE(PG8_SA(1, 0), cA + kstep, voffA); PG8_STAGE(PG8_SB(1, 1), cB + hstep + kstep, voffB);
        PG8_WAIT_V(6); PG8_BAR;
    }
    for (;;) {
        const bool has_next = S.next(ui + 1, nxt);
        const char* nA = has_next ? (const char*)g.A + (size_t)nxt.pm * tstep : cA; const char* nB = has_next ? (const char*)g.Bt + (size_t)nxt.pn * tstep : cB;
#pragma unroll 1
        for (int t = 0; t < nt; t += 2) {
            const bool last = (t == nt - 2);
            const char* a1 = cA + (size_t)(t + 1) * kstep;
            const char* a2 = last ? nA : cA + (size_t)(t + 2) * kstep; const char* b2 = last ? nB : cB + (size_t)(t + 2) * kstep;
            const char* a3 = a2 + kstep; const char* b3 = b2 + kstep;
            if constexpr (SP2) {
            PG8_LDB(B0, 0, 0); PG8_LDB(B1, 0, 1); PG8_SCHED; PG8_LDA(At, 0, 0); PG8_STAGE(PG8_SA(1, 1), a1 + hstep, voffA);
            PG8_WAIT_V(8); PG8_WAIT_L(0); PG8_BAR; PG8_MMA(0, 0, At, B0); PG8_MMA(0, 1, At, B1); PG8_BAR; PG8_SCHED;
            PG8_LDA(At, 0, 1); PG8_STAGE(PG8_SB(0, 0), b2, voffB); PG8_STAGE(PG8_SB(0, 1), b2 + hstep, voffB); PG8_STAGE(PG8_SA(0, 0), a2, voffA);
            PG8_WAIT_V(8); PG8_WAIT_L(0); PG8_BAR; PG8_MMA(1, 0, At, B0); PG8_MMA(1, 1, At, B1); PG8_BAR; PG8_SCHED;
            PG8_LDB(B0, 1, 0); PG8_LDB(B1, 1, 1); PG8_SCHED; PG8_LDA(At, 1, 0); PG8_STAGE(PG8_SA(0, 1), a2 + hstep, voffA);
            PG8_WAIT_V(8); PG8_WAIT_L(0); PG8_BAR; PG8_MMA(0, 0, At, B0); PG8_MMA(0, 1, At, B1); PG8_BAR; PG8_SCHED;
            PG8_LDA(At, 1, 1); PG8_STAGE(PG8_SB(1, 0), b3, voffB); PG8_STAGE(PG8_SB(1, 1), b3 + hstep, voffB); PG8_STAGE(PG8_SA(1, 0), a3, voffA);
            PG8_WAIT_V(8); PG8_WAIT_L(0); PG8_BAR; PG8_MMA(1, 0, At, B0); PG8_MMA(1, 1, At, B1); PG8_BAR; PG8_SCHED;
            } else {
            PG8_LDB(B0, 0, 0); PG8_SCHED; PG8_LDA(At, 0, 0); PG8_STAGE(PG8_SA(1, 1), a1 + hstep, voffA);
            PG8_WAIT_L(8); PG8_BAR; PG8_WAIT_L(0); PG8_MMA(0, 0, At, B0); PG8_BAR; PG8_SCHED;
            PG8_LDB(B1, 0, 1); PG8_STAGE(PG8_SB(0, 0), b2, voffB);
            PG8_BAR; PG8_WAIT_L(0); PG8_MMA(0, 1, At, B1); PG8_BAR;
            PG8_LDA(At, 0, 1); PG8_STAGE(PG8_SA(0, 0), a2, voffA);
            PG8_BAR; PG8_WAIT_L(0); PG8_MMA(1, 0, At, B0); PG8_BAR; PG8_SCHED;
            PG8_STAGE(PG8_SB(0, 1), b2 + hstep, voffB);
            PG8_WAIT_V(6); PG8_BAR; PG8_MMA(1, 1, At, B1); PG8_BAR;
            PG8_LDB(B0, 1, 0); PG8_SCHED; PG8_LDA(At, 1, 0); PG8_STAGE(PG8_SA(0, 1), a2 + hstep, voffA);
            PG8_WAIT_L(8); PG8_BAR; PG8_WAIT_L(0); PG8_MMA(0, 0, At, B0); PG8_BAR; PG8_SCHED;
            PG8_LDB(B1, 1, 1); PG8_STAGE(PG8_SB(1, 0), b3, voffB);
            PG8_BAR; PG8_WAIT_L(0); PG8_MMA(0, 1, At, B1); PG8_BAR;
            PG8_LDA(At, 1, 1); PG8_STAGE(PG8_SA(1, 0), a3, voffA);
            PG8_BAR; PG8_WAIT_L(0); PG8_MMA(1, 0, At, B0); PG8_BAR; PG8_SCHED;
            PG8_STAGE(PG8_SB(1, 1), b3 + hstep, voffB);
            PG8_WAIT_V(6); PG8_BAR; PG8_MMA(1, 1, At, B1); PG8_BAR;
            }
        }
        if constexpr (ALIGN_EPI) { if (wr == 0) PG8_BAR; }
        E(acc, cur, wr, wc, fr, fq, lds + STAGE_BYTES);
        if (!has_next) break;
#pragma unroll
        for (int a = 0; a < 2; ++a)
#pragma unroll
            for (int b = 0; b < 2; ++b)
#pragma unroll
                for (int m = 0; m < 4; ++m)
#pragma unroll
                    for (int n = 0; n < 2; ++n) acc[a][b][m][n] = (f32x4){0.f, 0.f, 0.f, 0.f};
        cur = nxt; cA = nA; cB = nB; ++ui;
        if constexpr (ALIGN_EPI) { if (wr == 1) PG8_BAR; }
    }
    PG8_WAIT_V(0);
    if constexpr (!ALIGN_EPI) { if (wr == 0) PG8_BAR; }
    PG8_BAR;
    asm volatile("" ::: "memory");
#undef PG8_SA
#undef PG8_SB
#undef PG8_STAGE
#undef PG8_LDA
#undef PG8_LDB
#undef PG8_MMA
#undef PG8_WAIT_V
#undef PG8_WAIT_L
#undef PG8_BAR
#undef PG8_SCHED
}
}

__device__ __forceinline__ int lane_id() { return (int)__builtin_amdgcn_mbcnt_hi(~0u, __builtin_amdgcn_mbcnt_lo(~0u, 0u)); }
__device__ __forceinline__ float sigmoid_f(float v) { return __builtin_amdgcn_rcpf(1.f + __expf(-v)); }
__device__ __forceinline__ float silu_f(float v) { return v * sigmoid_f(v); }
__device__ __forceinline__ unsigned f2bf(float f) { unsigned u = __builtin_bit_cast(unsigned, f); return (u + 0x7fffu + ((u >> 16) & 1u)) >> 16; }
__device__ __forceinline__ unsigned pk2(float lo, float hi) { return f2bf(lo) | (f2bf(hi) << 16); }
__device__ __forceinline__ float bf2f(bf16_t b) { return __builtin_bit_cast(float, ((unsigned)b) << 16); }
__device__ __forceinline__ int t5_bucket(int n) {
    if (n < 16) return n;
    const int l = 16 + (int)(logf((float)n * (1.f / 16.f)) * (16.f / 2.0794415416798357f));
    return l < 31 ? l : 31;
}
__device__ __forceinline__ float log_sigmoid_f(float x) { return fminf(x, 0.f) - log1pf(expf(-fabsf(x))); }

using pg8::Unit; using pg8::cvt_pk_bf16;
template <int ACT  > __device__ __forceinline__ void store_tile_bf16(const f32x4 (&acc)[2][2][4][2], bf16_t* base, int ld, float sc, int wr, int wc, int fr, int fq) {
    bf16_t* p0 = base + (size_t)(wr * 64 + fr) * ld + wc * 32 + 8 * fq;
#pragma unroll
    for (int ai = 0; ai < 2; ++ai)
#pragma unroll
        for (int m = 0; m < 4; ++m) { bf16_t* rowp = p0 + (size_t)(ai * 128 + m * 16) * ld;
#pragma unroll
            for (int bj = 0; bj < 2; ++bj) { f32x4 v0 = acc[ai][bj][m][0], v1 = acc[ai][bj][m][1];
                if (ACT == 1) {
#pragma unroll
                    for (int j = 0; j < 4; ++j) { v0[j] = silu_f(v0[j]); v1[j] = silu_f(v1[j]); } }
                else { v0 = v0 * sc; v1 = v1 * sc; }
                u32x4 w; w.x = cvt_pk_bf16(v0[0], v0[1]); w.y = cvt_pk_bf16(v0[2], v0[3]); w.z = cvt_pk_bf16(v1[0], v1[1]); w.w = cvt_pk_bf16(v1[2], v1[3]);
                *(u32x4*)(rowp + bj * 128) = w; } }
}

struct Epi1 {
    static constexpr bool PERM = true;
    unsigned char* ws;
    __device__ __forceinline__ void operator()(const f32x4 (&acc)[2][2][4][2], const Unit& u, int wr, int wc, int fr, int fq, LAS unsigned char* xl) const {
        { int l_ = lane_id(); asm volatile("" : "+v"(l_)); fr = l_ & 15; fq = (l_ >> 4) & 3; }
        const int pn = u.pn; const size_t r0 = (size_t)u.pm * 256;
        bf16_t* const Q = (bf16_t*)(ws + WS_Q); bf16_t* const C = (bf16_t*)(ws + WS_C); bf16_t* const SZA = (bf16_t*)(ws + WS_SZA); bf16_t* const QI = (bf16_t*)(ws + WS_QI);
        bf16_t* const KI = (bf16_t*)(ws + WS_KI); bf16_t* const QKM = (bf16_t*)(ws + WS_QKM); bf16_t* const VM = (bf16_t*)(ws + WS_VM); bf16_t* const GM = (bf16_t*)(ws + WS_GM);
        float* const WI = (float*)(ws + WS_WI); float* const IFG = (float*)(ws + WS_IFG);
        const float* const kvg = (const float*)(ws + WS_PAR) + P_KVG; const float* const lng = (const float*)(ws + WS_PAR) + P_LNG; const float* const lnb = (const float*)(ws + WS_PAR) + P_LNB;
        if (pn < 4) { store_tile_bf16<0>(acc, Q + r0 * 1024 + pn * 256, 1024, QSCALE, wr, wc, fr, fq); return; }
        if (pn == 4) {
            LAS float* P = (LAS float*)xl;
#pragma unroll
            for (int ai = 0; ai < 2; ++ai)
#pragma unroll
                for (int m = 0; m < 4; ++m) { float s = 0.f;
#pragma unroll
                    for (int bj = 0; bj < 2; ++bj)
#pragma unroll
                        for (int n = 0; n < 2; ++n) { const f32x4 x = acc[ai][bj][m][n]; s += (x[0] * x[0] + x[1] * x[1]) + (x[2] * x[2] + x[3] * x[3]); }
                    s += __shfl_xor(s, 16); s += __shfl_xor(s, 32);
                    if (fq == 0) P[(ai * 128 + wr * 64 + m * 16 + fr) * 4 + wc] = s; }
            asm volatile("s_waitcnt lgkmcnt(0)" ::: "memory"); __builtin_amdgcn_s_barrier(); asm volatile("" ::: "memory");
            const int c0 = wc * 32 + 8 * fq;
            f32x4 g[2][2];
#pragma unroll
            for (int bj = 0; bj < 2; ++bj) { g[bj][0] = *(const f32x4*)(kvg + bj * 128 + c0); g[bj][1] = *(const f32x4*)(kvg + bj * 128 + c0 + 4); }
#pragma unroll
            for (int ai = 0; ai < 2; ++ai)
#pragma unroll
                for (int m = 0; m < 4; ++m) { const int r = ai * 128 + wr * 64 + m * 16 + fr;
                    const f32x4 pp = *(const LAS f32x4*)(P + r * 4);
                    const float rstd = rsqrtf(((pp[0] + pp[1]) + (pp[2] + pp[3])) * (1.f / 256.f) + LN_EPS);
                    bf16_t* rowp = C + (r0 + r) * 256 + c0;
#pragma unroll
                    for (int bj = 0; bj < 2; ++bj) { const f32x4 v0 = acc[ai][bj][m][0] * rstd * g[bj][0], v1 = acc[ai][bj][m][1] * rstd * g[bj][1];
                        u32x4 w; w.x = cvt_pk_bf16(v0[0], v0[1]); w.y = cvt_pk_bf16(v0[2], v0[3]); w.z = cvt_pk_bf16(v1[0], v1[1]); w.w = cvt_pk_bf16(v1[2], v1[3]);
                        *(u32x4*)(rowp + bj * 128) = w; } }
            asm volatile("s_waitcnt lgkmcnt(0)" ::: "memory"); __builtin_amdgcn_s_barrier(); asm volatile("" ::: "memory");
            return;
        }
        if (pn < 9) { store_tile_bf16<1>(acc, SZA + r0 * 1024 + (pn - 5) * 256, 1024, 1.f, wr, wc, fr, fq); return; }
        if (pn < 13) { store_tile_bf16<0>(acc, QI + r0 * 1024 + (pn - 9) * 256, 1024, 0.125f, wr, wc, fr, fq); return; }
        if (pn == 13) {
            if (wc == 0) {
                f32x4 g[2][2], bb[2][2];
#pragma unroll
                for (int bj = 0; bj < 2; ++bj)
#pragma unroll
                    for (int n = 0; n < 2; ++n) { g[bj][n] = *(const f32x4*)(lng + 32 * bj + 8 * fq + 4 * n); bb[bj][n] = *(const f32x4*)(lnb + 32 * bj + 8 * fq + 4 * n); }
#pragma unroll
                for (int ai = 0; ai < 2; ++ai)
#pragma unroll
                    for (int m = 0; m < 4; ++m) { float s = 0.f;
#pragma unroll
                        for (int bj = 0; bj < 2; ++bj)
#pragma unroll
                            for (int n = 0; n < 2; ++n) { const f32x4 x = acc[ai][bj][m][n]; s += (x[0] + x[1]) + (x[2] + x[3]); }
                        s += __shfl_xor(s, 16); s += __shfl_xor(s, 32);
                        const float mu = s * (1.f / 64.f); float q = 0.f;
#pragma unroll
                        for (int bj = 0; bj < 2; ++bj)
#pragma unroll
                            for (int n = 0; n < 2; ++n) { const f32x4 d = acc[ai][bj][m][n] - mu; q += (d[0] * d[0] + d[1] * d[1]) + (d[2] * d[2] + d[3] * d[3]); }
                        q += __shfl_xor(q, 16); q += __shfl_xor(q, 32);
                        const float rstd = rsqrtf(q * (1.f / 64.f) + LN_EPS);
                        bf16_t* rowp = KI + (r0 + ai * 128 + wr * 64 + m * 16 + fr) * 64 + 8 * fq;
#pragma unroll
                        for (int bj = 0; bj < 2; ++bj) { const f32x4 v0 = (acc[ai][bj][m][0] - mu) * rstd * g[bj][0] + bb[bj][0], v1 = (acc[ai][bj][m][1] - mu) * rstd * g[bj][1] + bb[bj][1];
                            u32x4 w; w.x = cvt_pk_bf16(v0[0], v0[1]); w.y = cvt_pk_bf16(v0[2], v0[3]); w.z = cvt_pk_bf16(v1[0], v1[1]); w.w = cvt_pk_bf16(v1[2], v1[3]);
                            *(u32x4*)(rowp + bj * 32) = w; } }
            } else if (wc == 1) {
#pragma unroll
                for (int ai = 0; ai < 2; ++ai)
#pragma unroll
                    for (int m = 0; m < 4; ++m) { const size_t r = r0 + ai * 128 + wr * 64 + m * 16 + fr;
                        if (fq < 2) { *(f32x4*)(WI + r * 16 + 8 * fq) = acc[ai][0][m][0] * 0.25f; *(f32x4*)(WI + r * 16 + 8 * fq + 4) = acc[ai][0][m][1] * 0.25f; }
                        else if (fq == 2) { *(f32x4*)(IFG + r * 8) = acc[ai][0][m][0]; *(f32x4*)(IFG + r * 8 + 4) = acc[ai][0][m][1]; } }
            }
            return;
        }
        if (pn < 18) { store_tile_bf16<0>(acc, QKM + r0 * 1024 + (pn - 14) * 256, 1024, 1.f, wr, wc, fr, fq); return; }
        if (pn < 22) { store_tile_bf16<0>(acc, VM + r0 * 1024 + (pn - 18) * 256, 1024, 1.f, wr, wc, fr, fq); return; }
        {
            bf16_t* p0 = GM + (r0 + wr * 64 + fr) * 1024 + (pn - 22) * 128 + wc * 32 + 8 * fq;
#pragma unroll
            for (int ai = 0; ai < 2; ++ai)
#pragma unroll
                for (int m = 0; m < 4; ++m) { f32x4 v0, v1;
#pragma unroll
                    for (int j = 0; j < 4; ++j) { v0[j] = sigmoid_f(acc[ai][0][m][0][j]) * silu_f(acc[ai][1][m][0][j]); v1[j] = sigmoid_f(acc[ai][0][m][1][j]) * silu_f(acc[ai][1][m][1][j]); }
                    u32x4 w; w.x = cvt_pk_bf16(v0[0], v0[1]); w.y = cvt_pk_bf16(v0[2], v0[3]); w.z = cvt_pk_bf16(v1[0], v1[1]); w.w = cvt_pk_bf16(v1[2], v1[3]);
                    *(u32x4*)(p0 + (size_t)(ai * 128 + m * 16) * 1024) = w; }
        }
    }
};
struct EpiKV {
    static constexpr bool PERM = true;
    bf16_t *Kb, *Vb;
    __device__ __forceinline__ void operator()(const f32x4 (&acc)[2][2][4][2], const Unit& u, int wr, int wc, int fr, int fq, LAS unsigned char*) const {
        { int l_ = lane_id(); asm volatile("" : "+v"(l_)); fr = l_ & 15; fq = (l_ >> 4) & 3; }
        bf16_t* base = (u.pn < 4 ? Kb + u.pn * 256 : Vb + (u.pn - 4) * 256) + (size_t)u.pm * 256 * 1024;
        store_tile_bf16<0>(acc, base, 1024, 1.f, wr, wc, fr, fq);
    }
};
struct EpiOut {
    static constexpr bool PERM = false;
    const float* x; float* out;
    __device__ __forceinline__ void operator()(const f32x4 (&acc)[2][2][4][2], const Unit& u, int wr, int wc, int fr, int fq, LAS unsigned char*) const {
        { int l_ = lane_id(); asm volatile("" : "+v"(l_)); fr = l_ & 15; fq = (l_ >> 4) & 3; }
        const size_t off0 = ((size_t)u.pm * 256 + wr * 64 + fr) * DM + u.pn * 256 + wc * 32 + 4 * fq;
#pragma unroll
        for (int ai = 0; ai < 2; ++ai)
#pragma unroll
            for (int m = 0; m < 4; ++m) { const size_t off = off0 + (size_t)(ai * 128 + m * 16) * DM;
#pragma unroll
                for (int bj = 0; bj < 2; ++bj)
#pragma unroll
                    for (int n = 0; n < 2; ++n) { const f32x4 xv = *(const f32x4*)(x + off + bj * 128 + n * 16);
                        *(f32x4*)(out + off + bj * 128 + n * 16) = xv * ALPHA + acc[ai][bj][m][n]; } }
    }
};


#define XB_TMO      128
#define XB_XCNT(j)  (256  + 64 * (j))
#define XB_XSUB(j)  (1280 + 64 * (j))
#define XB_XGEN(j)  (2304 + 64 * (j))
#define XB_TOP      3328
#define XB_TOPGEN   3392
#define XCD_BAR_WORDS 3456
#define XB_SPIN_CAP (1u << 18)
__device__ __forceinline__ unsigned xb_ld(unsigned* p)              { return __hip_atomic_load(p, __ATOMIC_RELAXED, __HIP_MEMORY_SCOPE_AGENT); }
__device__ __forceinline__ unsigned xb_add(unsigned* p, unsigned v) { return __hip_atomic_fetch_add(p, v, __ATOMIC_RELAXED, __HIP_MEMORY_SCOPE_AGENT); }
__device__ __forceinline__ unsigned xb_xcc_id() { return (unsigned)__builtin_amdgcn_s_getreg((3 << 11) | 20) & 0xFu; }
#define XB_SPIN(cond, bar) do { unsigned _sp = 0; while (cond) { __builtin_amdgcn_s_sleep(1); \
    if ((++_sp & 255u) == 0u) { if (xb_ld(&(bar)[XB_TMO])) break; if (_sp > XB_SPIN_CAP) { atomicAdd(&(bar)[XB_TMO], 1u); break; } } } } while (0)
struct XcdBarrier { unsigned* bar; unsigned x; volatile LAS unsigned* st; };
__device__ __forceinline__ XcdBarrier xcd_barrier_post(unsigned* bar, volatile LAS unsigned* st) {
    XcdBarrier b; b.bar = bar; b.x = xb_xcc_id(); b.st = st;
    if (threadIdx.x == 0) (void)xb_add(&bar[XB_XCNT(b.x)], 1u);
    return b;
}
__device__ __forceinline__ void xcd_barrier_complete(unsigned* bar, unsigned x, unsigned& nloc, unsigned& nx) {
    const unsigned G = gridDim.x * gridDim.y * gridDim.z;
    unsigned sum, cnt, mine, sp = 0u;
    for (;;) {
        sum = 0u; cnt = 0u; mine = 0u;
#pragma unroll
        for (unsigned j = 0; j < 16; ++j) { const unsigned c = xb_ld(&bar[XB_XCNT(j)]); sum += c; cnt += (c > 0u) ? 1u : 0u; mine = (j == x) ? c : mine; }
        if (sum == G) break;
        __builtin_amdgcn_s_sleep(1);
        if ((++sp & 255u) == 0u) { if (xb_ld(&bar[XB_TMO])) break; if (sp > XB_SPIN_CAP) { atomicAdd(&bar[XB_TMO], 1u); break; } }
    }
    nloc = mine > 0u ? mine : 1u; nx = cnt > 0u ? cnt : 1u;
}
__device__ __forceinline__ void xcd_barrier(const XcdBarrier& b, int wave_) {
    asm volatile("s_waitcnt vmcnt(0)" ::: "memory");
    __syncthreads();
    if (wave_ == 0 && lane_id() == 0) {
        unsigned* bar = b.bar;
        __builtin_amdgcn_s_waitcnt(0);
        unsigned nloc = b.st[0], nx = b.st[1];
        if (nloc == 0u) { xcd_barrier_complete(bar, b.x, nloc, nx); b.st[0] = nloc; b.st[1] = nx; }
        const unsigned old = xb_add(&bar[XB_XSUB(b.x)], 1u);
        const unsigned gen = old / nloc;
        if (old + 1u == (gen + 1u) * nloc) {
            __builtin_amdgcn_fence(__ATOMIC_RELEASE, "agent");
            asm volatile("s_waitcnt vmcnt(0)" ::: "memory");
            const unsigned og = xb_add(&bar[XB_TOP], 1u);
            const unsigned tg = og / nx;
            if (og + 1u == (tg + 1u) * nx) xb_add(&bar[XB_TOPGEN], 1u);
            else XB_SPIN(xb_ld(&bar[XB_TOPGEN]) == tg, bar);
            __builtin_amdgcn_fence(__ATOMIC_ACQUIRE, "agent");
            xb_add(&bar[XB_XGEN(b.x)], 1u);
            asm volatile("s_waitcnt vmcnt(0)" ::: "memory");
        } else {
            XB_SPIN(xb_ld(&bar[XB_XGEN(b.x)]) == gen, bar);
            __builtin_amdgcn_fence(__ATOMIC_ACQUIRE, "agent");
            asm volatile("s_waitcnt vmcnt(0)" ::: "memory");
        }
    }
    __syncthreads();
}

typedef float f32x16 __attribute__((ext_vector_type(16)));
__device__ __forceinline__ unsigned mono_key(float s) { s = s + 0.0f; const unsigned u = __builtin_bit_cast(unsigned, s); return (u & 0x80000000u) ? ~u : (u | 0x80000000u); }
__device__ __forceinline__ float swap_add(float a, float b) {
    auto rr = __builtin_amdgcn_permlane32_swap(__builtin_bit_cast(unsigned, a), __builtin_bit_cast(unsigned, b), false, false);
    return __builtin_bit_cast(float, (unsigned)rr[0]) + __builtin_bit_cast(float, (unsigned)rr[1]);
}
#define WRITELANE(dst, sval, ln) asm volatile("v_writelane_b32 %0, %1, %2" : "+v"(dst) : "s"(__builtin_amdgcn_readfirstlane((int)(sval))), "i"(ln))
__device__ __forceinline__ unsigned wave_sum_u32(unsigned v) {
    v += (unsigned)__builtin_amdgcn_update_dpp(0, (int)v, 0xB1, 0xF, 0xF, true);
    v += (unsigned)__builtin_amdgcn_update_dpp(0, (int)v, 0x4E, 0xF, 0xF, true);
    v += (unsigned)__builtin_amdgcn_update_dpp(0, (int)v, 0x141, 0xF, 0xF, true);
    v += (unsigned)__builtin_amdgcn_update_dpp(0, (int)v, 0x140, 0xF, 0xF, true);
    return (unsigned)__builtin_amdgcn_readlane((int)v, 0) + (unsigned)__builtin_amdgcn_readlane((int)v, 16) + (unsigned)__builtin_amdgcn_readlane((int)v, 32) + (unsigned)__builtin_amdgcn_readlane((int)v, 48);
}
__device__ __forceinline__ void emit_mask(const unsigned (&K)[32], unsigned T, bool exact, int ng, int t, unsigned long long* mrow, int lane, LAS unsigned long long* wl) {
    if (lane < 32) wl[lane] = 0ull;
    asm volatile("s_waitcnt lgkmcnt(0)" ::: "memory");
    if (exact) {
#pragma unroll
        for (int g = 0; g < 32; ++g) if (g < ng) { const unsigned long long w = __ballot(K[g] >= T); if (lane == 0) wl[g] = w; }
    } else {
        int gt = 0;
#pragma unroll
        for (int g = 0; g < 32; ++g) gt += __popcll(__ballot(K[g] > T));
        int need = NSEL - gt;
#pragma unroll
        for (int g = 0; g < 32; ++g) {
            const unsigned long long gtm = __ballot(K[g] > T); unsigned long long m = __ballot(K[g] == T);
            const int c = __popcll(m), take = c < need ? c : need;
            while (__popcll(m) > take) m &= ~(1ull << (63 - __clzll((long long)m)));
            need -= take;
            const unsigned long long w = gtm | m;
            if (lane == 0) wl[g] = w;
        }
    }
    asm volatile("s_waitcnt lgkmcnt(0)" ::: "memory");
    if (lane < 32) mrow[(size_t)lane * SEQ + t] = wl[lane];
    asm volatile("s_waitcnt lgkmcnt(0)" ::: "memory");
}
__device__ __forceinline__ void select2_store(const unsigned (&K0)[32], const unsigned (&K1)[32], int ng, int t, unsigned long long* mrow, int lane, LAS unsigned long long* wl) {
    unsigned T0 = 0u, T1 = 0u; bool ex0 = false, ex1 = false;
#pragma unroll 1
    for (int bit = 31; bit >= 0; --bit) {
        const unsigned cand0 = ex0 ? 0xffffffffu : (T0 | (1u << bit)), cand1 = ex1 ? 0xffffffffu : (T1 | (1u << bit));
        unsigned c0 = 0u, c1 = 0u;
#pragma unroll
        for (int gg = 0; gg < 8; ++gg) if (4 * gg < ng) {
#pragma unroll
            for (int j = 0; j < 4; ++j) { c0 += K0[4 * gg + j] >= cand0 ? 1u : 0u; c1 += K1[4 * gg + j] >= cand1 ? 1u : 0u; } }
        const unsigned tot = wave_sum_u32(c0 + (c1 << 16)); const int n0 = (int)(tot & 0xffffu), n1 = (int)(tot >> 16);
        if (!ex0) { if (n0 >= NSEL) T0 = cand0; if (n0 == NSEL) ex0 = true; }
        if (!ex1) { if (n1 >= NSEL) T1 = cand1; if (n1 == NSEL) ex1 = true; }
        if (ex0 && ex1) break;
    }
    emit_mask(K0, T0, ex0, ng, t, mrow, lane, wl);
    emit_mask(K1, T1, ex1, ng, t + 1, mrow, lane, wl);
}
__device__ __forceinline__ void topk_unit(const bf16_t* __restrict__ QI, const bf16_t* __restrict__ KI, const float* __restrict__ WI, unsigned long long* mask, int b, int i, int wave, int lane, LAS unsigned long long* wl) {
    const int t0 = i * 16, tq = t0 + 2 * wave;
    const size_t rb = (size_t)b * SEQ;
    unsigned long long* mrow = mask + (size_t)b * 32 * SEQ;
    if (t0 + 15 < NSEL) {
        const int g = lane & 31, t = tq + (lane >> 5), n = t - 64 * g + 1;
        mrow[(size_t)g * SEQ + t] = n >= 64 ? ~0ull : (n <= 0 ? 0ull : ((1ull << n) - 1ull));
        return;
    }
    const int r = lane & 31, hi = lane >> 5;
    bf16x8 A[4];
    { const bf16_t* qp = QI + (rb + tq + (r >> 4)) * 1024 + (r & 15) * 64 + hi * 8;
#pragma unroll
      for (int ks = 0; ks < 4; ++ks) A[ks] = *(const bf16x8*)(qp + ks * 16); }
    float wv[16];
#pragma unroll
    for (int reg = 0; reg < 16; ++reg) { const int hh = (reg & 3) + 8 * ((reg >> 2) & 1) + 4 * hi; wv[reg] = WI[(rb + tq + (reg >> 3)) * 16 + hh]; }
    const int ng = (t0 + 15) / 64 + 1;
    unsigned K0[32], K1[32];
    const GAS bf16_t* kp = (const GAS bf16_t*)KI + (rb + r) * 64 + hi * 8;
    bf16x8 Bc0[4], Bc1[4], Bn0[4], Bn1[4];
#define TK_LOAD(D0, D1) do { asm volatile("" : "+v"(kp)); const GAS bf16_t* kp1_ = kp + 32 * 64; \
        _Pragma("unroll") for (int ks = 0; ks < 4; ++ks) { D0[ks] = *(const GAS bf16x8*)(kp + ks * 16); D1[ks] = *(const GAS bf16x8*)(kp1_ + ks * 16); } kp += 64 * 64; } while (0)
    TK_LOAD(Bc0, Bc1);
#pragma unroll
    for (int g = 0; g < 32; ++g) {
        if (g < ng) {
            if (g + 1 < ng) TK_LOAD(Bn0, Bn1);
            f32x16 a0 = {}, a1 = {};
#pragma unroll
            for (int ks = 0; ks < 4; ++ks) { a0 = __builtin_amdgcn_mfma_f32_32x32x16_bf16(A[ks], Bc0[ks], a0, 0, 0, 0); a1 = __builtin_amdgcn_mfma_f32_32x32x16_bf16(A[ks], Bc1[ks], a1, 0, 0, 0); }
            float p00 = 0.f, p01 = 0.f, p10 = 0.f, p11 = 0.f;
#pragma unroll
            for (int reg = 0; reg < 8; ++reg) { p00 = fmaf(fmaxf(a0[reg], 0.f), wv[reg], p00); p10 = fmaf(fmaxf(a1[reg], 0.f), wv[reg], p10);
                                                p01 = fmaf(fmaxf(a0[reg + 8], 0.f), wv[reg + 8], p01); p11 = fmaf(fmaxf(a1[reg + 8], 0.f), wv[reg + 8], p11); }
            const float sA = swap_add(p00, p01), sB = swap_add(p10, p11);
            auto rr = __builtin_amdgcn_permlane32_swap(__builtin_bit_cast(unsigned, sA), __builtin_bit_cast(unsigned, sB), false, false);
            const float s0 = __builtin_bit_cast(float, (unsigned)rr[0]), s1 = __builtin_bit_cast(float, (unsigned)rr[1]);
            const int lim = tq - 64 * g;
            K0[g] = lane <= lim ? mono_key(s0) : 0u; K1[g] = lane <= lim + 1 ? mono_key(s1) : 0u;
#pragma unroll
            for (int ks = 0; ks < 4; ++ks) { Bc0[ks] = Bn0[ks]; Bc1[ks] = Bn1[ks]; }
        } else { K0[g] = 0u; K1[g] = 0u; }
    }
#undef TK_LOAD
    select2_store(K0, K1, ng, tq, mrow, lane, wl);
}

namespace att {
constexpr int NW = 8, QBLK = 32, KVBLK = 64, QB = NW * QBLK, D = 128, RS = 1024, OS = 2048;
constexpr int SHM_V = KVBLK * D * 2, SHM_K = KVBLK * D * 2;
constexpr int LDS_WS = 2 * SHM_V + 2 * SHM_K, LDS_LUT = LDS_WS + NW * 64 * 4, LDS_TOTAL = LDS_LUT + 512;
constexpr float THRL = 11.5f;
typedef short s16x4 __attribute__((ext_vector_type(4)));
#define KSWZ(row, colB) ((row) * 256 + ((colB) ^ (((row) & 7) << 4)))
#define SBAR() __builtin_amdgcn_sched_barrier(0)
__device__ __forceinline__ int v_st(int k, int c) { const int kk = (k & ~0xC) | ((k & 4) << 1) | ((k & 8) >> 1); return ((kk >> 3) * 4 + (c >> 5)) * 512 + ((kk & 7) * 32 + (c & 31)) * 2; }
__device__ __forceinline__ int v_rd_base(int lane) { return ((lane & 3) << 3) | (((lane >> 2) & 3) << 6) | (((lane >> 4) & 1) << 5) | (((lane >> 5) & 1) << 8); }
constexpr int v_rd_off(int d0, int ks, int half) { return d0 * 512 + ks * 4096 + half * 2048; }
__device__ __forceinline__ int crow(int r, int hi) { return (r & 3) + 8 * (r >> 2) + 4 * hi; }
__device__ __forceinline__ unsigned cvtpk(float lo, float hi) { return pg8::cvt_pk_bf16(lo, hi); }
__device__ __forceinline__ bf16x8 ld8(const bf16_t* p) { return *reinterpret_cast<const bf16x8*>(p); }
__device__ __forceinline__ void apply_mask(f32x16& p0, f32x16& p1, unsigned long long mw, int hi) {
    const unsigned a = (unsigned)mw >> (4 * hi), b = (unsigned)(mw >> 32) >> (4 * hi);
#pragma unroll
    for (int r = 0; r < 16; ++r) { const int c = (r & 3) + 8 * (r >> 2);
        p0[r] = (a & (1u << c)) ? p0[r] : -__builtin_inff();
        p1[r] = (b & (1u << c)) ? p1[r] : -__builtin_inff(); }
}
__device__ __forceinline__ void add_bias(f32x16& p0, f32x16& p1, const float* lut, int dq) {
#pragma unroll
    for (int r = 0; r < 16; ++r) { const int c = (r & 3) + 8 * (r >> 2);
        int i0 = dq - c, i1 = dq - c - 32; i0 = i0 < 0 ? 0 : (i0 > 127 ? 127 : i0); i1 = i1 < 0 ? 0 : (i1 > 127 ? 127 : i1);
        p0[r] += lut[i0]; p1[r] += lut[i1]; }
}
__device__ __forceinline__ void partialSM(f32x16& p0, f32x16& p1, float& m_reg, float& mn, float& alpha) {
    float pmax = p0[0];
#pragma unroll
    for (int r = 1; r < 16; ++r) pmax = fmaxf(pmax, p0[r]);
#pragma unroll
    for (int r = 0; r < 16; ++r) pmax = fmaxf(pmax, p1[r]);
    { auto rr = __builtin_amdgcn_permlane32_swap(__float_as_uint(pmax), __float_as_uint(pmax), false, false);
      pmax = fmaxf(__uint_as_float(rr[0]), __uint_as_float(rr[1])); }
    if (__builtin_expect(__all(pmax - m_reg <= THRL), 1)) { mn = m_reg; alpha = 1.f; }
    else { mn = fmaxf(m_reg, pmax); alpha = __builtin_amdgcn_exp2f(m_reg - mn); m_reg = mn; }
#pragma unroll
    for (int r = 0; r < 16; ++r) { p0[r] = p0[r] - mn; p1[r] = p1[r] - mn; }
#pragma unroll
    for (int r = 0; r < 16; ++r) p0[r] = __builtin_amdgcn_exp2f(p0[r]);
}
__device__ __forceinline__ void finishSM(f32x16& p0, f32x16& p1, float alpha, float& l_reg, bf16x8& pa0, bf16x8& pa1, bf16x8& pa2, bf16x8& pa3) {
#pragma unroll
    for (int r = 0; r < 16; ++r) p1[r] = __builtin_amdgcn_exp2f(p1[r]);
    float ps = 0;
#pragma unroll
    for (int r = 0; r < 16; ++r) ps += p0[r];
#pragma unroll
    for (int r = 0; r < 16; ++r) ps += p1[r];
    { auto rr = __builtin_amdgcn_permlane32_swap(__float_as_uint(ps), __float_as_uint(ps), false, false);
      ps = __uint_as_float(rr[0]) + __uint_as_float(rr[1]); }
    l_reg = l_reg * alpha + ps;
#define PK4(P, B_, OUT) do { unsigned a0 = cvtpk(P[B_+0], P[B_+1]), a1 = cvtpk(P[B_+2], P[B_+3]);                          \
        unsigned b0 = cvtpk(P[B_+4], P[B_+5]), b1 = cvtpk(P[B_+6], P[B_+7]);                                             \
        auto r0 = __builtin_amdgcn_permlane32_swap(a0, b0, false, false); auto r1 = __builtin_amdgcn_permlane32_swap(a1, b1, false, false); \
        u32x4 w = {r0[0], r1[0], r0[1], r1[1]}; OUT = *reinterpret_cast<bf16x8*>(&w); } while (0)
    PK4(p0, 0, pa0); PK4(p0, 8, pa1); PK4(p1, 0, pa2); PK4(p1, 8, pa3);
#undef PK4
}
template <int KB>
__device__ __forceinline__ void qkt(f32x16& p0, f32x16& p1, const char* K_lds, int r32, int hi, const bf16x8* qr) {
    p0 = f32x16{}; p1 = f32x16{};
    const char* kb[4];
#pragma unroll
    for (int dd = 0; dd < 4; ++dd) kb[dd] = K_lds + KB * SHM_K + KSWZ(r32, (dd * 16 + hi * 8) * 2);
#pragma unroll
    for (int d0 = 0; d0 < 8; ++d0) { const char* a = kb[d0 & 3] + (d0 >> 2) * 128;
        bf16x8 b0 = *reinterpret_cast<const bf16x8*>(a);
        bf16x8 b1 = *reinterpret_cast<const bf16x8*>(a + 32 * 256);
        p0 = __builtin_amdgcn_mfma_f32_32x32x16_bf16(b0, qr[d0], p0, 0, 0, 0);
        p1 = __builtin_amdgcn_mfma_f32_32x32x16_bf16(b1, qr[d0], p1, 0, 0, 0); }
}
template <int VB>
__device__ __forceinline__ void pv_tile(f32x16* o, int vb0, bf16x8 pa0, bf16x8 pa1, bf16x8 pa2, bf16x8 pa3) {
#define TRRD(dst, off) asm volatile("ds_read_b64_tr_b16 %0, %1 offset:%2" : "=&v"(dst) : "v"(vb0), "i"(off) : "memory")
#define PV_D0(d0) do { s16x4 l0, l1, l2, l3, h0, h1, h2, h3; constexpr int b_ = VB * SHM_V + v_rd_off(d0, 0, 0); \
        TRRD(l0, b_); TRRD(h0, b_ + 2048); TRRD(l1, b_ + 4096); TRRD(h1, b_ + 6144); TRRD(l2, b_ + 8192); TRRD(h2, b_ + 10240); TRRD(l3, b_ + 12288); TRRD(h3, b_ + 14336); \
        asm volatile("s_waitcnt lgkmcnt(0)" ::: "memory"); SBAR();   \
        o[d0] = __builtin_amdgcn_mfma_f32_32x32x16_bf16(pa0, (bf16x8){l0[0], l0[1], l0[2], l0[3], h0[0], h0[1], h0[2], h0[3]}, o[d0], 0, 0, 0);   \
        o[d0] = __builtin_amdgcn_mfma_f32_32x32x16_bf16(pa1, (bf16x8){l1[0], l1[1], l1[2], l1[3], h1[0], h1[1], h1[2], h1[3]}, o[d0], 0, 0, 0);   \
        o[d0] = __builtin_amdgcn_mfma_f32_32x32x16_bf16(pa2, (bf16x8){l2[0], l2[1], l2[2], l2[3], h2[0], h2[1], h2[2], h2[3]}, o[d0], 0, 0, 0);   \
        o[d0] = __builtin_amdgcn_mfma_f32_32x32x16_bf16(pa3, (bf16x8){l3[0], l3[1], l3[2], l3[3], h3[0], h3[1], h3[2], h3[3]}, o[d0], 0, 0, 0); } while (0)
    PV_D0(0); PV_D0(1); PV_D0(2); PV_D0(3);
#undef PV_D0
#undef TRRD
}
struct BlockRef { const bf16_t* Q; const bf16_t* K; const bf16_t* V; bf16_t* O; const bf16_t* Z; const unsigned long long* MK; int P0; };
struct Seam { bf16x8 qr[8]; bf16x8 st_v0, st_v1, st_k0, st_k1; };
#define ROW(p, k0, rr) ((p) + (size_t)((k0) + (rr)) * RS + sc)
#define VMW() asm volatile("s_waitcnt vmcnt(0)" ::: "memory")
#define VMWN(n) asm volatile("s_waitcnt vmcnt(%0)" :: "i"(n) : "memory")
#define SLOAD_H(Kp, Vp, k0) do { unsigned o_ = soff; asm volatile("" : "+v"(o_)); const char* kp_ = (const char*)(Kp) + (size_t)(k0) * (RS * 2); const char* vp_ = (const char*)(Vp) + (size_t)(k0) * (RS * 2); \
        S.st_v0 = *(const bf16x8*)(vp_ + o_); S.st_v1 = *(const bf16x8*)(vp_ + o_ + 32 * RS * 2); S.st_k0 = *(const bf16x8*)(kp_ + o_); S.st_k1 = *(const bf16x8*)(kp_ + o_ + 32 * RS * 2); } while (0)
#define QLOAD(Qp) do { unsigned o_ = qoff; asm volatile("" : "+v"(o_)); const char* qp_ = (const char*)(Qp); _Pragma("unroll") for (int d0 = 0; d0 < 8; ++d0) S.qr[d0] = *(const bf16x8*)(qp_ + o_ + d0 * 32); } while (0)
#define MLOAD(t) ({ unsigned o_ = moff; asm volatile("" : "+v"(o_)); *(const unsigned long long*)((const char*)cur.MK + (size_t)(t) * (SEQ * 8) + o_); })
#define SWRITE_HK(bf) do { *(bf16x8*)(K_lds + (bf) * SHM_K + kws) = S.st_k0; *(bf16x8*)(K_lds + (bf) * SHM_K + kws + 32 * 256) = S.st_k1; } while (0)
#define SWRITE_HV(bf) do { *(bf16x8*)(V_lds + (bf) * SHM_V + vst0) = S.st_v0; *(bf16x8*)(V_lds + (bf) * SHM_V + vst1) = S.st_v1; } while (0)
#define SWRITE_H(bf) do { SWRITE_HV(bf); SWRITE_HK(bf); } while (0)
__device__ __forceinline__ void prime(const BlockRef& cur, char* lds, Seam& S, const float* rel_bias, int h, int wid) {
    const int lane = lane_id(), tid = wid * 64 + lane, r32 = lane & 31, hi = lane >> 5;
    const int sr = tid >> 4, sc = (tid & 15) * 8, kws = KSWZ(sr, sc * 2); char* K_lds = lds + 2 * SHM_V;
    const unsigned soff = (unsigned)(sr * RS + sc) * 2u, qoff = (unsigned)((wid * QBLK + r32) * RS + hi * 8) * 2u;
    if (tid < 128) ((float*)(lds + LDS_LUT))[tid] = (rel_bias[t5_bucket(tid) * HA + h] - rel_bias[31 * HA + h]) * LOG2E;
    QLOAD(cur.Q);
    SLOAD_H(cur.K, cur.V, 0); VMW(); SWRITE_HK(0);
    __syncthreads();
}
__device__ __forceinline__ void block(const BlockRef& cur, const BlockRef& nxt, char* lds, Seam& S, int wid) {
    int tid = wid * 64 + lane_id(); asm volatile("" : "+v"(tid));
    const int lane = tid & 63, r32 = lane & 31, hi = lane >> 5;
    const int NT = cur.P0 / KVBLK + 4;
    const int qlo = cur.P0 + wid * QBLK, qrow = qlo + r32, qm = qrow - 4 * hi;
    char* V_lds = lds; char* K_lds = lds + 2 * SHM_V;
    float* ws = (float*)(lds + LDS_WS) + wid * 64; float* li_l = ws, * al_l = ws + 32;
    const float* lut = (const float*)(lds + LDS_LUT);
    float m_reg = -1e30f, l_reg = 0; f32x16 o[4] = {};
    const int sr = tid >> 4, sc = (tid & 15) * 8, vst0 = v_st(sr, sc), vst1 = v_st(32 + sr, sc), kws = KSWZ(sr, sc * 2);
    const int vb0 = (int)(uintptr_t)V_lds + v_rd_base(lane);
    const bf16_t* Kh = cur.K; const bf16_t* Vh = cur.V;
    const unsigned soff = (unsigned)(sr * RS + sc) * 2u, qoff = (unsigned)((wid * QBLK + r32) * RS + hi * 8) * 2u, moff = (unsigned)(wid * QBLK + r32) * 8u;
#define RESC(a) do { if (__any((a) < 1.f)) { if (hi == 0) al_l[r32] = (a); asm volatile("s_waitcnt lgkmcnt(0)" ::: "memory");              \
                     for (int d_ = 0; d_ < 4; ++d_) for (int r = 0; r < 16; ++r) o[d_][r] *= al_l[crow(r, hi)]; } } while (0)
#define KBASE(t) ((t) * KVBLK)
#define MASKT(P0_, P1_, mw, t) do { const int kb_ = KBASE(t); if (kb_ + 176 > qlo) add_bias(P0_, P1_, lut, qm - kb_); apply_mask(P0_, P1_, mw, hi); } while (0)
#define SEAM_K0() do { VMWN(8); SWRITE_HK(0); SBAR(); } while (0)
    f32x16 pA0, pA1, pB0, pB1; float mnA, mnB, alA, alB; bf16x8 pa0, pa1, pa2, pa3; unsigned long long mwA, mwB;
    SWRITE_HV(0); SBAR();
    mwA = MLOAD(0);
    if (NT > 1) SLOAD_H(Kh, Vh, KBASE(1));
    SBAR(); qkt<0>(pA0, pA1, K_lds, r32, hi, S.qr);
    MASKT(pA0, pA1, mwA, 0); partialSM(pA0, pA1, m_reg, mnA, alA);
    if (NT > 1) { VMW(); SWRITE_H(1); }
    __syncthreads();
#define HALF_STEP(PX0, PX1, mnX, alX, mwX, PY0, PY1, alY, t, KB, VB, SB) do {                                                 \
        SBAR(); mwX = MLOAD(t); qkt<KB>(PX0, PX1, K_lds, r32, hi, S.qr);                                          \
        finishSM(PY0, PY1, alY, l_reg, pa0, pa1, pa2, pa3); SBAR();                                                           \
        if ((t) + 1 < NT) { SLOAD_H(Kh, Vh, KBASE((t) + 1)); SBAR(); }                                                        \
        pv_tile<VB>(o, vb0, pa0, pa1, pa2, pa3); MASKT(PX0, PX1, mwX, (t)); partialSM(PX0, PX1, m_reg, mnX, alX);             \
        __syncthreads();                                                                                                      \
        if ((t) + 1 < NT) { VMW(); SWRITE_H(SB); }                                                                            \
        RESC(alX); __syncthreads(); } while (0)
    for (int t = 1; t + 1 < NT; t += 2) {
        HALF_STEP(pB0, pB1, mnB, alB, mwB, pA0, pA1, alA, t, 1, 0, 0);
        HALF_STEP(pA0, pA1, mnA, alA, mwA, pB0, pB1, alB, t + 1, 0, 1, 1);
    }
    SBAR(); mwB = MLOAD(NT - 1); qkt<1>(pB0, pB1, K_lds, r32, hi, S.qr); SBAR();
    SLOAD_H(nxt.K, nxt.V, 0); SBAR();
    QLOAD(nxt.Q);
    SBAR();
    finishSM(pA0, pA1, alA, l_reg, pa0, pa1, pa2, pa3); SBAR();
    pv_tile<0>(o, vb0, pa0, pa1, pa2, pa3);
    MASKT(pB0, pB1, mwB, NT - 1); partialSM(pB0, pB1, m_reg, mnB, alB); __syncthreads(); RESC(alB);
    finishSM(pB0, pB1, alB, l_reg, pa0, pa1, pa2, pa3); SBAR(); pv_tile<1>(o, vb0, pa0, pa1, pa2, pa3);
    SBAR(); SEAM_K0();
    if (hi == 0) li_l[r32] = l_reg; asm volatile("s_waitcnt lgkmcnt(0)" ::: "memory");
    float rli[16];
#pragma unroll
    for (int r = 0; r < 16; ++r) rli[r] = __builtin_amdgcn_rcpf(li_l[crow(r, hi)]);
    { int l2 = lane_id(); asm volatile("" : "+v"(l2)); const int e32 = l2 & 31, ehi = (l2 >> 5) & 1;
      const char* Zw = (const char*)cur.Z + (size_t)(wid * QBLK) * (RS * 2); char* Ow = (char*)cur.O + (size_t)(wid * QBLK) * (OS * 2);
      const unsigned zo = (unsigned)(4 * ehi * RS + e32) * 2u, oo = (unsigned)(4 * ehi * OS + e32) * 2u;
#pragma unroll
      for (int r = 0; r < 16; ++r) { const int c = (r & 3) + 8 * (r >> 2);
#pragma unroll
        for (int d0 = 0; d0 < 4; ++d0) { float v = o[d0][r] * rli[r]; float vn = __builtin_bit_cast(float, __builtin_amdgcn_mov_dpp(__builtin_bit_cast(int, v), 0xB1, 0xF, 0xF, true));
            if ((e32 & 1) == 0) { const unsigned zz = *(const unsigned*)(Zw + zo + (c * RS + d0 * 32) * 2);
                v *= __uint_as_float(zz << 16); vn *= __uint_as_float(zz & 0xffff0000u);
                *(unsigned*)(Ow + oo + (c * OS + d0 * 32) * 2) = cvtpk(v, vn); } } } }
    __syncthreads();
#undef RESC
#undef KBASE
#undef MASKT
#undef SEAM_K0
#undef HALF_STEP
}
#undef ROW
#undef VMW
#undef VMWN
#undef SLOAD_H
#undef QLOAD
#undef MLOAD
#undef SWRITE_HK
#undef SWRITE_HV
#undef SWRITE_H
#undef KSWZ
#undef SBAR
}

namespace ml {
constexpr int RSK = 272, RSV = 80, RSS = 144;
typedef short v4i16 __attribute__((ext_vector_type(4)));
__device__ __forceinline__ v4i16 trd(const LAS unsigned char* p) { return __builtin_amdgcn_ds_read_tr16_b64_v4i16((LAS v4i16*)p); }
__device__ __forceinline__ bf16x8 frag_tr(const LAS unsigned char* img, int rs, int kbase, int col0, int lane) {
    const int i = lane & 15, q = i >> 2, p = i & 3, grp = lane >> 4;
    const LAS unsigned char* a = img + (kbase + 8 * grp + q) * rs + (col0 + 4 * p) * 2;
    const v4i16 lo = trd(a), hi = trd(a + 4 * rs);
    return (bf16x8){lo[0], lo[1], lo[2], lo[3], hi[0], hi[1], hi[2], hi[3]};
}
__device__ __forceinline__ float wave_incl_sum(float v, int lane) {
#pragma unroll
    for (int o = 1; o < 64; o <<= 1) { const float t = __shfl_up(v, o); if (lane >= o) v += t; }
    return v;
}
__device__ __forceinline__ float wave_incl_max(float v, int lane) {
#pragma unroll
    for (int o = 1; o < 64; o <<= 1) { const float t = __shfl_up(v, o); if (lane >= o) v = fmaxf(v, t); }
    return v;
}
__device__ __forceinline__ float wave_max(float v) {
#pragma unroll
    for (int o = 1; o < 64; o <<= 1) v = fmaxf(v, __shfl_xor(v, o));
    return v;
}
__device__ __forceinline__ void conv2(const u32x4 (&X)[5], const float (&cw)[4][8], const float (&cb)[8], float (&y0)[8], float (&y1)[8]) {
#pragma unroll
    for (int c = 0; c < 8; ++c) { float x[5];
#pragma unroll
        for (int j = 0; j < 5; ++j) { const unsigned w = X[j][c >> 1]; x[j] = __builtin_bit_cast(float, (c & 1) ? (w & 0xffff0000u) : (w << 16)); }
        float a0 = cb[c], a1 = cb[c];
#pragma unroll
        for (int j = 0; j < 4; ++j) { a0 = fmaf(cw[j][c], x[j], a0); a1 = fmaf(cw[j][c], x[j + 1], a1); }
        y0[c] = silu_f(a0); y1[c] = silu_f(a1); }
}
__device__ __forceinline__ u32x4 pack8f(const float (&y)[8]) { u32x4 w; w.x = pg8::cvt_pk_bf16(y[0], y[1]); w.y = pg8::cvt_pk_bf16(y[2], y[3]); w.z = pg8::cvt_pk_bf16(y[4], y[5]); w.w = pg8::cvt_pk_bf16(y[6], y[7]); return w; }
__device__ __forceinline__ void load5(u32x4 (&X)[5], const bf16_t* QKM, size_t rb, int t, int c) {
#pragma unroll
    for (int j = 0; j < 5; ++j) { const int tt = t - 3 + j; X[j] = tt >= 0 ? *(const u32x4*)(QKM + (rb + tt) * 1024 + c) : (u32x4){0u, 0u, 0u, 0u}; }
}

__device__ __forceinline__ void state_phase(unsigned char* ws, unsigned char* outb, LAS unsigned char* lds, int wave, int vcu) {
    const int lane = lane_id(), tid = wave * 64 + lane, fr = lane & 15, fq = lane >> 4;
    const int b = vcu >> 5, h = (vcu >> 3) & 3, vs = vcu & 7, bh = b * 4 + h;
    const size_t rb = (size_t)b * SEQ;
    const bf16_t* QKM = (const bf16_t*)(ws + WS_QKM); const bf16_t* VM = (const bf16_t*)(ws + WS_VM); const float* IFG = (const float*)(ws + WS_IFG);
    const float* par = (const float*)(ws + WS_PAR);
    bf16_t* CstT = (bf16_t*)outb; float* nst = (float*)(ws + WS_NST + 65536); float* mst = (float*)(ws + WS_NST);
    LAS float* AG = (LAS float*)lds; LAS float* BL = (LAS float*)(lds + 8192); LAS float* ML = BL + 32; LAS float* MM = BL + 64; LAS float* DEC = BL + 96;
    LAS unsigned char* Kimg = lds + 16384; LAS unsigned char* Vimg = lds + 16384 + 64 * RSK;
    const float bi = par[P_BI + h], bfg = par[P_BF + h];
#pragma unroll 1
    for (int j = 0; j < 4; ++j) { const int k = wave + 8 * j; const float* g = IFG + (rb + 64 * k + lane) * 8;
        const float lf = log_sigmoid_f(g[4 + h] + bfg), ii = g[h] + bi;
        const float bcs = wave_incl_sum(lf, lane), bL = __shfl(bcs, 63), a = bL - bcs + ii, mloc = wave_max(a);
        AG[k * 64 + lane] = a; if (lane == 0) { BL[k] = bL; ML[k] = mloc; } }
    __syncthreads();
    if (tid == 0) { float m = 0.f; if (vs == 0) mst[bh * 32] = 0.f;
        for (int k = 0; k < 32; ++k) { const float mn = fmaxf(BL[k] + m, ML[k]); DEC[k] = __expf(BL[k] + m - mn); MM[k] = mn; m = mn; if (vs == 0 && k < 31) mst[bh * 32 + k + 1] = mn; } }
    __syncthreads();
    for (int i = tid; i < 2048; i += 512) AG[i] = __expf(AG[i] - MM[i >> 6]);
    { bf16_t* c0 = CstT + ((size_t)(bh * 32) * 256 + vs * 32) * 128; *(u32x4*)(c0 + tid * 8) = (u32x4){0u, 0u, 0u, 0u};
      if (vs == 0 && tid < 128) nst[(size_t)(bh * 32) * 128 + tid] = 0.f; }
    __syncthreads();
    const int dg = tid & 15, lg = tid >> 4, ck = 512 + h * 128 + 8 * dg;
    float cw[4][8], cb[8];
#pragma unroll
    for (int c = 0; c < 8; ++c) { cb[c] = par[P_CB + ck + c];
#pragma unroll
        for (int j = 0; j < 4; ++j) cw[j][c] = par[P_CW + j * 1024 + ck + c]; }
    f32x4 acc[2] = {{0.f, 0.f, 0.f, 0.f}, {0.f, 0.f, 0.f, 0.f}}, accn = {0.f, 0.f, 0.f, 0.f};
    const bf16x8 ones = {0x3F80, 0x3F80, 0x3F80, 0x3F80, 0x3F80, 0x3F80, 0x3F80, 0x3F80};
    u32x4 X[5], Vr;
    load5(X, QKM, rb, 2 * lg, ck);
    Vr = tid < 256 ? *(const u32x4*)(VM + (rb + (tid >> 2)) * 1024 + h * 256 + vs * 32 + (tid & 3) * 8) : (u32x4){0u, 0u, 0u, 0u};
#pragma unroll 1
    for (int k = 0; k < 31; ++k) {
        const int t0 = 64 * k;
        { float y0[8], y1[8]; conv2(X, cw, cb, y0, y1);
          const float w0 = AG[k * 64 + 2 * lg] * 0.08838834764831845f, w1 = AG[k * 64 + 2 * lg + 1] * 0.08838834764831845f;
#pragma unroll
          for (int c = 0; c < 8; ++c) { y0[c] *= w0; y1[c] *= w1; }
          *(LAS u32x4*)(Kimg + (2 * lg) * RSK + dg * 16) = pack8f(y0); *(LAS u32x4*)(Kimg + (2 * lg + 1) * RSK + dg * 16) = pack8f(y1);
          if (tid < 256) *(LAS u32x4*)(Vimg + (tid >> 2) * RSV + (tid & 3) * 16) = Vr; }
        __syncthreads();
        if (k + 1 < 31) { load5(X, QKM, rb, t0 + 64 + 2 * lg, ck);
            if (tid < 256) Vr = *(const u32x4*)(VM + (rb + t0 + 64 + (tid >> 2)) * 1024 + h * 256 + vs * 32 + (tid & 3) * 8); }
        const float dec = DEC[k];
        acc[0] = acc[0] * dec; acc[1] = acc[1] * dec; accn = accn * dec;
#pragma unroll
        for (int ks = 0; ks < 2; ++ks) { const bf16x8 ak = frag_tr(Kimg, RSK, 32 * ks, 16 * wave, lane);
            const bf16x8 v0 = frag_tr(Vimg, RSV, 32 * ks, 0, lane), v1 = frag_tr(Vimg, RSV, 32 * ks, 16, lane);
            acc[0] = __builtin_amdgcn_mfma_f32_16x16x32_bf16(ak, v0, acc[0], 0, 0, 0);
            acc[1] = __builtin_amdgcn_mfma_f32_16x16x32_bf16(ak, v1, acc[1], 0, 0, 0);
            accn = __builtin_amdgcn_mfma_f32_16x16x32_bf16(ak, ones, accn, 0, 0, 0); }
        { bf16_t* cst = CstT + ((size_t)(bh * 32 + k + 1) * 256 + vs * 32) * 128;
#pragma unroll
          for (int vt = 0; vt < 2; ++vt) { u32x2 w; w.x = pg8::cvt_pk_bf16(acc[vt][0], acc[vt][1]); w.y = pg8::cvt_pk_bf16(acc[vt][2], acc[vt][3]);
              *(u32x2*)(cst + (size_t)(16 * vt + fr) * 128 + 16 * wave + 4 * fq) = w; }
          if (vs == 0 && fr == 0) *(f32x4*)(nst + (size_t)(bh * 32 + k + 1) * 128 + 16 * wave + 4 * fq) = accn; }
        __syncthreads();
    }
}

__device__ __forceinline__ void out_unit(unsigned char* ws, unsigned char* outb, LAS unsigned char* lds, int wave, int b, int h, int k) {
    const int lane = lane_id(), tid = wave * 64 + lane, fr = lane & 15, fq = lane >> 4;
    const int bh = b * 4 + h, t0 = 64 * k; const size_t rb = (size_t)b * SEQ;
    const bf16_t* QKM = (const bf16_t*)(ws + WS_QKM); const bf16_t* VM = (const bf16_t*)(ws + WS_VM); const bf16_t* GM = (const bf16_t*)(ws + WS_GM); const float* IFG = (const float*)(ws + WS_IFG);
    const float* par = (const float*)(ws + WS_PAR);
    const bf16_t* CstT = (const bf16_t*)outb + (size_t)(bh * 32 + k) * 256 * 128; const float* nst = (const float*)(ws + WS_NST + 65536) + (size_t)(bh * 32 + k) * 128; const float* mst = (const float*)(ws + WS_NST);
    bf16_t* Y = (bf16_t*)(ws + WS_Y);
    LAS unsigned char* Qimg = lds; LAS unsigned char* Qs = lds + 64 * RSK; LAS unsigned char* Kimg = lds + 2 * 64 * RSK; LAS unsigned char* Simg = lds + 3 * 64 * RSK;
    LAS unsigned char* Vw = lds + 3 * 64 * RSK + 64 * RSS + wave * (64 * RSV);
    LAS float* SC = (LAS float*)(lds + 3 * 64 * RSK + 64 * RSS + 8 * 64 * RSV);
    LAS float* PART = SC + 256;
    float inter;
    { const float* g = IFG + (rb + t0 + lane) * 8;
      const float lf = log_sigmoid_f(g[4 + h] + par[P_BF + h]), ii = g[h] + par[P_BI + h];
      const float bcs = wave_incl_sum(lf, lane), u = ii - bcs, pm = wave_incl_max(u, lane), mp = mst[bh * 32 + k];
      const float gl = bcs + mp, mt = fmaxf(bcs + pm, gl);
      inter = __expf(gl - mt);
      if (wave == 0) { SC[lane] = bcs - mt; SC[64 + lane] = u; SC[128 + lane] = __expf(-mt); } }
    { const int dg = tid & 15, lg = tid >> 4, r0 = 2 * lg;
      const float in0 = __shfl(inter, r0), in1 = __shfl(inter, r0 + 1);
#pragma unroll 1
      for (int isk = 0; isk < 2; ++isk) { const int cc = (isk ? 512 : 0) + h * 128 + 8 * dg;
          float cw[4][8], cb[8];
#pragma unroll
          for (int c = 0; c < 8; ++c) { cb[c] = par[P_CB + cc + c];
#pragma unroll
              for (int j = 0; j < 4; ++j) cw[j][c] = par[P_CW + j * 1024 + cc + c]; }
          u32x4 X[5]; load5(X, QKM, rb, t0 + r0, cc);
          float y0[8], y1[8]; conv2(X, cw, cb, y0, y1);
          if (isk) {
#pragma unroll
              for (int c = 0; c < 8; ++c) { y0[c] *= 0.08838834764831845f; y1[c] *= 0.08838834764831845f; }
              *(LAS u32x4*)(Kimg + r0 * RSK + dg * 16) = pack8f(y0); *(LAS u32x4*)(Kimg + (r0 + 1) * RSK + dg * 16) = pack8f(y1);
          } else {
              *(LAS u32x4*)(Qimg + r0 * RSK + dg * 16) = pack8f(y0); *(LAS u32x4*)(Qimg + (r0 + 1) * RSK + dg * 16) = pack8f(y1);
#pragma unroll
              for (int c = 0; c < 8; ++c) { y0[c] *= in0; y1[c] *= in1; }
              *(LAS u32x4*)(Qs + r0 * RSK + dg * 16) = pack8f(y0); *(LAS u32x4*)(Qs + (r0 + 1) * RSK + dg * 16) = pack8f(y1);
          } }
#pragma unroll
      for (int i = 0; i < 4; ++i) { const int l = 16 * i + (lane >> 2), pc = lane & 3;
          *(LAS u32x4*)(Vw + l * RSV + pc * 16) = *(const u32x4*)(VM + (rb + t0 + l) * 1024 + h * 256 + 32 * wave + pc * 8); } }
    __syncthreads();
    { const int lt = wave >> 1; const float rt = SC[16 * lt + fr];
#pragma unroll
      for (int si = 0; si < 2; ++si) { const int st = 2 * (wave & 1) + si; u32x2 w = {0u, 0u};
          if (st <= lt) { f32x4 sacc = {0.f, 0.f, 0.f, 0.f};
#pragma unroll
              for (int ks = 0; ks < 4; ++ks) { const bf16x8 kf = *(const LAS bf16x8*)(Kimg + (16 * st + fr) * RSK + (32 * ks + 8 * fq) * 2), qf = *(const LAS bf16x8*)(Qimg + (16 * lt + fr) * RSK + (32 * ks + 8 * fq) * 2);
                  sacc = __builtin_amdgcn_mfma_f32_16x16x32_bf16(kf, qf, sacc, 0, 0, 0); }
              const int l = 16 * lt + fr; float e[4];
#pragma unroll
              for (int j = 0; j < 4; ++j) { const int sidx = 16 * st + 4 * fq + j; e[j] = sidx <= l ? sacc[j] * __expf(rt + SC[64 + sidx]) : 0.f; }
              w.x = pg8::cvt_pk_bf16(e[0], e[1]); w.y = pg8::cvt_pk_bf16(e[2], e[3]); }
          *(LAS u32x2*)(Simg + (16 * lt + fr) * RSS + (16 * st + 4 * fq) * 2) = w; } }
    __syncthreads();
    const bf16x8 ones = {0x3F80, 0x3F80, 0x3F80, 0x3F80, 0x3F80, 0x3F80, 0x3F80, 0x3F80};
    if (wave < 4) { f32x4 dacc = {0.f, 0.f, 0.f, 0.f};
#pragma unroll
        for (int ks = 0; ks < 2; ++ks) { const bf16x8 sf = *(const LAS bf16x8*)(Simg + (16 * wave + fr) * RSS + (32 * ks + 8 * fq) * 2); dacc = __builtin_amdgcn_mfma_f32_16x16x32_bf16(ones, sf, dacc, 0, 0, 0); }
#pragma unroll
        for (int ks = 0; ks < 4; ++ks) { const f32x4 n0 = *(const f32x4*)(nst + 32 * ks + 8 * fq), n1 = *(const f32x4*)(nst + 32 * ks + 8 * fq + 4);
            u32x4 nw; nw.x = pg8::cvt_pk_bf16(n0[0], n0[1]); nw.y = pg8::cvt_pk_bf16(n0[2], n0[3]); nw.z = pg8::cvt_pk_bf16(n1[0], n1[1]); nw.w = pg8::cvt_pk_bf16(n1[2], n1[3]);
            const bf16x8 qf = *(const LAS bf16x8*)(Qs + (16 * wave + fr) * RSK + (32 * ks + 8 * fq) * 2);
            dacc = __builtin_amdgcn_mfma_f32_16x16x32_bf16(__builtin_bit_cast(bf16x8, nw), qf, dacc, 0, 0, 0); }
        if (fq == 0) SC[192 + 16 * wave + fr] = dacc[0]; }
    f32x4 acc[4][2];
#pragma unroll
    for (int lt = 0; lt < 4; ++lt) { acc[lt][0] = (f32x4){0.f, 0.f, 0.f, 0.f}; acc[lt][1] = (f32x4){0.f, 0.f, 0.f, 0.f}; }
#pragma unroll
    for (int ks = 0; ks < 2; ++ks) { const bf16x8 v0 = frag_tr(Vw, RSV, 32 * ks, 0, lane), v1 = frag_tr(Vw, RSV, 32 * ks, 16, lane);
#pragma unroll
        for (int lt = 0; lt < 4; ++lt) { const bf16x8 sf = *(const LAS bf16x8*)(Simg + (16 * lt + fr) * RSS + (32 * ks + 8 * fq) * 2);
            acc[lt][0] = __builtin_amdgcn_mfma_f32_16x16x32_bf16(v0, sf, acc[lt][0], 0, 0, 0); acc[lt][1] = __builtin_amdgcn_mfma_f32_16x16x32_bf16(v1, sf, acc[lt][1], 0, 0, 0); } }
#pragma unroll
    for (int ks = 0; ks < 4; ++ks) { const bf16x8 c0 = *(const bf16x8*)(CstT + (size_t)(32 * wave + fr) * 128 + 32 * ks + 8 * fq), c1 = *(const bf16x8*)(CstT + (size_t)(32 * wave + 16 + fr) * 128 + 32 * ks + 8 * fq);
#pragma unroll
        for (int lt = 0; lt < 4; ++lt) { const bf16x8 qf = *(const LAS bf16x8*)(Qs + (16 * lt + fr) * RSK + (32 * ks + 8 * fq) * 2);
            acc[lt][0] = __builtin_amdgcn_mfma_f32_16x16x32_bf16(c0, qf, acc[lt][0], 0, 0, 0); acc[lt][1] = __builtin_amdgcn_mfma_f32_16x16x32_bf16(c1, qf, acc[lt][1], 0, 0, 0); } }
    __syncthreads();
#pragma unroll
    for (int lt = 0; lt < 4; ++lt) { const int l = 16 * lt + fr; const float sc = 1.f / fmaxf(fabsf(SC[192 + l]), SC[128 + l]);
        acc[lt][0] = acc[lt][0] * sc; acc[lt][1] = acc[lt][1] * sc;
        float s1 = 0.f, s2 = 0.f;
#pragma unroll
        for (int vt = 0; vt < 2; ++vt)
#pragma unroll
            for (int j = 0; j < 4; ++j) { const float x = acc[lt][vt][j]; s1 += x; s2 = fmaf(x, x, s2); }
        s1 += __shfl_xor(s1, 16); s1 += __shfl_xor(s1, 32); s2 += __shfl_xor(s2, 16); s2 += __shfl_xor(s2, 32);
        if (fq == 0) { PART[(l * 8 + wave) * 2] = s1; PART[(l * 8 + wave) * 2 + 1] = s2; } }
    __syncthreads();
#pragma unroll
    for (int lt = 0; lt < 4; ++lt) { const int l = 16 * lt + fr; float s1 = 0.f, s2 = 0.f;
#pragma unroll
        for (int w = 0; w < 8; ++w) { s1 += PART[(l * 8 + w) * 2]; s2 += PART[(l * 8 + w) * 2 + 1]; }
        const float mu = s1 * (1.f / DVM), var = fmaxf(s2 * (1.f / DVM) - mu * mu, 0.f), rstd = rsqrtf(var + LN_EPS);
#pragma unroll
        for (int vt = 0; vt < 2; ++vt) { const int c = h * 256 + 32 * wave + 16 * vt + 4 * fq; const size_t row = rb + t0 + l;
            const f32x4 gg = *(const f32x4*)(par + P_MHG + c); const u32x2 gm = *(const u32x2*)(GM + row * 1024 + c);
            const float g0 = __builtin_bit_cast(float, gm.x << 16), g1 = __builtin_bit_cast(float, gm.x & 0xffff0000u), g2 = __builtin_bit_cast(float, gm.y << 16), g3 = __builtin_bit_cast(float, gm.y & 0xffff0000u);
            const f32x4 x = acc[lt][vt];
            u32x2 w; w.x = pg8::cvt_pk_bf16((x[0] - mu) * rstd * gg[0] * g0, (x[1] - mu) * rstd * gg[1] * g1); w.y = pg8::cvt_pk_bf16((x[2] - mu) * rstd * gg[2] * g2, (x[3] - mu) * rstd * gg[3] * g3);
            *(u32x2*)(Y + row * 2048 + 1024 + c) = w; } }
    __syncthreads();
}
}

constexpr int NWAVES = 8, NTHREADS = 512;
#ifndef PROBE_ID
#define PROBE_ID -1
#endif
#define REP(id) ((PROBE_ID) == (id) ? 2 : 1)
constexpr int LDS_BYTES = 147456;
constexpr int MISC_OFF = 131072 + 8192;
constexpr int CW_BAR = 4096;
struct Args {
    const float* in[16]; float* out; unsigned char* ws; int ph_lo, ph_hi, li, pad;
};

template <class SrcMap>
__device__ __forceinline__ void p0_transpose_item(const float* W, int K, int Nsrc, int nblk, bf16_t* WT, int row_off, LAS float* scr, int item, int lane, SrcMap smap) {
    const int kb = item / nblk, nb = item % nblk, k0 = 64 * kb, n0 = 32 * nb;
    const int src = smap(n0 + (lane & 31));
#pragma unroll 8
    for (int i = 0; i < 32; ++i) { const int kk = 2 * i + (lane >> 5); scr[kk * 33 + (lane & 31)] = src >= 0 ? W[(size_t)(k0 + kk) * Nsrc + src] : 0.f; }
    asm volatile("s_waitcnt lgkmcnt(0)" ::: "memory");
    const int c = lane & 7;
#pragma unroll
    for (int j = 0; j < 4; ++j) { const int n = (lane >> 3) + 8 * j; const LAS float* s = scr + (8 * c) * 33 + n;
        u32x4 o; o.x = pk2(s[0 * 33], s[1 * 33]); o.y = pk2(s[2 * 33], s[3 * 33]); o.z = pk2(s[4 * 33], s[5 * 33]); o.w = pk2(s[6 * 33], s[7 * 33]);
        *(u32x4*)(WT + (size_t)(row_off + n0 + n) * K + k0 + 8 * c) = o; }
    asm volatile("s_waitcnt lgkmcnt(0)" ::: "memory");
}
struct MapIdent { __device__ __forceinline__ int operator()(int n) const { return n; } };
struct MapWin { __device__ __forceinline__ int operator()(int n) const { return win_src(n); } };

__global__ void __launch_bounds__(NTHREADS, 2) skel_fwd(Args args) {
    extern __shared__ __attribute__((aligned(16))) unsigned char lds_raw[];
    LAS unsigned char* lds = (LAS unsigned char*)lds_raw;
#define FRESH_TID() ({ int t_ = wave * 64 + lane_id(); asm volatile("" : "+v"(t_)); t_; })
    const int wave = __builtin_amdgcn_readfirstlane(threadIdx.x >> 6);
    const int G = gridDim.x, bx = blockIdx.x;
    const int vcu = (G % 8 == 0) ? (bx % 8) * (G / 8) + bx / 8 : bx;
    unsigned char* ws = args.ws;
    const int lo = args.ph_lo, hi = args.ph_hi;
#define IN(k) (lo <= (k) && (k) < hi)
#define BOTH(k) (IN(k) && IN((k) + 1))
    volatile LAS unsigned* MISC = (volatile LAS unsigned*)(lds + MISC_OFF);
    if (threadIdx.x < 32) MISC[threadIdx.x] = 0u;
    __syncthreads();
    XcdBarrier bar = xcd_barrier_post((unsigned*)(ws + WS_CTL) + CW_BAR + args.li * XCD_BAR_WORDS, MISC + 8);
#define GRID_BAR() xcd_barrier(bar, wave)
#define XB ((bf16_t*)(ws + WS_XB))
#define WINT ((bf16_t*)(ws + WS_WINT))
#define WOUTT ((bf16_t*)(ws + WS_WOUTT))
#define WKVT ((bf16_t*)(ws + WS_WKVT))
#define PARF ((float*)(ws + WS_PAR))

    if (IN(0)) {
      _Pragma("unroll 1") for (int rep = 0; rep < REP(0); ++rep) {
        const int tid = FRESH_TID(), lane = tid & 63;
        const int gw = vcu * NWAVES + wave, NGW = G * NWAVES;
        LAS float* scr = (LAS float*)(lds + wave * 16384);
        const float* x = args.in[0];
        for (int it = gw; it < M * DM / 512; it += NGW) {
            const f32x4 a = *(const f32x4*)(x + (size_t)it * 512 + lane * 8), b = *(const f32x4*)(x + (size_t)it * 512 + lane * 8 + 4);
            u32x4 o; o.x = pk2(a[0], a[1]); o.y = pk2(a[2], a[3]); o.z = pk2(b[0], b[1]); o.w = pk2(b[2], b[3]);
            *(u32x4*)(XB + (size_t)it * 512 + lane * 8) = o;
        }
        constexpr int I_IN = (DM / 64) * (NP / 32), I_OUT = (DM / 64) * (DM / 32), I_UV = (DC / 64) * (DHA / 32);
        for (int it = gw; it < I_IN + I_OUT + HA * I_UV; it += NGW) {
            int r = it;
            if (r < I_IN) { p0_transpose_item(args.in[1], DM, NCOLS, NP / 32, WINT, 0, scr, r, lane, MapWin()); continue; } r -= I_IN;
            if (r < I_OUT) { p0_transpose_item(args.in[13], DM, DM, DM / 32, WOUTT, 0, scr, r, lane, MapIdent()); continue; } r -= I_OUT;
            { const int h = r / I_UV; p0_transpose_item(args.in[6] + (size_t)h * DC * DHA, DC, DHA, DHA / 32, WKVT, 1024 + h * DHA, scr, r % I_UV, lane, MapIdent()); }
        }
        {
            const int gt = vcu * NTHREADS + tid, NGT = G * NTHREADS;
            for (int i = gt; i < P_TOTAL; i += NGT) { float v = 0.f;
                if (i < P_LNG) v = args.in[4][i - P_KVG]; else if (i < P_LNB) v = args.in[7][i - P_LNG]; else if (i < P_RB) v = args.in[8][i - P_LNB];
                else if (i < P_CW) v = args.in[9][i - P_RB]; else if (i < P_CB) v = args.in[10][i - P_CW]; else if (i < P_MHG) v = args.in[11][i - P_CB];
                else if (i < P_BI) v = args.in[12][i - P_MHG]; else if (i < P_BI + 4) v = args.in[2][i - P_BI]; else if (i < P_BF + 4) v = args.in[3][i - P_BF];
                else if (i >= P_LG && i < P_LB) v = args.in[14][i - P_LG]; else if (i >= P_LB) v = args.in[15][i - P_LB];
                PARF[i] = v; }
        }
        const float* wuk = args.in[5];
        for (int it = gw; it < 1024 * 256 / 512; it += NGW) {
            const f32x4 a = *(const f32x4*)(wuk + (size_t)it * 512 + lane * 8), b = *(const f32x4*)(wuk + (size_t)it * 512 + lane * 8 + 4);
            u32x4 o; o.x = pk2(a[0], a[1]); o.y = pk2(a[2], a[3]); o.z = pk2(b[0], b[1]); o.w = pk2(b[2], b[3]);
            *(u32x4*)(WKVT + (size_t)it * 512 + lane * 8) = o;
        }
        __syncthreads();
      }
        if (BOTH(0)) GRID_BAR();
    }
    if (IN(1)) {
        pg8::Gemm g{XB, WINT, M, NP, DM}; pg8::StaticOrder S; S.init(M, NP, G, bx);
        Epi1 E{ws};
        _Pragma("unroll 1") for (int rep = 0; rep < REP(1); ++rep) pg8::gemm_phase<Epi1, pg8::StaticOrder>(lds, g, S, E, wave);
        if (BOTH(1)) GRID_BAR();
    }
    if (IN(2)) {
        {
            const int lane = FRESH_TID() & 63, b = vcu >> 5, j = vcu & 31;
#pragma unroll 1
            for (int u = 0; u < 4 * REP(2); ++u) { const int gi = (u & 1) ? ((u & 2) ? j : 64 + j) : ((u & 2) ? 63 - j : 127 - j);
                topk_unit((const bf16_t*)(ws + WS_QI), (const bf16_t*)(ws + WS_KI), (const float*)(ws + WS_WI), (unsigned long long*)(ws + WS_MASK), b, gi, wave, lane, (LAS unsigned long long*)(lds + 131072 + 4096 + wave * 256)); }
        }
        pg8::Gemm g{(bf16_t*)(ws + WS_C), WKVT, M, 2048, DC}; pg8::StaticOrder S; S.init(M, 2048, G, bx);
        EpiKV E{(bf16_t*)((unsigned char*)args.out + OUT_K), (bf16_t*)((unsigned char*)args.out + OUT_V)};
        _Pragma("unroll 1") for (int rep = 0; rep < REP(3); ++rep) pg8::gemm_phase<EpiKV, pg8::StaticOrder>(lds, g, S, E, wave);
        _Pragma("unroll 1") for (int rep = 0; rep < REP(4); ++rep) ml::state_phase(ws, (unsigned char*)args.out, lds, wave, vcu);
        if (BOTH(2)) GRID_BAR();
    }
    if (IN(3)) {
        const int b = vcu >> 5, h = (vcu >> 2) & 7, x = vcu & 3;
        const bf16_t* Qh = (const bf16_t*)(ws + WS_Q) + (size_t)b * SEQ * 1024 + h * DHA;
        const bf16_t* Kh = (const bf16_t*)((unsigned char*)args.out + OUT_K) + (size_t)b * SEQ * 1024 + h * DHA;
        const bf16_t* Vh = (const bf16_t*)((unsigned char*)args.out + OUT_V) + (size_t)b * SEQ * 1024 + h * DHA;
        bf16_t* Yh = (bf16_t*)(ws + WS_Y) + (size_t)b * SEQ * 2048 + h * DHA;
        const bf16_t* Zh = (const bf16_t*)(ws + WS_SZA) + (size_t)b * SEQ * 1024 + h * DHA;
        const unsigned long long* MKb = (const unsigned long long*)(ws + WS_MASK) + (size_t)b * 32 * SEQ;
        const int q0 = x * 256, q1 = (7 - x) * 256;
        att::BlockRef r0{Qh + (size_t)q0 * 1024, Kh, Vh, Yh + (size_t)q0 * 2048, Zh + (size_t)q0 * 1024, MKb + q0, q0};
        att::BlockRef r1{Qh + (size_t)q1 * 1024, Kh, Vh, Yh + (size_t)q1 * 2048, Zh + (size_t)q1 * 1024, MKb + q1, q1};
        att::Seam S;
      _Pragma("unroll 1") for (int rep = 0; rep < REP(5); ++rep) {
        att::prime(r0, (char*)lds_raw, S, PARF + P_RB, h, wave);
#pragma unroll 1
        for (int pass = 0; pass < 2; ++pass) { const att::BlockRef cur = pass ? r1 : r0; att::block(cur, r1, (char*)lds_raw, S, wave); }
      }
#pragma unroll 1
        for (int i = 0; i < 4 * REP(6); ++i) { const int u = vcu * 4 + (i & 3); ml::out_unit(ws, (unsigned char*)args.out, lds, wave, u >> 7, (u >> 5) & 3, u & 31); }
        if (BOTH(3)) GRID_BAR();
    }
    if (IN(4)) {
        pg8::Gemm g{(bf16_t*)(ws + WS_Y), WOUTT, M, DM, DM}; pg8::StaticOrder S; S.init(M, DM, G, bx);
        EpiOut E{args.in[0], args.out};
        _Pragma("unroll 1") for (int rep = 0; rep < REP(7); ++rep) pg8::gemm_phase<EpiOut, pg8::StaticOrder>(lds, g, S, E, wave);
        if (BOTH(4)) GRID_BAR();
    }
    if (IN(5)) {
        const int lane = FRESH_TID() & 63;
        const int gw = vcu * NWAVES + wave, NGW = G * NWAVES;
        const float* lg = PARF + P_LG; const float* lb = PARF + P_LB;
        for (int r = gw; r < M; r += NGW) {
            f32x4* p = (f32x4*)(args.out + (size_t)r * DM) + lane;
            f32x4 v[8]; float s = 0.f;
#pragma unroll
            for (int j = 0; j < 8; ++j) { v[j] = p[64 * j]; s += (v[j][0] + v[j][1]) + (v[j][2] + v[j][3]); }
#pragma unroll
            for (int o = 1; o < 64; o <<= 1) s += __shfl_xor(s, o);
            const float mu = s * (1.f / DM); float q = 0.f;
#pragma unroll
            for (int j = 0; j < 8; ++j) { v[j] = v[j] - mu; q += (v[j][0] * v[j][0] + v[j][1] * v[j][1]) + (v[j][2] * v[j][2] + v[j][3] * v[j][3]); }
#pragma unroll
            for (int o = 1; o < 64; o <<= 1) q += __shfl_xor(q, o);
            const float rstd = rsqrtf(q * (1.f / DM) + LN_EPS);
#pragma unroll
            for (int j = 0; j < 8; ++j) { const f32x4 gg = *((const f32x4*)lg + lane + 64 * j), bb = *((const f32x4*)lb + lane + 64 * j); p[64 * j] = v[j] * rstd * gg + bb; }
        }
    }
#undef IN
#undef BOTH
}


__global__ void __launch_bounds__(256) naive_topk(const bf16_t* __restrict__ QI, const bf16_t* __restrict__ KI, const float* __restrict__ WI, unsigned long long* __restrict__ mask) {
    __shared__ float qi[HIDX * DIDX]; __shared__ float w[HIDX]; __shared__ unsigned keys[SEQ]; __shared__ unsigned cnt; __shared__ unsigned Tsh;
    const int row = blockIdx.x, b = row / SEQ, t = row % SEQ, tid = threadIdx.x;
    for (int i = tid; i < HIDX * DIDX; i += 256) qi[i] = bf2f(QI[(size_t)row * 1024 + i]);
    if (tid < HIDX) w[tid] = WI[(size_t)row * 16 + tid];
    __syncthreads();
    for (int s = tid; s < SEQ; s += 256) {
        unsigned key = 0u;
        if (s <= t) {
            const bf16_t* kr = KI + ((size_t)b * SEQ + s) * DIDX; float kf[DIDX];
#pragma unroll
            for (int d = 0; d < DIDX; ++d) kf[d] = bf2f(kr[d]);
            float sc = 0.f;
            for (int h = 0; h < HIDX; ++h) { float a = 0.f;
#pragma unroll
                for (int d = 0; d < DIDX; ++d) a = fmaf(qi[h * DIDX + d], kf[d], a);
                sc = fmaf(fmaxf(a, 0.f), w[h], sc); }
            key = mono_key(sc);
        }
        keys[s] = key;
    }
    __syncthreads();
    if (t >= NSEL) {
        unsigned T = 0u;
        for (int bit = 31; bit >= 0; --bit) {
            const unsigned cand = T | (1u << bit);
            if (tid == 0) cnt = 0u;
            __syncthreads();
            unsigned c = 0u;
            for (int s = tid; s < SEQ; s += 256) c += keys[s] >= cand ? 1u : 0u;
            atomicAdd(&cnt, c);
            __syncthreads();
            if (cnt >= (unsigned)NSEL) T = cand;
            __syncthreads();
        }
        if (tid == 0) {
            unsigned gt = 0u; for (int s = 0; s < SEQ; ++s) gt += keys[s] > T ? 1u : 0u;
            unsigned need = NSEL - gt;
            for (int s = 0; s < SEQ; ++s) if (keys[s] == T) { if (need > 0u) --need; else keys[s] = 0u; }
            Tsh = T;
        }
        __syncthreads();
    } else { if (tid == 0) Tsh = 1u; __syncthreads(); }
    if (tid < 32) {
        const unsigned T = Tsh; unsigned long long wv = 0ull;
        for (int l = 0; l < 64; ++l) if (keys[tid * 64 + l] >= T) wv |= 1ull << l;
        mask[((size_t)b * 32 + tid) * SEQ + t] = wv;
    }
}

__global__ void __launch_bounds__(256) naive_attn(const bf16_t* __restrict__ Qb, const bf16_t* __restrict__ Kb, const bf16_t* __restrict__ Vb, const bf16_t* __restrict__ SZA,
                                                  const unsigned long long* __restrict__ mask, const float* __restrict__ rel_bias, bf16_t* __restrict__ Y) {
    __shared__ int sel[NSEL]; __shared__ int nsel_s; __shared__ float q[1024]; __shared__ float p[NSEL]; __shared__ float red[8]; __shared__ int pre[33];
    const int row = blockIdx.x, b = row / SEQ, t = row % SEQ, tid = threadIdx.x;
    for (int i = tid; i < 1024; i += 256) q[i] = bf2f(Qb[(size_t)row * 1024 + i]);
    if (tid == 0) { int a = 0; for (int g = 0; g < 32; ++g) { pre[g] = a; a += __popcll(mask[((size_t)b * 32 + g) * SEQ + t]); } pre[32] = a; nsel_s = a; }
    __syncthreads();
    if (tid < 32) { unsigned long long wv = mask[((size_t)b * 32 + tid) * SEQ + t]; int o = pre[tid]; while (wv) { const int l = __ffsll((long long)wv) - 1; wv &= wv - 1; if (o < NSEL) sel[o] = tid * 64 + l; ++o; } }
    __syncthreads();
    const int nsel = nsel_s < NSEL ? nsel_s : NSEL;
    for (int h = 0; h < HA; ++h) {
        float lg = -1e30f;
        if (tid < nsel) { const int s = sel[tid]; const bf16_t* kr = Kb + ((size_t)b * SEQ + s) * 1024 + h * DHA; float a = 0.f;
            for (int d = 0; d < DHA; ++d) a = fmaf(q[h * DHA + d], bf2f(kr[d]), a);
            lg = (t - s >= 0) ? a + rel_bias[t5_bucket(t - s) * HA + h] * LOG2E : -1e30f; }
        float mx = lg;
        for (int o = 1; o < 64; o <<= 1) mx = fmaxf(mx, __shfl_xor(mx, o));
        if ((tid & 63) == 0) red[tid >> 6] = mx;
        __syncthreads();
        mx = fmaxf(fmaxf(red[0], red[1]), fmaxf(red[2], red[3]));
        const float pe = tid < nsel ? exp2f(lg - mx) : 0.f;
        p[tid] = pe;
        float sm = pe;
        for (int o = 1; o < 64; o <<= 1) sm += __shfl_xor(sm, o);
        if ((tid & 63) == 0) red[4 + (tid >> 6)] = sm;
        __syncthreads();
        const float l = (red[4] + red[5]) + (red[6] + red[7]);
        if (tid < DHA) { float o = 0.f;
            for (int j = 0; j < nsel; ++j) o = fmaf(p[j], bf2f(Vb[((size_t)b * SEQ + sel[j]) * 1024 + h * DHA + tid]), o);
            const float y = o / l * bf2f(SZA[(size_t)row * 1024 + h * DHA + tid]);
            Y[(size_t)row * 2048 + h * DHA + tid] = (bf16_t)f2bf(y); }
        __syncthreads();
    }
}

__global__ void __launch_bounds__(512) naive_mlstm(const bf16_t* __restrict__ QKM, const bf16_t* __restrict__ VM, const bf16_t* __restrict__ GM, const float* __restrict__ IFG,
                                                   const float* __restrict__ conv_w, const float* __restrict__ conv_b, const float* __restrict__ b_i, const float* __restrict__ b_f,
                                                   const float* __restrict__ mhg, float* __restrict__ Cst, float* __restrict__ hbuf, bf16_t* __restrict__ Y) {
    extern __shared__ float dsm[]; float* qs = dsm; float* ks = dsm + CHUNK * DKM; float* Ss = dsm + 2 * CHUNK * DKM;
    __shared__ float bcs[CHUNK], ii[CHUNK], mt[CHUNK], inter[CHUNK], den[CHUNK], wgt[CHUNK], nvec[DKM], qn[CHUNK]; __shared__ float m_s, decay_s;
    const int bh = blockIdx.x, b = bh / HM, h = bh % HM, tid = threadIdx.x;
    float* C = Cst + (size_t)bh * DVM * DKM; float* hb = hbuf + (size_t)bh * CHUNK * DVM;
    for (int i = tid; i < DVM * DKM; i += 512) C[i] = 0.f;
    if (tid < DKM) nvec[tid] = 0.f;
    if (tid == 0) m_s = 0.f;
    __syncthreads();
    for (int kc = 0; kc < NCHUNK; ++kc) {
        const int t0 = kc * CHUNK; const size_t rb = (size_t)b * SEQ;
        _Pragma("unroll 1") for (int i = tid; i < CHUNK * DKM * 2; i += 512) {
            const int isk = i >= CHUNK * DKM, e = isk ? i - CHUNK * DKM : i, l = e / DKM, d = e % DKM, c = (isk ? 512 : 0) + h * DKM + d, t = t0 + l;
            float a = conv_b[c];
            for (int j = 0; j < 4; ++j) { const int tt = t - 3 + j; if (tt >= 0) a = fmaf(conv_w[j * 1024 + c], bf2f(QKM[(rb + tt) * 1024 + c]), a); }
            a = silu_f(a);
            if (isk) ks[e] = a * 0.08838834764831845f; else qs[e] = a;
        }
        if (tid == 0) { float cs = 0.f;
            _Pragma("unroll 1") for (int l = 0; l < CHUNK; ++l) { const float* g = IFG + (rb + t0 + l) * 8; cs += log_sigmoid_f(g[4 + h] + b_f[h]); bcs[l] = cs; ii[l] = g[h] + b_i[h]; }
            float rm = -1e30f; const float mp = m_s;
            _Pragma("unroll 1") for (int l = 0; l < CHUNK; ++l) { rm = fmaxf(rm, ii[l] - bcs[l]); const float gl = bcs[l] + mp; const float m = fmaxf(bcs[l] + rm, gl); mt[l] = m; inter[l] = expf(gl - m); } }
        __syncthreads();
        _Pragma("unroll 1") for (int i = tid; i < CHUNK * CHUNK; i += 512) { const int l = i / CHUNK, s = i % CHUNK; float v = 0.f;
            if (s <= l) { float a = 0.f; _Pragma("unroll 4") for (int d = 0; d < DKM; ++d) a = fmaf(qs[l * DKM + d], ks[s * DKM + d], a); v = a * expf(bcs[l] - bcs[s] + ii[s] - mt[l]); }
            Ss[i] = v; }
        if (tid < CHUNK) { float a = 0.f; _Pragma("unroll 4") for (int d = 0; d < DKM; ++d) a = fmaf(qs[tid * DKM + d], nvec[d], a); qn[tid] = a; }
        __syncthreads();
        if (tid < CHUNK) { float a = 0.f; _Pragma("unroll 4") for (int s = 0; s < CHUNK; ++s) a += Ss[tid * CHUNK + s]; den[tid] = a + inter[tid] * qn[tid]; }
        __syncthreads();
        { const int v = tid % DVM, lh = tid / DVM;
            _Pragma("unroll 1") for (int lq = 0; lq < 2; ++lq) { float acc[16]; const int l0 = lh * 32 + lq * 16;
#pragma unroll
                for (int l = 0; l < 16; ++l) acc[l] = 0.f;
_Pragma("unroll 2")
                for (int d = 0; d < DKM; ++d) { const float c = C[v * DKM + d];
#pragma unroll
                    for (int l = 0; l < 16; ++l) acc[l] = fmaf(qs[(l0 + l) * DKM + d], c, acc[l]); }
#pragma unroll
                for (int l = 0; l < 16; ++l) acc[l] *= inter[l0 + l];
_Pragma("unroll 2")
                for (int s = 0; s < CHUNK; ++s) { const float vv = bf2f(VM[(rb + t0 + s) * 1024 + h * DVM + v]);
#pragma unroll
                    for (int l = 0; l < 16; ++l) acc[l] = fmaf(Ss[(l0 + l) * CHUNK + s], vv, acc[l]); }
#pragma unroll
                for (int l = 0; l < 16; ++l) { const int L = l0 + l; hb[L * DVM + v] = acc[l] / fmaxf(fabsf(den[L]), expf(-mt[L])); } } }
        __syncthreads();
        { const int wv = tid >> 6, ln = tid & 63;
            _Pragma("unroll 1") for (int l = wv; l < CHUNK; l += 8) { float x[4]; float s = 0.f;
                for (int j = 0; j < 4; ++j) { x[j] = hb[l * DVM + ln + 64 * j]; s += x[j]; }
                for (int o = 1; o < 64; o <<= 1) s += __shfl_xor(s, o);
                const float mu = s * (1.f / DVM); float q = 0.f;
                for (int j = 0; j < 4; ++j) { x[j] -= mu; q += x[j] * x[j]; }
                for (int o = 1; o < 64; o <<= 1) q += __shfl_xor(q, o);
                const float rstd = rsqrtf(q * (1.f / DVM) + LN_EPS);
                for (int j = 0; j < 4; ++j) { const int c = h * DVM + ln + 64 * j; const float y = x[j] * rstd * mhg[c] * bf2f(GM[(rb + t0 + l) * 1024 + c]);
                    Y[(rb + t0 + l) * 2048 + 1024 + c] = (bf16_t)f2bf(y); } } }
        if (tid == 0) { const float bL = bcs[CHUNK - 1], mp = m_s; float ma = -1e30f;
            _Pragma("unroll 1") for (int l = 0; l < CHUNK; ++l) ma = fmaxf(ma, bL - bcs[l] + ii[l]);
            const float mn = fmaxf(bL + mp, ma); decay_s = expf(bL + mp - mn);
            _Pragma("unroll 1") for (int l = 0; l < CHUNK; ++l) wgt[l] = expf(bL - bcs[l] + ii[l] - mn);
            m_s = mn; }
        __syncthreads();
        { const int v = tid % DVM, dh = tid / DVM; const float dc = decay_s;
            _Pragma("unroll 1") for (int dq = 0; dq < 4; ++dq) { float acc[16]; const int d0 = dh * 64 + dq * 16;
#pragma unroll
                for (int d = 0; d < 16; ++d) acc[d] = C[v * DKM + d0 + d] * dc;
_Pragma("unroll 2")
                for (int l = 0; l < CHUNK; ++l) { const float wvv = wgt[l] * bf2f(VM[(rb + t0 + l) * 1024 + h * DVM + v]);
#pragma unroll
                    for (int d = 0; d < 16; ++d) acc[d] = fmaf(wvv, ks[l * DKM + d0 + d], acc[d]); }
#pragma unroll
                for (int d = 0; d < 16; ++d) C[v * DKM + d0 + d] = acc[d]; } }
        if (tid < DKM) { float a = nvec[tid] * decay_s; _Pragma("unroll 4") for (int l = 0; l < CHUNK; ++l) a = fmaf(wgt[l], ks[l * DKM + tid], a); nvec[tid] = a; }
        __syncthreads();
    }
}

constexpr int NAIVE_MLSTM_LDS = (2 * CHUNK * DKM + CHUNK * CHUNK) * 4;
extern "C" void kernel_launch(void* const* d_in, const int* in_sizes, int n_in, void* d_out, int out_size, void* d_ws, size_t ws_size, hipStream_t stream) {
    static int grid = 0;
    if (grid == 0) {
        if (n_in != 16 || in_sizes[0] != M * DM || out_size != M * DM || ws_size < WS_END) { fprintf(stderr, "kernel_launch: unexpected shapes (n_in %d, in0 %d, out %d, ws %zu)\n", n_in, n_in > 0 ? in_sizes[0] : -1, out_size, ws_size); grid = -1; return; }
        int dev = 0, cus = 0, per_cu = 0;
        if (hipGetDevice(&dev) != hipSuccess || hipDeviceGetAttribute(&cus, hipDeviceAttributeMultiprocessorCount, dev) != hipSuccess) { grid = -1; return; }
        if (hipFuncSetAttribute((const void*)skel_fwd, hipFuncAttributeMaxDynamicSharedMemorySize, LDS_BYTES) != hipSuccess) { fprintf(stderr, "kernel_launch: hipFuncSetAttribute failed\n"); grid = -1; return; }
        if (hipOccupancyMaxActiveBlocksPerMultiprocessor(&per_cu, (const void*)skel_fwd, NTHREADS, LDS_BYTES) != hipSuccess || per_cu < 1) fprintf(stderr, "kernel_launch: occupancy query says %d\n", per_cu);
        (void)hipFuncSetAttribute((const void*)naive_mlstm, hipFuncAttributeMaxDynamicSharedMemorySize, NAIVE_MLSTM_LDS);
        (void)hipGetLastError();
        grid = cus;
    }
    if (grid < 0) return;
    Args a{};
    for (int i = 0; i < 16; ++i) a.in[i] = (const float*)d_in[i];
    a.out = (float*)d_out; a.ws = (unsigned char*)d_ws;
    unsigned char* ws = (unsigned char*)d_ws;
    if (hipMemsetAsync((char*)d_ws + WS_CTL, 0, CTL_ZERO_BYTES, stream) != hipSuccess) { fprintf(stderr, "kernel_launch: memset failed\n"); return; }
    int li = 0;
    auto launch = [&](int lo, int hi) { a.ph_lo = lo; a.ph_hi = hi; a.li = li++; hipLaunchKernelGGL(skel_fwd, dim3(grid), dim3(NTHREADS), LDS_BYTES, stream, a); };
    launch(0, 6);
}
```

```cpp
#include <hip/hip_runtime.h>
#include <cstdio>
#include <cstdint>

#define LAS __attribute__((address_space(3)))
#define GAS __attribute__((address_space(1)))
typedef unsigned short bf16_t;
typedef short bf16x8 __attribute__((ext_vector_type(8)));
typedef float f32x4 __attribute__((ext_vector_type(4)));
typedef float f32x2 __attribute__((ext_vector_type(2)));
typedef unsigned u32x4 __attribute__((ext_vector_type(4)));
typedef unsigned u32x2 __attribute__((ext_vector_type(2)));

constexpr int BATCH = 8, SEQ = 2048, DM = 2048, M = BATCH * SEQ;
constexpr int NCOLS = 7512, NP = 7680;
constexpr int HA = 8, DHA = 128, DC = 256, HIDX = 16, DIDX = 64, NSEL = 256;
constexpr int HM = 4, DVM = 256, DKM = 128, CHUNK = 64, NCHUNK = SEQ / CHUNK;
constexpr float LN_EPS = 1e-5f;
constexpr float ALPHA = 1.189207115002721f;
constexpr float LOG2E = 1.4426950408889634f;
constexpr float QSCALE = 0.08838834764831845f * LOG2E;
constexpr int O_QA = 0, O_CKV = 1024, O_ZA = 1280, O_QI = 2304, O_KI = 3328, O_WI = 3392, O_QM = 3408, O_KM = 3920, O_VM = 4432, O_IM = 5456, O_FM = 5460, O_OM = 5464, O_ZM = 6488;
__host__ __device__ __forceinline__ int win_src(int np) {
    const int t = np >> 8, lc = np & 255;
    if (t < 4) return O_QA + np;
    if (t == 4) return O_CKV + lc;
    if (t < 9) return O_ZA + (np - 5 * 256);
    if (t < 13) return O_QI + (np - 9 * 256);
    if (t == 13) {
        if (lc < 32) return O_KI + lc;
        if (lc >= 128 && lc < 160) return O_KI + 32 + (lc - 128);
        if (lc >= 32 && lc < 48) return O_WI + (lc - 32);
        if (lc >= 48 && lc < 52) return O_IM + (lc - 48);
        if (lc >= 52 && lc < 56) return O_FM + (lc - 52);
        return -1;
    }
    if (t < 16) return O_QM + (np - 14 * 256);
    if (t < 18) return O_KM + (np - 16 * 256);
    if (t < 22) return O_VM + (np - 18 * 256);
    { const int j = t - 22; return lc < 128 ? O_OM + 128 * j + lc : O_ZM + 128 * j + (lc - 128); }
}

constexpr size_t MiB = 1u << 20;
constexpr size_t WS_CTL = 0, CTL_ZERO_BYTES = 1 * MiB;
constexpr size_t WS_XB = 1 * MiB;
constexpr size_t WS_Y = WS_XB;
constexpr size_t WS_WINT = 65 * MiB;
constexpr size_t WS_WOUTT = 95 * MiB;
constexpr size_t WS_WKVT = 103 * MiB;
constexpr size_t WS_Q = 104 * MiB;
constexpr size_t WS_C = 136 * MiB;
constexpr size_t WS_SZA = 144 * MiB;
constexpr size_t WS_QI = 176 * MiB;
constexpr size_t WS_KI = 208 * MiB;
constexpr size_t WS_WI = 210 * MiB;
constexpr size_t WS_IFG = 211 * MiB;
constexpr size_t WS_QKM = 212 * MiB;
constexpr size_t WS_VM = 244 * MiB;
constexpr size_t WS_GM = 276 * MiB;
constexpr size_t WS_MASK = 308 * MiB;
constexpr size_t WS_PAR = 312 * MiB;
constexpr int P_KVG = 0, P_LNG = 256, P_LNB = 320, P_RB = 384, P_CW = 640, P_CB = 4736, P_MHG = 5760, P_BI = 6784, P_BF = 6788, P_LG = 6800, P_LB = 8848, P_TOTAL = 10896;
constexpr size_t WS_NST = 313 * MiB;
constexpr size_t WS_DBG = 316 * MiB;
constexpr size_t WS_END = 324 * MiB;
constexpr size_t OUT_K = 64 * MiB, OUT_V = 96 * MiB;

__device__ __forceinline__ int lane_id_() { return (int)__builtin_amdgcn_mbcnt_hi(~0u, __builtin_amdgcn_mbcnt_lo(~0u, 0u)); }
namespace pg8 {
constexpr int BM = 256, BK = 64, HALF = 128, HTB = HALF * BK * 2, STAGE_BYTES = 8 * HTB, NXCD = 8, WGM = 8;
__host__ __device__ __forceinline__ int lds_byte(int r, int c) { const int st = (r >> 4) * 2 + (c >> 5), rr = r & 15, cc = c & 31, ob = rr * 64 + cc * 2; return st * 1024 + (ob ^ (((ob >> 9) & 1) << 5)); }
__host__ __device__ __forceinline__ void stage_rc(int b, int& R, int& C) { const int st = b / 1024, sb = b % 1024, swz = sb ^ (((sb >> 9) & 1) << 5); R = (st >> 1) * 16 + swz / 64; C = (st & 1) * 32 + (swz % 64) / 2; }
__host__ __device__ __forceinline__ int perm32(int rho) { const int n = rho >> 4, i = rho & 15; return 8 * (i >> 2) + 4 * n + (i & 3); }
struct Unit { int pm, pn; };
struct Gemm { const bf16_t* A; const bf16_t* Bt; int M, N, K; };
struct StaticOrder {
    int nM, nN, nwg, G, c;
    __host__ __device__ void init(int M_, int N_, int G_, int c_) { nM = M_ / BM; nN = N_ / BM; nwg = nM * nN; G = G_; c = c_; }
    __host__ __device__ bool next(int i, Unit& u) const {
        const long L = (long)i * G + c; if (L >= nwg) return false;
        int wgid = (int)L; { const int q = nwg / NXCD, r = nwg % NXCD, xcd = wgid % NXCD, off = wgid / NXCD; wgid = (xcd < r ? xcd * (q + 1) : r * (q + 1) + (xcd - r) * q) + off; }
        const int nig = WGM * nN, gid = wgid / nig, fm = gid * WGM, gsz = (nM - fm) < WGM ? (nM - fm) : WGM;
        u.pm = fm + ((wgid % nig) % gsz); u.pn = (wgid % nig) / gsz; return true;
    }
};
typedef float f32x2_t_ __attribute__((ext_vector_type(2))); typedef __bf16 bf16x2_t_ __attribute__((ext_vector_type(2)));
__device__ __forceinline__ unsigned cvt_pk_bf16(float lo, float hi) { f32x2_t_ v = {lo, hi}; bf16x2_t_ b = __builtin_convertvector(v, bf16x2_t_); return __builtin_bit_cast(unsigned, b); }

template <class Epi, class Sched, bool ALIGN_EPI = true, bool SP2 = true>
__device__ __forceinline__ void gemm_phase(LAS unsigned char* lds, const Gemm g, const Sched& S, const Epi& E, int wave_) {
    int tid = wave_ * 64 + lane_id_(); asm volatile("" : "+v"(tid));
    const int wid = __builtin_amdgcn_readfirstlane(tid >> 6), lane = tid & 63, wr = wid >> 2, wc = wid & 3, fr = lane & 15, fq = lane >> 4;
    const int K = g.K, nt = K / BK;
    unsigned voffA[2], voffB[2];
#pragma unroll
    for (int i = 0; i < 2; ++i) { int R, C; stage_rc(tid * 16 + i * 8192, R, C); const int Rb = Epi::PERM ? ((R & ~31) + perm32(R & 31)) : R;
        voffA[i] = (unsigned)(R * K + C) * 2u; voffB[i] = (unsigned)(Rb * K + C) * 2u; }
    const size_t kstep = (size_t)(BK * 2);
    const size_t hstep = (size_t)HALF * K * 2;
    const size_t tstep = 2 * hstep;
    const unsigned ldsw = (unsigned)wid * 1024u;
    const int aoff = lds_byte(wr * 64 + fr, fq * 8), boff = lds_byte(wc * 32 + fr, fq * 8);
#define PG8_SA(b, h) (((b) * 2 + (h)) * HTB)
#define PG8_SB(b, h) ((4 + (b) * 2 + (h)) * HTB)
#define PG8_STAGE(bufoff, gbase, voff) do { _Pragma("unroll") for (int _i = 0; _i < 2; ++_i) \
        __builtin_amdgcn_global_load_lds((const unsigned*)((const char*)(gbase) + (voff)[_i]), (LAS unsigned*)(lds + (bufoff) + ldsw + _i * 8192), 16, 0, 0); } while (0)
#define PG8_LDA(dst, b, h) do { _Pragma("unroll") for (int m = 0; m < 4; ++m) _Pragma("unroll") for (int k = 0; k < 2; ++k) dst[m][k] = *(const LAS bf16x8*)(lds + PG8_SA(b, h) + aoff + m * 2048 + k * 1024); } while (0)
#define PG8_LDB(dst, b, h) do { _Pragma("unroll") for (int n = 0; n < 2; ++n) _Pragma("unroll") for (int k = 0; k < 2; ++k) dst[n][k] = *(const LAS bf16x8*)(lds + PG8_SB(b, h) + boff + n * 2048 + k * 1024); } while (0)
#define PG8_MMA(ai, bj, At, Bt) do { __builtin_amdgcn_s_setprio(1); _Pragma("unroll") for (int m = 0; m < 4; ++m) _Pragma("unroll") for (int n = 0; n < 2; ++n) _Pragma("unroll") for (int k = 0; k < 2; ++k) \
        acc[ai][bj][m][n] = __builtin_amdgcn_mfma_f32_16x16x32_bf16(Bt[n][k], At[m][k], acc[ai][bj][m][n], 0, 0, 0); __builtin_amdgcn_s_setprio(0); } while (0)
#define PG8_WAIT_V(n) asm volatile("s_waitcnt vmcnt(" #n ")" ::: "memory")
#define PG8_WAIT_L(n) asm volatile("s_waitcnt lgkmcnt(" #n ")" ::: "memory")
#define PG8_BAR __builtin_amdgcn_s_barrier()
#define PG8_SCHED __builtin_amdgcn_sched_barrier(0)
    Unit cur, nxt; int ui = 0;
    if (!S.next(0, cur)) return;
    f32x4 acc[2][2][4][2];
#pragma unroll
    for (int a = 0; a < 2; ++a)
#pragma unroll
        for (int b = 0; b < 2; ++b)
#pragma unroll
            for (int m = 0; m < 4; ++m)
#pragma unroll
                for (int n = 0; n < 2; ++n) acc[a][b][m][n] = (f32x4){0.f, 0.f, 0.f, 0.f};
    bf16x8 At[4][2], B0[2][2], B1[2][2];
    const char* cA = (const char*)g.A + (size_t)cur.pm * tstep; const char* cB = (const char*)g.Bt + (size_t)cur.pn * tstep;
    if constexpr (SP2) {
        PG8_STAGE(PG8_SB(0, 0), cB, voffB); PG8_STAGE(PG8_SB(0, 1), cB + hstep, voffB); PG8_STAGE(PG8_SA(0, 0), cA, voffA); PG8_STAGE(PG8_SA(0, 1), cA + hstep, voffA);
        if (wr == 1) PG8_BAR;
        PG8_WAIT_V(2); PG8_BAR;
        PG8_STAGE(PG8_SB(1, 0), cB + kstep, voffB); PG8_STAGE(PG8_SA(1, 0), cA + kstep, voffA); PG8_STAGE(PG8_SB(1, 1), cB + hstep + kstep, voffB);
        PG8_WAIT_V(6); PG8_BAR;
    } else {
        PG8_STAGE(PG8_SB(0, 0), cB, voffB); PG8_STAGE(PG8_SA(0, 0), cA, voffA); PG8_STAGE(PG8_SB(0, 1), cB + hstep, voffB); PG8_STAGE(PG8_SA(0, 1), cA + hstep, voffA);
        if (wr == 1) PG8_BAR;
        PG8_WAIT_V(4); PG8_BAR;
        PG8_STAGE(PG8_SB(1, 0), cB + kstep, voffB); PG8_STAGE(PG8_SA(1, 0), cA + kstep, voffA); PG8_STAGE(PG8_SB(1, 1), cB + hstep + kstep, voffB);
        PG8_WAIT_V(6); PG8_BAR;
    }
    for (;;) {
        const bool has_next = S.next(ui + 1, nxt);
        const char* nA = has_next ? (const char*)g.A + (size_t)nxt.pm * tstep : cA; const char* nB = has_next ? (const char*)g.Bt + (size_t)nxt.pn * tstep : cB;
#pragma unroll 1
        for (int t = 0; t < nt; t += 2) {
            const bool last = (t == nt - 2);
            const char* a1 = cA + (size_t)(t + 1) * kstep;
            const char* a2 = last ? nA : cA + (size_t)(t + 2) * kstep; const char* b2 = last ? nB : cB + (size_t)(t + 2) * kstep;
            const char* a3 = a2 + kstep; const char* b3 = b2 + kstep;
            if constexpr (SP2) {
            PG8_LDB(B0, 0, 0); PG8_LDB(B1, 0, 1); PG8_SCHED; PG8_LDA(At, 0, 0); PG8_STAGE(PG8_SA(1, 1), a1 + hstep, voffA);
            PG8_WAIT_V(8); PG8_WAIT_L(0); PG8_BAR; PG8_MMA(0, 0, At, B0); PG8_MMA(0, 1, At, B1); PG8_BAR; PG8_SCHED;
            PG8_LDA(At, 0, 1); PG8_STAGE(PG8_SB(0, 0), b2, voffB); PG8_STAGE(PG8_SB(0, 1), b2 + hstep, voffB); PG8_STAGE(PG8_SA(0, 0), a2, voffA);
            PG8_WAIT_V(8); PG8_WAIT_L(0); PG8_BAR; PG8_MMA(1, 0, At, B0); PG8_MMA(1, 1, At, B1); PG8_BAR; PG8_SCHED;
            PG8_LDB(B0, 1, 0); PG8_LDB(B1, 1, 1); PG8_SCHED; PG8_LDA(At, 1, 0); PG8_STAGE(PG8_SA(0, 1), a2 + hstep, voffA);
            PG8_WAIT_V(8); PG8_WAIT_L(0); PG8_BAR; PG8_MMA(0, 0, At, B0); PG8_MMA(0, 1, At, B1); PG8_BAR; PG8_SCHED;
            PG8_LDA(At, 1, 1); PG8_STAGE(PG8_SB(1, 0), b3, voffB); PG8_STAGE(PG8_SB(1, 1), b3 + hstep, voffB); PG8_STAGE(PG8_SA(1, 0), a3, voffA);
            PG8_WAIT_V(8); PG8_WAIT_L(0); PG8_BAR; PG8_MMA(1, 0, At, B0); PG8_MMA(1, 1, At, B1); PG8_BAR; PG8_SCHED;
            } else {
            PG8_LDB(B0, 0, 0); PG8_SCHED; PG8_LDA(At, 0, 0); PG8_STAGE(PG8_SA(1, 1), a1 + hstep, voffA);
            PG8_WAIT_L(8); PG8_BAR; PG8_WAIT_L(0); PG8_MMA(0, 0, At, B0); PG8_BAR; PG8_SCHED;
            PG8_LDB(B1, 0, 1); PG8_STAGE(PG8_SB(0, 0), b2, voffB);
            PG8_BAR; PG8_WAIT_L(0); PG8_MMA(0, 1, At, B1); PG8_BAR;
            PG8_LDA(At, 0, 1); PG8_STAGE(PG8_SA(0, 0), a2, voffA);
            PG8_BAR; PG8_WAIT_L(0); PG8_MMA(1, 0, At, B0); PG8_BAR; PG8_SCHED;
            PG8_STAGE(PG8_SB(0, 1), b2 + hstep, voffB);
            PG8_WAIT_V(6); PG8_BAR; PG8_MMA(1, 1, At, B1); PG8_BAR;
            PG8_LDB(B0, 1, 0); PG8_SCHED; PG8_LDA(At, 1, 0); PG8_STAGE(PG8_SA(0, 1), a2 + hstep, voffA);
            PG8_WAIT_L(8); PG8_BAR; PG8_WAIT_L(0); PG8_MMA(0, 0, At, B0); PG8_BAR; PG8_SCHED;
            PG8_LDB(B1, 1, 1); PG8_STAGE(PG8_SB(1, 0), b3, voffB);
            PG8_BAR; PG8_WAIT_L(0); PG8_MMA(0, 1, At, B1); PG8_BAR;
            PG8_LDA(At, 1, 1); PG8_STAGE(PG8_SA(1, 0), a3, voffA);
            PG8_BAR; PG8_WAIT_L(0); PG8_MMA(1, 0, At, B0); PG8_BAR; PG8_SCHED;
            PG8_STAGE(PG8_SB(1, 1), b3 + hstep, voffB);
            PG8_WAIT_V(6); PG8_BAR; PG8_MMA(1, 1, At, B1); PG8_BAR;
            }
        }
        if constexpr (ALIGN_EPI) { if (wr == 0) PG8_BAR; }
        E(acc, cur, wr, wc, fr, fq, lds + STAGE_BYTES);
        if (!has_next) break;
#pragma unroll
        for (int a = 0; a < 2; ++a)
#pragma unroll
            for (int b = 0; b < 2; ++b)
#pragma unroll
                for (int m = 0; m < 4; ++m)
#pragma unroll
                    for (int n = 0; n < 2; ++n) acc[a][b][m][n] = (f32x4){0.f, 0.f, 0.f, 0.f};
        cur = nxt; cA = nA; cB = nB; ++ui;
        if constexpr (ALIGN_EPI) { if (wr == 1) PG8_BAR; }
    }
    PG8_WAIT_V(0);
    if constexpr (!ALIGN_EPI) { if (wr == 0) PG8_BAR; }
    PG8_BAR;
    asm volatile("" ::: "memory");
#undef PG8_SA
#undef PG8_SB
#undef PG8_STAGE
#undef PG8_LDA
#undef PG8_LDB
#undef PG8_MMA
#undef PG8_WAIT_V
#undef PG8_WAIT_L
#undef PG8_BAR
#undef PG8_SCHED
}
}

__device__ __forceinline__ int lane_id() { return (int)__builtin_amdgcn_mbcnt_hi(~0u, __builtin_amdgcn_mbcnt_lo(~0u, 0u)); }
__device__ __forceinline__ float sigmoid_f(float v) { return __builtin_amdgcn_rcpf(1.f + __expf(-v)); }
__device__ __forceinline__ float silu_f(float v) { return v * sigmoid_f(v); }
__device__ __forceinline__ unsigned f2bf(float f) { unsigned u = __builtin_bit_cast(unsigned, f); return (u + 0x7fffu + ((u >> 16) & 1u)) >> 16; }
__device__ __forceinline__ unsigned pk2(float lo, float hi) { return f2bf(lo) | (f2bf(hi) << 16); }
__device__ __forceinline__ float bf2f(bf16_t b) { return __builtin_bit_cast(float, ((unsigned)b) << 16); }
__device__ __forceinline__ int t5_bucket(int n) {
    if (n < 16) return n;
    const int l = 16 + (int)(logf((float)n * (1.f / 16.f)) * (16.f / 2.0794415416798357f));
    return l < 31 ? l : 31;
}
__device__ __forceinline__ float log_sigmoid_f(float x) { return fminf(x, 0.f) - log1pf(expf(-fabsf(x))); }

using pg8::Unit; using pg8::cvt_pk_bf16;
template <int ACT  > __device__ __forceinline__ void store_tile_bf16(const f32x4 (&acc)[2][2][4][2], bf16_t* base, int ld, float sc, int wr, int wc, int fr, int fq) {
    bf16_t* p0 = base + (size_t)(wr * 64 + fr) * ld + wc * 32 + 8 * fq;
#pragma unroll
    for (int ai = 0; ai < 2; ++ai)
#pragma unroll
        for (int m = 0; m < 4; ++m) { bf16_t* rowp = p0 + (size_t)(ai * 128 + m * 16) * ld;
#pragma unroll
            for (int bj = 0; bj < 2; ++bj) { f32x4 v0 = acc[ai][bj][m][0], v1 = acc[ai][bj][m][1];
                if (ACT == 1) {
#pragma unroll
                    for (int j = 0; j < 4; ++j) { v0[j] = silu_f(v0[j]); v1[j] = silu_f(v1[j]); } }
                else { v0 = v0 * sc; v1 = v1 * sc; }
                u32x4 w; w.x = cvt_pk_bf16(v0[0], v0[1]); w.y = cvt_pk_bf16(v0[2], v0[3]); w.z = cvt_pk_bf16(v1[0], v1[1]); w.w = cvt_pk_bf16(v1[2], v1[3]);
                *(u32x4*)(rowp + bj * 128) = w; } }
}

struct Epi1 {
    static constexpr bool PERM = true;
    unsigned char* ws;
    __device__ __forceinline__ void operator()(const f32x4 (&acc)[2][2][4][2], const Unit& u, int wr, int wc, int fr, int fq, LAS unsigned char* xl) const {
        { int l_ = lane_id(); asm volatile("" : "+v"(l_)); fr = l_ & 15; fq = (l_ >> 4) & 3; }
        const int pn = u.pn; const size_t r0 = (size_t)u.pm * 256;
        bf16_t* const Q = (bf16_t*)(ws + WS_Q); bf16_t* const C = (bf16_t*)(ws + WS_C); bf16_t* const SZA = (bf16_t*)(ws + WS_SZA); bf16_t* const QI = (bf16_t*)(ws + WS_QI);
        bf16_t* const KI = (bf16_t*)(ws + WS_KI); bf16_t* const QKM = (bf16_t*)(ws + WS_QKM); bf16_t* const VM = (bf16_t*)(ws + WS_VM); bf16_t* const GM = (bf16_t*)(ws + WS_GM);
        float* const WI = (float*)(ws + WS_WI); float* const IFG = (float*)(ws + WS_IFG);
        const float* const kvg = (const float*)(ws + WS_PAR) + P_KVG; const float* const lng = (const float*)(ws + WS_PAR) + P_LNG; const float* const lnb = (const float*)(ws + WS_PAR) + P_LNB;
        if (pn < 4) { store_tile_bf16<0>(acc, Q + r0 * 1024 + pn * 256, 1024, QSCALE, wr, wc, fr, fq); return; }
        if (pn == 4) {
            LAS float* P = (LAS float*)xl;
#pragma unroll
            for (int ai = 0; ai < 2; ++ai)
#pragma unroll
                for (int m = 0; m < 4; ++m) { float s = 0.f;
#pragma unroll
                    for (int bj = 0; bj < 2; ++bj)
#pragma unroll
                        for (int n = 0; n < 2; ++n) { const f32x4 x = acc[ai][bj][m][n]; s += (x[0] * x[0] + x[1] * x[1]) + (x[2] * x[2] + x[3] * x[3]); }
                    s += __shfl_xor(s, 16); s += __shfl_xor(s, 32);
                    if (fq == 0) P[(ai * 128 + wr * 64 + m * 16 + fr) * 4 + wc] = s; }
            asm volatile("s_waitcnt lgkmcnt(0)" ::: "memory"); __builtin_amdgcn_s_barrier(); asm volatile("" ::: "memory");
            const int c0 = wc * 32 + 8 * fq;
            f32x4 g[2][2];
#pragma unroll
            for (int bj = 0; bj < 2; ++bj) { g[bj][0] = *(const f32x4*)(kvg + bj * 128 + c0); g[bj][1] = *(const f32x4*)(kvg + bj * 128 + c0 + 4); }
#pragma unroll
            for (int ai = 0; ai < 2; ++ai)
#pragma unroll
                for (int m = 0; m < 4; ++m) { const int r = ai * 128 + wr * 64 + m * 16 + fr;
                    const f32x4 pp = *(const LAS f32x4*)(P + r * 4);
                    const float rstd = rsqrtf(((pp[0] + pp[1]) + (pp[2] + pp[3])) * (1.f / 256.f) + LN_EPS);
                    bf16_t* rowp = C + (r0 + r) * 256 + c0;
#pragma unroll
                    for (int bj = 0; bj < 2; ++bj) { const f32x4 v0 = acc[ai][bj][m][0] * rstd * g[bj][0], v1 = acc[ai][bj][m][1] * rstd * g[bj][1];
                        u32x4 w; w.x = cvt_pk_bf16(v0[0], v0[1]); w.y = cvt_pk_bf16(v0[2], v0[3]); w.z = cvt_pk_bf16(v1[0], v1[1]); w.w = cvt_pk_bf16(v1[2], v1[3]);
                        *(u32x4*)(rowp + bj * 128) = w; } }
            asm volatile("s_waitcnt lgkmcnt(0)" ::: "memory"); __builtin_amdgcn_s_barrier(); asm volatile("" ::: "memory");
            return;
        }
        if (pn < 9) { store_tile_bf16<1>(acc, SZA + r0 * 1024 + (pn - 5) * 256, 1024, 1.f, wr, wc, fr, fq); return; }
        if (pn < 13) { store_tile_bf16<0>(acc, QI + r0 * 1024 + (pn - 9) * 256, 1024, 0.125f, wr, wc, fr, fq); return; }
        if (pn == 13) {
            if (wc == 0) {
                f32x4 g[2][2], bb[2][2];
#pragma unroll
                for (int bj = 0; bj < 2; ++bj)
#pragma unroll
                    for (int n = 0; n < 2; ++n) { g[bj][n] = *(const f32x4*)(lng + 32 * bj + 8 * fq + 4 * n); bb[bj][n] = *(const f32x4*)(lnb + 32 * bj + 8 * fq + 4 * n); }
#pragma unroll
                for (int ai = 0; ai < 2; ++ai)
#pragma unroll
                    for (int m = 0; m < 4; ++m) { float s = 0.f;
#pragma unroll
                        for (int bj = 0; bj < 2; ++bj)
#pragma unroll
                            for (int n = 0; n < 2; ++n) { const f32x4 x = acc[ai][bj][m][n]; s += (x[0] + x[1]) + (x[2] + x[3]); }
                        s += __shfl_xor(s, 16); s += __shfl_xor(s, 32);
                        const float mu = s * (1.f / 64.f); float q = 0.f;
#pragma unroll
                        for (int bj = 0; bj < 2; ++bj)
#pragma unroll
                            for (int n = 0; n < 2; ++n) { const f32x4 d = acc[ai][bj][m][n] - mu; q += (d[0] * d[0] + d[1] * d[1]) + (d[2] * d[2] + d[3] * d[3]); }
                        q += __shfl_xor(q, 16); q += __shfl_xor(q, 32);
                        const float rstd = rsqrtf(q * (1.f / 64.f) + LN_EPS);
                        bf16_t* rowp = KI + (r0 + ai * 128 + wr * 64 + m * 16 + fr) * 64 + 8 * fq;
#pragma unroll
                        for (int bj = 0; bj < 2; ++bj) { const f32x4 v0 = (acc[ai][bj][m][0] - mu) * rstd * g[bj][0] + bb[bj][0], v1 = (acc[ai][bj][m][1] - mu) * rstd * g[bj][1] + bb[bj][1];
                            u32x4 w; w.x = cvt_pk_bf16(v0[0], v0[1]); w.y = cvt_pk_bf16(v0[2], v0[3]); w.z = cvt_pk_bf16(v1[0], v1[1]); w.w = cvt_pk_bf16(v1[2], v1[3]);
                            *(u32x4*)(rowp + bj * 32) = w; } }
            } else if (wc == 1) {
#pragma unroll
                for (int ai = 0; ai < 2; ++ai)
#pragma unroll
                    for (int m = 0; m < 4; ++m) { const size_t r = r0 + ai * 128 + wr * 64 + m * 16 + fr;
                        if (fq < 2) { *(f32x4*)(WI + r * 16 + 8 * fq) = acc[ai][0][m][0] * 0.25f; *(f32x4*)(WI + r * 16 + 8 * fq + 4) = acc[ai][0][m][1] * 0.25f; }
                        else if (fq == 2) { *(f32x4*)(IFG + r * 8) = acc[ai][0][m][0]; *(f32x4*)(IFG + r * 8 + 4) = acc[ai][0][m][1]; } }
            }
            return;
        }
        if (pn < 18) { store_tile_bf16<0>(acc, QKM + r0 * 1024 + (pn - 14) * 256, 1024, 1.f, wr, wc, fr, fq); return; }
        if (pn < 22) { store_tile_bf16<0>(acc, VM + r0 * 1024 + (pn - 18) * 256, 1024, 1.f, wr, wc, fr, fq); return; }
        {
            bf16_t* p0 = GM + (r0 + wr * 64 + fr) * 1024 + (pn - 22) * 128 + wc * 32 + 8 * fq;
#pragma unroll
            for (int ai = 0; ai < 2; ++ai)
#pragma unroll
                for (int m = 0; m < 4; ++m) { f32x4 v0, v1;
#pragma unroll
                    for (int j = 0; j < 4; ++j) { v0[j] = sigmoid_f(acc[ai][0][m][0][j]) * silu_f(acc[ai][1][m][0][j]); v1[j] = sigmoid_f(acc[ai][0][m][1][j]) * silu_f(acc[ai][1][m][1][j]); }
                    u32x4 w; w.x = cvt_pk_bf16(v0[0], v0[1]); w.y = cvt_pk_bf16(v0[2], v0[3]); w.z = cvt_pk_bf16(v1[0], v1[1]); w.w = cvt_pk_bf16(v1[2], v1[3]);
                    *(u32x4*)(p0 + (size_t)(ai * 128 + m * 16) * 1024) = w; }
        }
    }
};
struct EpiKV {
    static constexpr bool PERM = true;
    bf16_t *Kb, *Vb;
    __device__ __forceinline__ void operator()(const f32x4 (&acc)[2][2][4][2], const Unit& u, int wr, int wc, int fr, int fq, LAS unsigned char*) const {
        { int l_ = lane_id(); asm volatile("" : "+v"(l_)); fr = l_ & 15; fq = (l_ >> 4) & 3; }
        bf16_t* base = (u.pn < 4 ? Kb + u.pn * 256 : Vb + (u.pn - 4) * 256) + (size_t)u.pm * 256 * 1024;
        store_tile_bf16<0>(acc, base, 1024, 1.f, wr, wc, fr, fq);
    }
};
struct EpiOut {
    static constexpr bool PERM = false;
    const float* x; float* out;
    __device__ __forceinline__ void operator()(const f32x4 (&acc)[2][2][4][2], const Unit& u, int wr, int wc, int fr, int fq, LAS unsigned char*) const {
        { int l_ = lane_id(); asm volatile("" : "+v"(l_)); fr = l_ & 15; fq = (l_ >> 4) & 3; }
        const size_t off0 = ((size_t)u.pm * 256 + wr * 64 + fr) * DM + u.pn * 256 + wc * 32 + 4 * fq;
#pragma unroll
        for (int ai = 0; ai < 2; ++ai)
#pragma unroll
            for (int m = 0; m < 4; ++m) { const size_t off = off0 + (size_t)(ai * 128 + m * 16) * DM;
#pragma unroll
                for (int bj = 0; bj < 2; ++bj)
#pragma unroll
                    for (int n = 0; n < 2; ++n) { const f32x4 xv = *(const f32x4*)(x + off + bj * 128 + n * 16);
                        *(f32x4*)(out + off + bj * 128 + n * 16) = xv * ALPHA + acc[ai][bj][m][n]; } }
    }
};


#define XB_TMO      128
#define XB_XCNT(j)  (256  + 64 * (j))
#define XB_XSUB(j)  (1280 + 64 * (j))
#define XB_XGEN(j)  (2304 + 64 * (j))
#define XB_TOP      3328
#define XB_TOPGEN   3392
#define XCD_BAR_WORDS 3456
#define XB_SPIN_CAP (1u << 18)
__device__ __forceinline__ unsigned xb_ld(unsigned* p)              { return __hip_atomic_load(p, __ATOMIC_RELAXED, __HIP_MEMORY_SCOPE_AGENT); }
__device__ __forceinline__ unsigned xb_add(unsigned* p, unsigned v) { return __hip_atomic_fetch_add(p, v, __ATOMIC_RELAXED, __HIP_MEMORY_SCOPE_AGENT); }
__device__ __forceinline__ unsigned xb_xcc_id() { return (unsigned)__builtin_amdgcn_s_getreg((3 << 11) | 20) & 0xFu; }
#define XB_SPIN(cond, bar) do { unsigned _sp = 0; while (cond) { __builtin_amdgcn_s_sleep(1); \
    if ((++_sp & 255u) == 0u) { if (xb_ld(&(bar)[XB_TMO])) break; if (_sp > XB_SPIN_CAP) { atomicAdd(&(bar)[XB_TMO], 1u); break; } } } } while (0)
struct XcdBarrier { unsigned* bar; unsigned x; volatile LAS unsigned* st; };
__device__ __forceinline__ XcdBarrier xcd_barrier_post(unsigned* bar, volatile LAS unsigned* st) {
    XcdBarrier b; b.bar = bar; b.x = xb_xcc_id(); b.st = st;
    if (threadIdx.x == 0) (void)xb_add(&bar[XB_XCNT(b.x)], 1u);
    return b;
}
__device__ __forceinline__ void xcd_barrier_complete(unsigned* bar, unsigned x, unsigned& nloc, unsigned& nx) {
    const unsigned G = gridDim.x * gridDim.y * gridDim.z;
    unsigned sum, cnt, mine, sp = 0u;
    for (;;) {
        sum = 0u; cnt = 0u; mine = 0u;
#pragma unroll
        for (unsigned j = 0; j < 16; ++j) { const unsigned c = xb_ld(&bar[XB_XCNT(j)]); sum += c; cnt += (c > 0u) ? 1u : 0u; mine = (j == x) ? c : mine; }
        if (sum == G) break;
        __builtin_amdgcn_s_sleep(1);
        if ((++sp & 255u) == 0u) { if (xb_ld(&bar[XB_TMO])) break; if (sp > XB_SPIN_CAP) { atomicAdd(&bar[XB_TMO], 1u); break; } }
    }
    nloc = mine > 0u ? mine : 1u; nx = cnt > 0u ? cnt : 1u;
}
__device__ __forceinline__ void xcd_barrier(const XcdBarrier& b, int wave_) {
    asm volatile("s_waitcnt vmcnt(0)" ::: "memory");
    __syncthreads();
    if (wave_ == 0 && lane_id() == 0) {
        unsigned* bar = b.bar;
        __builtin_amdgcn_s_waitcnt(0);
        unsigned nloc = b.st[0], nx = b.st[1];
        if (nloc == 0u) { xcd_barrier_complete(bar, b.x, nloc, nx); b.st[0] = nloc; b.st[1] = nx; }
        const unsigned old = xb_add(&bar[XB_XSUB(b.x)], 1u);
        const unsigned gen = old / nloc;
        if (old + 1u == (gen + 1u) * nloc) {
            __builtin_amdgcn_fence(__ATOMIC_RELEASE, "agent");
            asm volatile("s_waitcnt vmcnt(0)" ::: "memory");
            const unsigned og = xb_add(&bar[XB_TOP], 1u);
            const unsigned tg = og / nx;
            if (og + 1u == (tg + 1u) * nx) xb_add(&bar[XB_TOPGEN], 1u);
            else XB_SPIN(xb_ld(&bar[XB_TOPGEN]) == tg, bar);
            __builtin_amdgcn_fence(__ATOMIC_ACQUIRE, "agent");
            xb_add(&bar[XB_XGEN(b.x)], 1u);
            asm volatile("s_waitcnt vmcnt(0)" ::: "memory");
        } else {
            XB_SPIN(xb_ld(&bar[XB_XGEN(b.x)]) == gen, bar);
            __builtin_amdgcn_fence(__ATOMIC_ACQUIRE, "agent");
            asm volatile("s_waitcnt vmcnt(0)" ::: "memory");
        }
    }
    __syncthreads();
}

typedef float f32x16 __attribute__((ext_vector_type(16)));
__device__ __forceinline__ unsigned mono_key(float s) { s = s + 0.0f; const unsigned u = __builtin_bit_cast(unsigned, s); return (u & 0x80000000u) ? ~u : (u | 0x80000000u); }
__device__ __forceinline__ float swap_add(float a, float b) {
    auto rr = __builtin_amdgcn_permlane32_swap(__builtin_bit_cast(unsigned, a), __builtin_bit_cast(unsigned, b), false, false);
    return __builtin_bit_cast(float, (unsigned)rr[0]) + __builtin_bit_cast(float, (unsigned)rr[1]);
}
#define WRITELANE(dst, sval, ln) asm volatile("v_writelane_b32 %0, %1, %2" : "+v"(dst) : "s"(__builtin_amdgcn_readfirstlane((int)(sval))), "i"(ln))
__device__ __forceinline__ unsigned wave_sum_u32(unsigned v) {
    v += (unsigned)__builtin_amdgcn_update_dpp(0, (int)v, 0xB1, 0xF, 0xF, true);
    v += (unsigned)__builtin_amdgcn_update_dpp(0, (int)v, 0x4E, 0xF, 0xF, true);
    v += (unsigned)__builtin_amdgcn_update_dpp(0, (int)v, 0x141, 0xF, 0xF, true);
    v += (unsigned)__builtin_amdgcn_update_dpp(0, (int)v, 0x140, 0xF, 0xF, true);
    return (unsigned)__builtin_amdgcn_readlane((int)v, 0) + (unsigned)__builtin_amdgcn_readlane((int)v, 16) + (unsigned)__builtin_amdgcn_readlane((int)v, 32) + (unsigned)__builtin_amdgcn_readlane((int)v, 48);
}
__device__ __forceinline__ void emit_mask(const unsigned (&K)[32], unsigned T, bool exact, int ng, int t, unsigned long long* mrow, int lane, LAS unsigned long long* wl) {
    if (lane < 32) wl[lane] = 0ull;
    asm volatile("s_waitcnt lgkmcnt(0)" ::: "memory");
    if (exact) {
#pragma unroll
        for (int g = 0; g < 32; ++g) if (g < ng) { const unsigned long long w = __ballot(K[g] >= T); if (lane == 0) wl[g] = w; }
    } else {
        int gt = 0;
#pragma unroll
        for (int g = 0; g < 32; ++g) gt += __popcll(__ballot(K[g] > T));
        int need = NSEL - gt;
#pragma unroll
        for (int g = 0; g < 32; ++g) {
            const unsigned long long gtm = __ballot(K[g] > T); unsigned long long m = __ballot(K[g] == T);
            const int c = __popcll(m), take = c < need ? c : need;
            while (__popcll(m) > take) m &= ~(1ull << (63 - __clzll((long long)m)));
            need -= take;
            const unsigned long long w = gtm | m;
            if (lane == 0) wl[g] = w;
        }
    }
    asm volatile("s_waitcnt lgkmcnt(0)" ::: "memory");
    if (lane < 32) mrow[(size_t)lane * SEQ + t] = wl[lane];
    asm volatile("s_waitcnt lgkmcnt(0)" ::: "memory");
}
__device__ __forceinline__ void select2_store(const unsigned (&K0)[32], const unsigned (&K1)[32], int ng, int t, unsigned long long* mrow, int lane, LAS unsigned long long* wl) {
    unsigned T0 = 0u, T1 = 0u; bool ex0 = false, ex1 = false;
#pragma unroll 1
    for (int bit = 31; bit >= 0; --bit) {
        const unsigned cand0 = ex0 ? 0xffffffffu : (T0 | (1u << bit)), cand1 = ex1 ? 0xffffffffu : (T1 | (1u << bit));
        unsigned c0 = 0u, c1 = 0u;
#pragma unroll
        for (int gg = 0; gg < 8; ++gg) if (4 * gg < ng) {
#pragma unroll
            for (int j = 0; j < 4; ++j) { c0 += K0[4 * gg + j] >= cand0 ? 1u : 0u; c1 += K1[4 * gg + j] >= cand1 ? 1u : 0u; } }
        const unsigned tot = wave_sum_u32(c0 + (c1 << 16)); const int n0 = (int)(tot & 0xffffu), n1 = (int)(tot >> 16);
        if (!ex0) { if (n0 >= NSEL) T0 = cand0; if (n0 == NSEL) ex0 = true; }
        if (!ex1) { if (n1 >= NSEL) T1 = cand1; if (n1 == NSEL) ex1 = true; }
        if (ex0 && ex1) break;
    }
    emit_mask(K0, T0, ex0, ng, t, mrow, lane, wl);
    emit_mask(K1, T1, ex1, ng, t + 1, mrow, lane, wl);
}
__device__ __forceinline__ void topk_unit(const bf16_t* __restrict__ QI, const bf16_t* __restrict__ KI, const float* __restrict__ WI, unsigned long long* mask, int b, int i, int wave, int lane, LAS unsigned long long* wl, LAS unsigned char* kt) {
    const int t0 = i * 16, tq = t0 + 2 * wave;
    const size_t rb = (size_t)b * SEQ;
    unsigned long long* mrow = mask + (size_t)b * 32 * SEQ;
    if (t0 + 15 < NSEL) {
        const int g = lane & 31, t = tq + (lane >> 5), n = t - 64 * g + 1;
        mrow[(size_t)g * SEQ + t] = n >= 64 ? ~0ull : (n <= 0 ? 0ull : ((1ull << n) - 1ull));
        return;
    }
    const int r = lane & 31, hi = lane >> 5;
    bf16x8 A[4];
    { const bf16_t* qp = QI + (rb + tq + (r >> 4)) * 1024 + (r & 15) * 64 + hi * 8;
#pragma unroll
      for (int ks = 0; ks < 4; ++ks) A[ks] = *(const bf16x8*)(qp + ks * 16); }
    float wv[16];
#pragma unroll
    for (int reg = 0; reg < 16; ++reg) { const int hh = (reg & 3) + 8 * ((reg >> 2) & 1) + 4 * hi; wv[reg] = WI[(rb + tq + (reg >> 3)) * 16 + hh]; }
    const int ng = (t0 + 15) / 64 + 1;
    unsigned K0[32], K1[32];
    const int tid = wave * 64 + lane, skey = tid >> 3, sch = tid & 7;
    const GAS bf16_t* kp = (const GAS bf16_t*)KI + (rb + skey) * 64 + sch * 8;
    const int swr = skey * 128 + ((sch ^ ((skey >> 1) & 7)) << 4);
    int rdo[2][2];
#pragma unroll
    for (int th = 0; th < 2; ++th) { const int row = 32 * th + r; rdo[th][0] = row * 128; rdo[th][1] = (row >> 1) & 7; }
    u32x4 stg;
    asm volatile("" : "+v"(kp)); stg = *(const GAS u32x4*)kp; kp += 64 * 64;
    *(LAS u32x4*)(kt + swr) = stg;
    __syncthreads();
#pragma unroll
    for (int g = 0; g < 32; ++g) {
        if (g < ng) {
            if (g + 1 < ng) { asm volatile("" : "+v"(kp)); stg = *(const GAS u32x4*)kp; kp += 64 * 64; }
            const LAS unsigned char* kb = kt + (g & 1) * 8192;
            bf16x8 B0[4], B1[4];
#pragma unroll
            for (int ks = 0; ks < 4; ++ks) { B0[ks] = *(const LAS bf16x8*)(kb + rdo[0][0] + (((2 * ks + hi) ^ rdo[0][1]) << 4)); B1[ks] = *(const LAS bf16x8*)(kb + rdo[1][0] + (((2 * ks + hi) ^ rdo[1][1]) << 4)); }
            f32x16 a0 = {}, a1 = {};
#pragma unroll
            for (int ks = 0; ks < 4; ++ks) { a0 = __builtin_amdgcn_mfma_f32_32x32x16_bf16(A[ks], B0[ks], a0, 0, 0, 0); a1 = __builtin_amdgcn_mfma_f32_32x32x16_bf16(A[ks], B1[ks], a1, 0, 0, 0); }
            float p00 = 0.f, p01 = 0.f, p10 = 0.f, p11 = 0.f;
#pragma unroll
            for (int reg = 0; reg < 8; ++reg) { p00 = fmaf(fmaxf(a0[reg], 0.f), wv[reg], p00); p10 = fmaf(fmaxf(a1[reg], 0.f), wv[reg], p10);
                                                p01 = fmaf(fmaxf(a0[reg + 8], 0.f), wv[reg + 8], p01); p11 = fmaf(fmaxf(a1[reg + 8], 0.f), wv[reg + 8], p11); }
            const float sA = swap_add(p00, p01), sB = swap_add(p10, p11);
            auto rr = __builtin_amdgcn_permlane32_swap(__builtin_bit_cast(unsigned, sA), __builtin_bit_cast(unsigned, sB), false, false);
            const float s0 = __builtin_bit_cast(float, (unsigned)rr[0]), s1 = __builtin_bit_cast(float, (unsigned)rr[1]);
            const int lim = tq - 64 * g;
            K0[g] = lane <= lim ? mono_key(s0) : 0u; K1[g] = lane <= lim + 1 ? mono_key(s1) : 0u;
            if (g + 1 < ng) *(LAS u32x4*)(kt + ((g + 1) & 1) * 8192 + swr) = stg;
            __syncthreads();
        } else { K0[g] = 0u; K1[g] = 0u; }
    }
    select2_store(K0, K1, ng, tq, mrow, lane, wl);
}

namespace att {
constexpr int NW = 8, QBLK = 32, KVBLK = 64, QB = NW * QBLK, D = 128, RS = 1024, OS = 2048;
constexpr int SHM_V = KVBLK * D * 2, SHM_K = KVBLK * D * 2;
constexpr int LDS_WS = 2 * SHM_V + 2 * SHM_K, LDS_LUT = LDS_WS + NW * 64 * 4, LDS_TOTAL = LDS_LUT + 512;
constexpr float THRL = 11.5f;
typedef short s16x4 __attribute__((ext_vector_type(4)));
#define KSWZ(row, colB) ((row) * 256 + ((colB) ^ (((row) & 7) << 4)))
#define SBAR() __builtin_amdgcn_sched_barrier(0)
__device__ __forceinline__ int v_st(int k, int c) { const int kk = (k & ~0xC) | ((k & 4) << 1) | ((k & 8) >> 1); return ((kk >> 3) * 4 + (c >> 5)) * 512 + ((kk & 7) * 32 + (c & 31)) * 2; }
__device__ __forceinline__ int v_rd_base(int lane) { return ((lane & 3) << 3) | (((lane >> 2) & 3) << 6) | (((lane >> 4) & 1) << 5) | (((lane >> 5) & 1) << 8); }
constexpr int v_rd_off(int d0, int ks, int half) { return d0 * 512 + ks * 4096 + half * 2048; }
__device__ __forceinline__ int crow(int r, int hi) { return (r & 3) + 8 * (r >> 2) + 4 * hi; }
__device__ __forceinline__ unsigned cvtpk(float lo, float hi) { return pg8::cvt_pk_bf16(lo, hi); }
__device__ __forceinline__ bf16x8 ld8(const bf16_t* p) { return *reinterpret_cast<const bf16x8*>(p); }
__device__ __forceinline__ void apply_mask(f32x16& p0, f32x16& p1, unsigned long long mw, int hi) {
    const unsigned a = (unsigned)mw >> (4 * hi), b = (unsigned)(mw >> 32) >> (4 * hi);
#pragma unroll
    for (int r = 0; r < 16; ++r) { const int c = (r & 3) + 8 * (r >> 2);
        p0[r] = (a & (1u << c)) ? p0[r] : -__builtin_inff();
        p1[r] = (b & (1u << c)) ? p1[r] : -__builtin_inff(); }
}
__device__ __forceinline__ void add_bias(f32x16& p0, f32x16& p1, const float* lut, int dq) {
#pragma unroll
    for (int r = 0; r < 16; ++r) { const int c = (r & 3) + 8 * (r >> 2);
        int i0 = dq - c, i1 = dq - c - 32; i0 = i0 < 0 ? 0 : (i0 > 127 ? 127 : i0); i1 = i1 < 0 ? 0 : (i1 > 127 ? 127 : i1);
        p0[r] += lut[i0]; p1[r] += lut[i1]; }
}
__device__ __forceinline__ void partialSM(f32x16& p0, f32x16& p1, float& m_reg, float& mn, float& alpha) {
    float pmax = p0[0];
#pragma unroll
    for (int r = 1; r < 16; ++r) pmax = fmaxf(pmax, p0[r]);
#pragma unroll
    for (int r = 0; r < 16; ++r) pmax = fmaxf(pmax, p1[r]);
    { auto rr = __builtin_amdgcn_permlane32_swap(__float_as_uint(pmax), __float_as_uint(pmax), false, false);
      pmax = fmaxf(__uint_as_float(rr[0]), __uint_as_float(rr[1])); }
    if (__builtin_expect(__all(pmax - m_reg <= THRL), 1)) { mn = m_reg; alpha = 1.f; }
    else { mn = fmaxf(m_reg, pmax); alpha = __builtin_amdgcn_exp2f(m_reg - mn); m_reg = mn; }
#pragma unroll
    for (int r = 0; r < 16; ++r) { p0[r] = p0[r] - mn; p1[r] = p1[r] - mn; }
#pragma unroll
    for (int r = 0; r < 16; ++r) p0[r] = __builtin_amdgcn_exp2f(p0[r]);
}
__device__ __forceinline__ void finishSM(f32x16& p0, f32x16& p1, float alpha, float& l_reg, bf16x8& pa0, bf16x8& pa1, bf16x8& pa2, bf16x8& pa3) {
#pragma unroll
    for (int r = 0; r < 16; ++r) p1[r] = __builtin_amdgcn_exp2f(p1[r]);
    float ps = 0;
#pragma unroll
    for (int r = 0; r < 16; ++r) ps += p0[r];
#pragma unroll
    for (int r = 0; r < 16; ++r) ps += p1[r];
    { auto rr = __builtin_amdgcn_permlane32_swap(__float_as_uint(ps), __float_as_uint(ps), false, false);
      ps = __uint_as_float(rr[0]) + __uint_as_float(rr[1]); }
    l_reg = l_reg * alpha + ps;
#define PK4(P, B_, OUT) do { unsigned a0 = cvtpk(P[B_+0], P[B_+1]), a1 = cvtpk(P[B_+2], P[B_+3]);                          \
        unsigned b0 = cvtpk(P[B_+4], P[B_+5]), b1 = cvtpk(P[B_+6], P[B_+7]);                                             \
        auto r0 = __builtin_amdgcn_permlane32_swap(a0, b0, false, false); auto r1 = __builtin_amdgcn_permlane32_swap(a1, b1, false, false); \
        u32x4 w = {r0[0], r1[0], r0[1], r1[1]}; OUT = *reinterpret_cast<bf16x8*>(&w); } while (0)
    PK4(p0, 0, pa0); PK4(p0, 8, pa1); PK4(p1, 0, pa2); PK4(p1, 8, pa3);
#undef PK4
}
template <int KB>
__device__ __forceinline__ void qkt(f32x16& p0, f32x16& p1, const char* K_lds, int r32, int hi, const bf16x8* qr) {
    p0 = f32x16{}; p1 = f32x16{};
    const char* kb[4];
#pragma unroll
    for (int dd = 0; dd < 4; ++dd) kb[dd] = K_lds + KB * SHM_K + KSWZ(r32, (dd * 16 + hi * 8) * 2);
#pragma unroll
    for (int d0 = 0; d0 < 8; ++d0) { const char* a = kb[d0 & 3] + (d0 >> 2) * 128;
        bf16x8 b0 = *reinterpret_cast<const bf16x8*>(a);
        bf16x8 b1 = *reinterpret_cast<const bf16x8*>(a + 32 * 256);
        p0 = __builtin_amdgcn_mfma_f32_32x32x16_bf16(b0, qr[d0], p0, 0, 0, 0);
        p1 = __builtin_amdgcn_mfma_f32_32x32x16_bf16(b1, qr[d0], p1, 0, 0, 0); }
}
template <int VB>
__device__ __forceinline__ void pv_tile(f32x16* o, int vb0, bf16x8 pa0, bf16x8 pa1, bf16x8 pa2, bf16x8 pa3) {
#define TRRD(dst, off) asm volatile("ds_read_b64_tr_b16 %0, %1 offset:%2" : "=&v"(dst) : "v"(vb0), "i"(off) : "memory")
#define PV_D0(d0) do { s16x4 l0, l1, l2, l3, h0, h1, h2, h3; constexpr int b_ = VB * SHM_V + v_rd_off(d0, 0, 0); \
        TRRD(l0, b_); TRRD(h0, b_ + 2048); TRRD(l1, b_ + 4096); TRRD(h1, b_ + 6144); TRRD(l2, b_ + 8192); TRRD(h2, b_ + 10240); TRRD(l3, b_ + 12288); TRRD(h3, b_ + 14336); \
        asm volatile("s_waitcnt lgkmcnt(0)" ::: "memory"); SBAR();   \
        o[d0] = __builtin_amdgcn_mfma_f32_32x32x16_bf16(pa0, (bf16x8){l0[0], l0[1], l0[2], l0[3], h0[0], h0[1], h0[2], h0[3]}, o[d0], 0, 0, 0);   \
        o[d0] = __builtin_amdgcn_mfma_f32_32x32x16_bf16(pa1, (bf16x8){l1[0], l1[1], l1[2], l1[3], h1[0], h1[1], h1[2], h1[3]}, o[d0], 0, 0, 0);   \
        o[d0] = __builtin_amdgcn_mfma_f32_32x32x16_bf16(pa2, (bf16x8){l2[0], l2[1], l2[2], l2[3], h2[0], h2[1], h2[2], h2[3]}, o[d0], 0, 0, 0);   \
        o[d0] = __builtin_amdgcn_mfma_f32_32x32x16_bf16(pa3, (bf16x8){l3[0], l3[1], l3[2], l3[3], h3[0], h3[1], h3[2], h3[3]}, o[d0], 0, 0, 0); } while (0)
    PV_D0(0); PV_D0(1); PV_D0(2); PV_D0(3);
#undef PV_D0
#undef TRRD
}
struct BlockRef { const bf16_t* Q; const bf16_t* K; const bf16_t* V; bf16_t* O; const bf16_t* Z; const unsigned long long* MK; int P0; };
struct Seam { bf16x8 qr[8]; bf16x8 st_v0, st_v1, st_k0, st_k1; };
#define ROW(p, k0, rr) ((p) + (size_t)((k0) + (rr)) * RS + sc)
#define VMW() asm volatile("s_waitcnt vmcnt(0)" ::: "memory")
#define VMWN(n) asm volatile("s_waitcnt vmcnt(%0)" :: "i"(n) : "memory")
#define SLOAD_H(Kp, Vp, k0) do { unsigned o_ = soff; asm volatile("" : "+v"(o_)); const char* kp_ = (const char*)(Kp) + (size_t)(k0) * (RS * 2); const char* vp_ = (const char*)(Vp) + (size_t)(k0) * (RS * 2); \
        S.st_v0 = *(const bf16x8*)(vp_ + o_); S.st_v1 = *(const bf16x8*)(vp_ + o_ + 32 * RS * 2); S.st_k0 = *(const bf16x8*)(kp_ + o_); S.st_k1 = *(const bf16x8*)(kp_ + o_ + 32 * RS * 2); } while (0)
#define QLOAD(Qp) do { unsigned o_ = qoff; asm volatile("" : "+v"(o_)); const char* qp_ = (const char*)(Qp); _Pragma("unroll") for (int d0 = 0; d0 < 8; ++d0) S.qr[d0] = *(const bf16x8*)(qp_ + o_ + d0 * 32); } while (0)
#define MLOAD(t) ({ unsigned o_ = moff; asm volatile("" : "+v"(o_)); *(const unsigned long long*)((const char*)cur.MK + (size_t)(t) * (SEQ * 8) + o_); })
#define SWRITE_HK(bf) do { *(bf16x8*)(K_lds + (bf) * SHM_K + kws) = S.st_k0; *(bf16x8*)(K_lds + (bf) * SHM_K + kws + 32 * 256) = S.st_k1; } while (0)
#define SWRITE_HV(bf) do { *(bf16x8*)(V_lds + (bf) * SHM_V + vst0) = S.st_v0; *(bf16x8*)(V_lds + (bf) * SHM_V + vst1) = S.st_v1; } while (0)
#define SWRITE_H(bf) do { SWRITE_HV(bf); SWRITE_HK(bf); } while (0)
__device__ __forceinline__ void prime(const BlockRef& cur, char* lds, Seam& S, const float* rel_bias, int h, int wid) {
    const int lane = lane_id(), tid = wid * 64 + lane, r32 = lane & 31, hi = lane >> 5;
    const int sr = tid >> 4, sc = (tid & 15) * 8, kws = KSWZ(sr, sc * 2); char* K_lds = lds + 2 * SHM_V;
    const unsigned soff = (unsigned)(sr * RS + sc) * 2u, qoff = (unsigned)((wid * QBLK + r32) * RS + hi * 8) * 2u;
    if (tid < 128) ((float*)(lds + LDS_LUT))[tid] = (rel_bias[t5_bucket(tid) * HA + h] - rel_bias[31 * HA + h]) * LOG2E;
    QLOAD(cur.Q);
    SLOAD_H(cur.K, cur.V, 0); VMW(); SWRITE_HK(0);
    __syncthreads();
}
__device__ __forceinline__ void block(const BlockRef& cur, const BlockRef& nxt, char* lds, Seam& S, int wid) {
    int tid = wid * 64 + lane_id(); asm volatile("" : "+v"(tid));
    const int lane = tid & 63, r32 = lane & 31, hi = lane >> 5;
    const int NT = cur.P0 / KVBLK + 4;
    const int qlo = cur.P0 + wid * QBLK, qrow = qlo + r32, qm = qrow - 4 * hi;
    char* V_lds = lds; char* K_lds = lds + 2 * SHM_V;
    float* ws = (float*)(lds + LDS_WS) + wid * 64; float* li_l = ws, * al_l = ws + 32;
    const float* lut = (const float*)(lds + LDS_LUT);
    float m_reg = -1e30f, l_reg = 0; f32x16 o[4] = {};
    const int sr = tid >> 4, sc = (tid & 15) * 8, vst0 = v_st(sr, sc), vst1 = v_st(32 + sr, sc), kws = KSWZ(sr, sc * 2);
    const int vb0 = (int)(uintptr_t)V_lds + v_rd_base(lane);
    const bf16_t* Kh = cur.K; const bf16_t* Vh = cur.V;
    const unsigned soff = (unsigned)(sr * RS + sc) * 2u, qoff = (unsigned)((wid * QBLK + r32) * RS + hi * 8) * 2u, moff = (unsigned)(wid * QBLK + r32) * 8u;
#define RESC(a) do { if (__any((a) < 1.f)) { if (hi == 0) al_l[r32] = (a); asm volatile("s_waitcnt lgkmcnt(0)" ::: "memory");              \
                     for (int d_ = 0; d_ < 4; ++d_) for (int r = 0; r < 16; ++r) o[d_][r] *= al_l[crow(r, hi)]; } } while (0)
#define KBASE(t) ((t) * KVBLK)
#define MASKT(P0_, P1_, mw, t) do { const int kb_ = KBASE(t); if (kb_ + 176 > qlo) add_bias(P0_, P1_, lut, qm - kb_); apply_mask(P0_, P1_, mw, hi); } while (0)
#define SEAM_K0() do { VMWN(8); SWRITE_HK(0); SBAR(); } while (0)
    f32x16 pA0, pA1, pB0, pB1; float mnA, mnB, alA, alB; bf16x8 pa0, pa1, pa2, pa3; unsigned long long mwA, mwB;
    SWRITE_HV(0); SBAR();
    mwA = MLOAD(0);
    if (NT > 1) SLOAD_H(Kh, Vh, KBASE(1));
    SBAR(); qkt<0>(pA0, pA1, K_lds, r32, hi, S.qr);
    MASKT(pA0, pA1, mwA, 0); partialSM(pA0, pA1, m_reg, mnA, alA);
    if (NT > 1) { VMW(); SWRITE_H(1); }
    __syncthreads();
#define HALF_STEP(PX0, PX1, mnX, alX, mwX, PY0, PY1, alY, t, KB, VB, SB) do {                                                 \
        SBAR(); mwX = MLOAD(t); qkt<KB>(PX0, PX1, K_lds, r32, hi, S.qr);                                          \
        finishSM(PY0, PY1, alY, l_reg, pa0, pa1, pa2, pa3); SBAR();                                                           \
        if ((t) + 1 < NT) { SLOAD_H(Kh, Vh, KBASE((t) + 1)); SBAR(); }                                                        \
        pv_tile<VB>(o, vb0, pa0, pa1, pa2, pa3); MASKT(PX0, PX1, mwX, (t)); partialSM(PX0, PX1, m_reg, mnX, alX);             \
        __syncthreads();                                                                                                      \
        if ((t) + 1 < NT) { VMW(); SWRITE_H(SB); }                                                                            \
        RESC(alX); __syncthreads(); } while (0)
    for (int t = 1; t + 1 < NT; t += 2) {
        HALF_STEP(pB0, pB1, mnB, alB, mwB, pA0, pA1, alA, t, 1, 0, 0);
        HALF_STEP(pA0, pA1, mnA, alA, mwA, pB0, pB1, alB, t + 1, 0, 1, 1);
    }
    SBAR(); mwB = MLOAD(NT - 1); qkt<1>(pB0, pB1, K_lds, r32, hi, S.qr); SBAR();
    SLOAD_H(nxt.K, nxt.V, 0); SBAR();
    QLOAD(nxt.Q);
    SBAR();
    finishSM(pA0, pA1, alA, l_reg, pa0, pa1, pa2, pa3); SBAR();
    pv_tile<0>(o, vb0, pa0, pa1, pa2, pa3);
    MASKT(pB0, pB1, mwB, NT - 1); partialSM(pB0, pB1, m_reg, mnB, alB); __syncthreads(); RESC(alB);
    finishSM(pB0, pB1, alB, l_reg, pa0, pa1, pa2, pa3); SBAR(); pv_tile<1>(o, vb0, pa0, pa1, pa2, pa3);
    SBAR(); SEAM_K0();
    if (hi == 0) li_l[r32] = l_reg; asm volatile("s_waitcnt lgkmcnt(0)" ::: "memory");
    float rli[16];
#pragma unroll
    for (int r = 0; r < 16; ++r) rli[r] = __builtin_amdgcn_rcpf(li_l[crow(r, hi)]);
    { int l2 = lane_id(); asm volatile("" : "+v"(l2)); const int e32 = l2 & 31, ehi = (l2 >> 5) & 1;
      const char* Zw = (const char*)cur.Z + (size_t)(wid * QBLK) * (RS * 2); char* Ow = (char*)cur.O + (size_t)(wid * QBLK) * (OS * 2);
      const unsigned zo = (unsigned)(4 * ehi * RS + e32) * 2u, oo = (unsigned)(4 * ehi * OS + e32) * 2u;
#pragma unroll
      for (int r = 0; r < 16; ++r) { const int c = (r & 3) + 8 * (r >> 2);
#pragma unroll
        for (int d0 = 0; d0 < 4; ++d0) { float v = o[d0][r] * rli[r]; float vn = __builtin_bit_cast(float, __builtin_amdgcn_mov_dpp(__builtin_bit_cast(int, v), 0xB1, 0xF, 0xF, true));
            if ((e32 & 1) == 0) { const unsigned zz = *(const unsigned*)(Zw + zo + (c * RS + d0 * 32) * 2);
                v *= __uint_as_float(zz << 16); vn *= __uint_as_float(zz & 0xffff0000u);
                *(unsigned*)(Ow + oo + (c * OS + d0 * 32) * 2) = cvtpk(v, vn); } } } }
    __syncthreads();
#undef RESC
#undef KBASE
#undef MASKT
#undef SEAM_K0
#undef HALF_STEP
}
#undef ROW
#undef VMW
#undef VMWN
#undef SLOAD_H
#undef QLOAD
#undef MLOAD
#undef SWRITE_HK
#undef SWRITE_HV
#undef SWRITE_H
#undef KSWZ
#undef SBAR
}

namespace ml {
constexpr int RSK = 272, RSV = 80, RSS = 144;
typedef short v4i16 __attribute__((ext_vector_type(4)));
__device__ __forceinline__ v4i16 trd(const LAS unsigned char* p) { return __builtin_amdgcn_ds_read_tr16_b64_v4i16((LAS v4i16*)p); }
__device__ __forceinline__ bf16x8 frag_tr(const LAS unsigned char* img, int rs, int kbase, int col0, int lane) {
    const int i = lane & 15, q = i >> 2, p = i & 3, grp = lane >> 4;
    const LAS unsigned char* a = img + (kbase + 8 * grp + q) * rs + (col0 + 4 * p) * 2;
    const v4i16 lo = trd(a), hi = trd(a + 4 * rs);
    return (bf16x8){lo[0], lo[1], lo[2], lo[3], hi[0], hi[1], hi[2], hi[3]};
}
__device__ __forceinline__ float wave_incl_sum(float v, int lane) {
#pragma unroll
    for (int o = 1; o < 64; o <<= 1) { const float t = __shfl_up(v, o); if (lane >= o) v += t; }
    return v;
}
__device__ __forceinline__ float wave_incl_max(float v, int lane) {
#pragma unroll
    for (int o = 1; o < 64; o <<= 1) { const float t = __shfl_up(v, o); if (lane >= o) v = fmaxf(v, t); }
    return v;
}
__device__ __forceinline__ float wave_max(float v) {
#pragma unroll
    for (int o = 1; o < 64; o <<= 1) v = fmaxf(v, __shfl_xor(v, o));
    return v;
}
__device__ __forceinline__ void conv2(const u32x4 (&X)[5], const float (&cw)[4][8], const float (&cb)[8], float (&y0)[8], float (&y1)[8]) {
#pragma unroll
    for (int c = 0; c < 8; ++c) { float x[5];
#pragma unroll
        for (int j = 0; j < 5; ++j) { const unsigned w = X[j][c >> 1]; x[j] = __builtin_bit_cast(float, (c & 1) ? (w & 0xffff0000u) : (w << 16)); }
        float a0 = cb[c], a1 = cb[c];
#pragma unroll
        for (int j = 0; j < 4; ++j) { a0 = fmaf(cw[j][c], x[j], a0); a1 = fmaf(cw[j][c], x[j + 1], a1); }
        y0[c] = silu_f(a0); y1[c] = silu_f(a1); }
}
__device__ __forceinline__ u32x4 pack8f(const float (&y)[8]) { u32x4 w; w.x = pg8::cvt_pk_bf16(y[0], y[1]); w.y = pg8::cvt_pk_bf16(y[2], y[3]); w.z = pg8::cvt_pk_bf16(y[4], y[5]); w.w = pg8::cvt_pk_bf16(y[6], y[7]); return w; }
__device__ __forceinline__ void load5(u32x4 (&X)[5], const bf16_t* QKM, size_t rb, int t, int c) {
#pragma unroll
    for (int j = 0; j < 5; ++j) { const int tt = t - 3 + j; X[j] = tt >= 0 ? *(const u32x4*)(QKM + (rb + tt) * 1024 + c) : (u32x4){0u, 0u, 0u, 0u}; }
}

__device__ __forceinline__ void state_phase(unsigned char* ws, unsigned char* outb, LAS unsigned char* lds, int wave, int vcu) {
    const int lane = lane_id(), tid = wave * 64 + lane, fr = lane & 15, fq = lane >> 4;
    const int b = vcu >> 5, h = (vcu >> 3) & 3, vs = vcu & 7, bh = b * 4 + h;
    const size_t rb = (size_t)b * SEQ;
    const bf16_t* QKM = (const bf16_t*)(ws + WS_QKM); const bf16_t* VM = (const bf16_t*)(ws + WS_VM); const float* IFG = (const float*)(ws + WS_IFG);
    const float* par = (const float*)(ws + WS_PAR);
    bf16_t* CstT = (bf16_t*)outb; float* nst = (float*)(ws + WS_NST + 65536); float* mst = (float*)(ws + WS_NST);
    LAS float* AG = (LAS float*)lds; LAS float* BL = (LAS float*)(lds + 8192); LAS float* ML = BL + 32; LAS float* MM = BL + 64; LAS float* DEC = BL + 96;
    LAS unsigned char* Kimg = lds + 16384; LAS unsigned char* Vimg = lds + 16384 + 64 * RSK;
    const float bi = par[P_BI + h], bfg = par[P_BF + h];
#pragma unroll 1
    for (int j = 0; j < 4; ++j) { const int k = wave + 8 * j; const float* g = IFG + (rb + 64 * k + lane) * 8;
        const float lf = log_sigmoid_f(g[4 + h] + bfg), ii = g[h] + bi;
        const float bcs = wave_incl_sum(lf, lane), bL = __shfl(bcs, 63), a = bL - bcs + ii, mloc = wave_max(a);
        AG[k * 64 + lane] = a; if (lane == 0) { BL[k] = bL; ML[k] = mloc; } }
    __syncthreads();
    if (tid == 0) { float m = 0.f; if (vs == 0) mst[bh * 32] = 0.f;
        for (int k = 0; k < 32; ++k) { const float mn = fmaxf(BL[k] + m, ML[k]); DEC[k] = __expf(BL[k] + m - mn); MM[k] = mn; m = mn; if (vs == 0 && k < 31) mst[bh * 32 + k + 1] = mn; } }
    __syncthreads();
    for (int i = tid; i < 2048; i += 512) AG[i] = __expf(AG[i] - MM[i >> 6]);
    { bf16_t* c0 = CstT + ((size_t)(bh * 32) * 256 + vs * 32) * 128; *(u32x4*)(c0 + tid * 8) = (u32x4){0u, 0u, 0u, 0u};
      if (vs == 0 && tid < 128) nst[(size_t)(bh * 32) * 128 + tid] = 0.f; }
    __syncthreads();
    const int dg = tid & 15, lg = tid >> 4, ck = 512 + h * 128 + 8 * dg;
    float cw[4][8], cb[8];
#pragma unroll
    for (int c = 0; c < 8; ++c) { cb[c] = par[P_CB + ck + c];
#pragma unroll
        for (int j = 0; j < 4; ++j) cw[j][c] = par[P_CW + j * 1024 + ck + c]; }
    f32x4 acc[2] = {{0.f, 0.f, 0.f, 0.f}, {0.f, 0.f, 0.f, 0.f}}, accn = {0.f, 0.f, 0.f, 0.f};
    const bf16x8 ones = {0x3F80, 0x3F80, 0x3F80, 0x3F80, 0x3F80, 0x3F80, 0x3F80, 0x3F80};
    u32x4 X[5], Vr;
    load5(X, QKM, rb, 2 * lg, ck);
    Vr = tid < 256 ? *(const u32x4*)(VM + (rb + (tid >> 2)) * 1024 + h * 256 + vs * 32 + (tid & 3) * 8) : (u32x4){0u, 0u, 0u, 0u};
#pragma unroll 1
    for (int k = 0; k < 31; ++k) {
        const int t0 = 64 * k;
        { float y0[8], y1[8]; conv2(X, cw, cb, y0, y1);
          const float w0 = AG[k * 64 + 2 * lg] * 0.08838834764831845f, w1 = AG[k * 64 + 2 * lg + 1] * 0.08838834764831845f;
#pragma unroll
          for (int c = 0; c < 8; ++c) { y0[c] *= w0; y1[c] *= w1; }
          *(LAS u32x4*)(Kimg + (2 * lg) * RSK + dg * 16) = pack8f(y0); *(LAS u32x4*)(Kimg + (2 * lg + 1) * RSK + dg * 16) = pack8f(y1);
          if (tid < 256) *(LAS u32x4*)(Vimg + (tid >> 2) * RSV + (tid & 3) * 16) = Vr; }
        __syncthreads();
        if (k + 1 < 31) { load5(X, QKM, rb, t0 + 64 + 2 * lg, ck);
            if (tid < 256) Vr = *(const u32x4*)(VM + (rb + t0 + 64 + (tid >> 2)) * 1024 + h * 256 + vs * 32 + (tid & 3) * 8); }
        const float dec = DEC[k];
        acc[0] = acc[0] * dec; acc[1] = acc[1] * dec; accn = accn * dec;
#pragma unroll
        for (int ks = 0; ks < 2; ++ks) { const bf16x8 ak = frag_tr(Kimg, RSK, 32 * ks, 16 * wave, lane);
            const bf16x8 v0 = frag_tr(Vimg, RSV, 32 * ks, 0, lane), v1 = frag_tr(Vimg, RSV, 32 * ks, 16, lane);
            acc[0] = __builtin_amdgcn_mfma_f32_16x16x32_bf16(ak, v0, acc[0], 0, 0, 0);
            acc[1] = __builtin_amdgcn_mfma_f32_16x16x32_bf16(ak, v1, acc[1], 0, 0, 0);
            accn = __builtin_amdgcn_mfma_f32_16x16x32_bf16(ak, ones, accn, 0, 0, 0); }
        { bf16_t* cst = CstT + ((size_t)(bh * 32 + k + 1) * 256 + vs * 32) * 128;
#pragma unroll
          for (int vt = 0; vt < 2; ++vt) { u32x2 w; w.x = pg8::cvt_pk_bf16(acc[vt][0], acc[vt][1]); w.y = pg8::cvt_pk_bf16(acc[vt][2], acc[vt][3]);
              *(u32x2*)(cst + (size_t)(16 * vt + fr) * 128 + 16 * wave + 4 * fq) = w; }
          if (vs == 0 && fr == 0) *(f32x4*)(nst + (size_t)(bh * 32 + k + 1) * 128 + 16 * wave + 4 * fq) = accn; }
        __syncthreads();
    }
}

__device__ __forceinline__ void out_unit(unsigned char* ws, unsigned char* outb, LAS unsigned char* lds, int wave, int b, int h, int k) {
    const int lane = lane_id(), tid = wave * 64 + lane, fr = lane & 15, fq = lane >> 4;
    const int bh = b * 4 + h, t0 = 64 * k; const size_t rb = (size_t)b * SEQ;
    const bf16_t* QKM = (const bf16_t*)(ws + WS_QKM); const bf16_t* VM = (const bf16_t*)(ws + WS_VM); const bf16_t* GM = (const bf16_t*)(ws + WS_GM); const float* IFG = (const float*)(ws + WS_IFG);
    const float* par = (const float*)(ws + WS_PAR);
    const bf16_t* CstT = (const bf16_t*)outb + (size_t)(bh * 32 + k) * 256 * 128; const float* nst = (const float*)(ws + WS_NST + 65536) + (size_t)(bh * 32 + k) * 128; const float* mst = (const float*)(ws + WS_NST);
    bf16_t* Y = (bf16_t*)(ws + WS_Y);
    LAS unsigned char* Qimg = lds; LAS unsigned char* Qs = lds + 64 * RSK; LAS unsigned char* Kimg = lds + 2 * 64 * RSK; LAS unsigned char* Simg = lds + 3 * 64 * RSK;
    LAS unsigned char* Vw = lds + 3 * 64 * RSK + 64 * RSS + wave * (64 * RSV);
    LAS float* SC = (LAS float*)(lds + 3 * 64 * RSK + 64 * RSS + 8 * 64 * RSV);
    LAS float* PART = SC + 256;
    float inter;
    { const float* g = IFG + (rb + t0 + lane) * 8;
      const float lf = log_sigmoid_f(g[4 + h] + par[P_BF + h]), ii = g[h] + par[P_BI + h];
      const float bcs = wave_incl_sum(lf, lane), u = ii - bcs, pm = wave_incl_max(u, lane), mp = mst[bh * 32 + k];
      const float gl = bcs + mp, mt = fmaxf(bcs + pm, gl);
      inter = __expf(gl - mt);
      if (wave == 0) { SC[lane] = bcs - mt; SC[64 + lane] = u; SC[128 + lane] = __expf(-mt); } }
    { const int dg = tid & 15, lg = tid >> 4, r0 = 2 * lg;
      const float in0 = __shfl(inter, r0), in1 = __shfl(inter, r0 + 1);
#pragma unroll 1
      for (int isk = 0; isk < 2; ++isk) { const int cc = (isk ? 512 : 0) + h * 128 + 8 * dg;
          float cw[4][8], cb[8];
#pragma unroll
          for (int c = 0; c < 8; ++c) { cb[c] = par[P_CB + cc + c];
#pragma unroll
              for (int j = 0; j < 4; ++j) cw[j][c] = par[P_CW + j * 1024 + cc + c]; }
          u32x4 X[5]; load5(X, QKM, rb, t0 + r0, cc);
          float y0[8], y1[8]; conv2(X, cw, cb, y0, y1);
          if (isk) {
#pragma unroll
              for (int c = 0; c < 8; ++c) { y0[c] *= 0.08838834764831845f; y1[c] *= 0.08838834764831845f; }
              *(LAS u32x4*)(Kimg + r0 * RSK + dg * 16) = pack8f(y0); *(LAS u32x4*)(Kimg + (r0 + 1) * RSK + dg * 16) = pack8f(y1);
          } else {
              *(LAS u32x4*)(Qimg + r0 * RSK + dg * 16) = pack8f(y0); *(LAS u32x4*)(Qimg + (r0 + 1) * RSK + dg * 16) = pack8f(y1);
#pragma unroll
              for (int c = 0; c < 8; ++c) { y0[c] *= in0; y1[c] *= in1; }
              *(LAS u32x4*)(Qs + r0 * RSK + dg * 16) = pack8f(y0); *(LAS u32x4*)(Qs + (r0 + 1) * RSK + dg * 16) = pack8f(y1);
          } }
#pragma unroll
      for (int i = 0; i < 4; ++i) { const int l = 16 * i + (lane >> 2), pc = lane & 3;
          *(LAS u32x4*)(Vw + l * RSV + pc * 16) = *(const u32x4*)(VM + (rb + t0 + l) * 1024 + h * 256 + 32 * wave + pc * 8); } }
    __syncthreads();
    { const int lt = wave >> 1; const float rt = SC[16 * lt + fr];
#pragma unroll
      for (int si = 0; si < 2; ++si) { const int st = 2 * (wave & 1) + si; u32x2 w = {0u, 0u};
          if (st <= lt) { f32x4 sacc = {0.f, 0.f, 0.f, 0.f};
#pragma unroll
              for (int ks = 0; ks < 4; ++ks) { const bf16x8 kf = *(const LAS bf16x8*)(Kimg + (16 * st + fr) * RSK + (32 * ks + 8 * fq) * 2), qf = *(const LAS bf16x8*)(Qimg + (16 * lt + fr) * RSK + (32 * ks + 8 * fq) * 2);
                  sacc = __builtin_amdgcn_mfma_f32_16x16x32_bf16(kf, qf, sacc, 0, 0, 0); }
              const int l = 16 * lt + fr; float e[4];
#pragma unroll
              for (int j = 0; j < 4; ++j) { const int sidx = 16 * st + 4 * fq + j; e[j] = sidx <= l ? sacc[j] * __expf(rt + SC[64 + sidx]) : 0.f; }
              w.x = pg8::cvt_pk_bf16(e[0], e[1]); w.y = pg8::cvt_pk_bf16(e[2], e[3]); }
          *(LAS u32x2*)(Simg + (16 * lt + fr) * RSS + (16 * st + 4 * fq) * 2) = w; } }
    __syncthreads();
    const bf16x8 ones = {0x3F80, 0x3F80, 0x3F80, 0x3F80, 0x3F80, 0x3F80, 0x3F80, 0x3F80};
    if (wave < 4) { f32x4 dacc = {0.f, 0.f, 0.f, 0.f};
#pragma unroll
        for (int ks = 0; ks < 2; ++ks) { const bf16x8 sf = *(const LAS bf16x8*)(Simg + (16 * wave + fr) * RSS + (32 * ks + 8 * fq) * 2); dacc = __builtin_amdgcn_mfma_f32_16x16x32_bf16(ones, sf, dacc, 0, 0, 0); }
#pragma unroll
        for (int ks = 0; ks < 4; ++ks) { const f32x4 n0 = *(const f32x4*)(nst + 32 * ks + 8 * fq), n1 = *(const f32x4*)(nst + 32 * ks + 8 * fq + 4);
            u32x4 nw; nw.x = pg8::cvt_pk_bf16(n0[0], n0[1]); nw.y = pg8::cvt_pk_bf16(n0[2], n0[3]); nw.z = pg8::cvt_pk_bf16(n1[0], n1[1]); nw.w = pg8::cvt_pk_bf16(n1[2], n1[3]);
            const bf16x8 qf = *(const LAS bf16x8*)(Qs + (16 * wave + fr) * RSK + (32 * ks + 8 * fq) * 2);
            dacc = __builtin_amdgcn_mfma_f32_16x16x32_bf16(__builtin_bit_cast(bf16x8, nw), qf, dacc, 0, 0, 0); }
        if (fq == 0) SC[192 + 16 * wave + fr] = dacc[0]; }
    f32x4 acc[4][2];
#pragma unroll
    for (int lt = 0; lt < 4; ++lt) { acc[lt][0] = (f32x4){0.f, 0.f, 0.f, 0.f}; acc[lt][1] = (f32x4){0.f, 0.f, 0.f, 0.f}; }
#pragma unroll
    for (int ks = 0; ks < 2; ++ks) { const bf16x8 v0 = frag_tr(Vw, RSV, 32 * ks, 0, lane), v1 = frag_tr(Vw, RSV, 32 * ks, 16, lane);
#pragma unroll
        for (int lt = 0; lt < 4; ++lt) { const bf16x8 sf = *(const LAS bf16x8*)(Simg + (16 * lt + fr) * RSS + (32 * ks + 8 * fq) * 2);
            acc[lt][0] = __builtin_amdgcn_mfma_f32_16x16x32_bf16(v0, sf, acc[lt][0], 0, 0, 0); acc[lt][1] = __builtin_amdgcn_mfma_f32_16x16x32_bf16(v1, sf, acc[lt][1], 0, 0, 0); } }
#pragma unroll
    for (int ks = 0; ks < 4; ++ks) { const bf16x8 c0 = *(const bf16x8*)(CstT + (size_t)(32 * wave + fr) * 128 + 32 * ks + 8 * fq), c1 = *(const bf16x8*)(CstT + (size_t)(32 * wave + 16 + fr) * 128 + 32 * ks + 8 * fq);
#pragma unroll
        for (int lt = 0; lt < 4; ++lt) { const bf16x8 qf = *(const LAS bf16x8*)(Qs + (16 * lt + fr) * RSK + (32 * ks + 8 * fq) * 2);
            acc[lt][0] = __builtin_amdgcn_mfma_f32_16x16x32_bf16(c0, qf, acc[lt][0], 0, 0, 0); acc[lt][1] = __builtin_amdgcn_mfma_f32_16x16x32_bf16(c1, qf, acc[lt][1], 0, 0, 0); } }
    __syncthreads();
#pragma unroll
    for (int lt = 0; lt < 4; ++lt) { const int l = 16 * lt + fr; const float sc = 1.f / fmaxf(fabsf(SC[192 + l]), SC[128 + l]);
        acc[lt][0] = acc[lt][0] * sc; acc[lt][1] = acc[lt][1] * sc;
        float s1 = 0.f, s2 = 0.f;
#pragma unroll
        for (int vt = 0; vt < 2; ++vt)
#pragma unroll
            for (int j = 0; j < 4; ++j) { const float x = acc[lt][vt][j]; s1 += x; s2 = fmaf(x, x, s2); }
        s1 += __shfl_xor(s1, 16); s1 += __shfl_xor(s1, 32); s2 += __shfl_xor(s2, 16); s2 += __shfl_xor(s2, 32);
        if (fq == 0) { PART[(l * 8 + wave) * 2] = s1; PART[(l * 8 + wave) * 2 + 1] = s2; } }
    __syncthreads();
#pragma unroll
    for (int lt = 0; lt < 4; ++lt) { const int l = 16 * lt + fr; float s1 = 0.f, s2 = 0.f;
#pragma unroll
        for (int w = 0; w < 8; ++w) { s1 += PART[(l * 8 + w) * 2]; s2 += PART[(l * 8 + w) * 2 + 1]; }
        const float mu = s1 * (1.f / DVM), var = fmaxf(s2 * (1.f / DVM) - mu * mu, 0.f), rstd = rsqrtf(var + LN_EPS);
#pragma unroll
        for (int vt = 0; vt < 2; ++vt) { const int c = h * 256 + 32 * wave + 16 * vt + 4 * fq; const size_t row = rb + t0 + l;
            const f32x4 gg = *(const f32x4*)(par + P_MHG + c); const u32x2 gm = *(const u32x2*)(GM + row * 1024 + c);
            const float g0 = __builtin_bit_cast(float, gm.x << 16), g1 = __builtin_bit_cast(float, gm.x & 0xffff0000u), g2 = __builtin_bit_cast(float, gm.y << 16), g3 = __builtin_bit_cast(float, gm.y & 0xffff0000u);
            const f32x4 x = acc[lt][vt];
            u32x2 w; w.x = pg8::cvt_pk_bf16((x[0] - mu) * rstd * gg[0] * g0, (x[1] - mu) * rstd * gg[1] * g1); w.y = pg8::cvt_pk_bf16((x[2] - mu) * rstd * gg[2] * g2, (x[3] - mu) * rstd * gg[3] * g3);
            *(u32x2*)(Y + row * 2048 + 1024 + c) = w; } }
    __syncthreads();
}
}

constexpr int NWAVES = 8, NTHREADS = 512;
#ifndef PROBE_ID
#define PROBE_ID -1
#endif
#define REP(id) ((PROBE_ID) == (id) ? 2 : 1)
constexpr int LDS_BYTES = 147456;
constexpr int MISC_OFF = 131072 + 8192;
constexpr int CW_BAR = 4096;
struct Args {
    const float* in[16]; float* out; unsigned char* ws; int ph_lo, ph_hi, li, pad;
};

template <class SrcMap>
__device__ __forceinline__ void p0_transpose_item(const float* W, int K, int Nsrc, int nblk, bf16_t* WT, int row_off, LAS float* scr, int item, int lane, SrcMap smap) {
    const int kb = item / nblk, nb = item % nblk, k0 = 64 * kb, n0 = 32 * nb;
    const int src = smap(n0 + (lane & 31));
#pragma unroll 8
    for (int i = 0; i < 32; ++i) { const int kk = 2 * i + (lane >> 5); scr[kk * 33 + (lane & 31)] = src >= 0 ? W[(size_t)(k0 + kk) * Nsrc + src] : 0.f; }
    asm volatile("s_waitcnt lgkmcnt(0)" ::: "memory");
    const int c = lane & 7;
#pragma unroll
    for (int j = 0; j < 4; ++j) { const int n = (lane >> 3) + 8 * j; const LAS float* s = scr + (8 * c) * 33 + n;
        u32x4 o; o.x = pk2(s[0 * 33], s[1 * 33]); o.y = pk2(s[2 * 33], s[3 * 33]); o.z = pk2(s[4 * 33], s[5 * 33]); o.w = pk2(s[6 * 33], s[7 * 33]);
        *(u32x4*)(WT + (size_t)(row_off + n0 + n) * K + k0 + 8 * c) = o; }
    asm volatile("s_waitcnt lgkmcnt(0)" ::: "memory");
}
struct MapIdent { __device__ __forceinline__ int operator()(int n) const { return n; } };
struct MapWin { __device__ __forceinline__ int operator()(int n) const { return win_src(n); } };

__global__ void __launch_bounds__(NTHREADS, 2) skel_fwd(Args args) {
    extern __shared__ __attribute__((aligned(16))) unsigned char lds_raw[];
    LAS unsigned char* lds = (LAS unsigned char*)lds_raw;
#define FRESH_TID() ({ int t_ = wave * 64 + lane_id(); asm volatile("" : "+v"(t_)); t_; })
    const int wave = __builtin_amdgcn_readfirstlane(threadIdx.x >> 6);
    const int G = gridDim.x, bx = blockIdx.x;
    const int vcu = (G % 8 == 0) ? (bx % 8) * (G / 8) + bx / 8 : bx;
    unsigned char* ws = args.ws;
    const int lo = args.ph_lo, hi = args.ph_hi;
#define IN(k) (lo <= (k) && (k) < hi)
#define BOTH(k) (IN(k) && IN((k) + 1))
    volatile LAS unsigned* MISC = (volatile LAS unsigned*)(lds + MISC_OFF);
    if (threadIdx.x < 32) MISC[threadIdx.x] = 0u;
    __syncthreads();
    XcdBarrier bar = xcd_barrier_post((unsigned*)(ws + WS_CTL) + CW_BAR + args.li * XCD_BAR_WORDS, MISC + 8);
#define GRID_BAR() xcd_barrier(bar, wave)
#define XB ((bf16_t*)(ws + WS_XB))
#define WINT ((bf16_t*)(ws + WS_WINT))
#define WOUTT ((bf16_t*)(ws + WS_WOUTT))
#define WKVT ((bf16_t*)(ws + WS_WKVT))
#define PARF ((float*)(ws + WS_PAR))

    if (IN(0)) {
      _Pragma("unroll 1") for (int rep = 0; rep < REP(0); ++rep) {
        const int tid = FRESH_TID(), lane = tid & 63;
        const int gw = vcu * NWAVES + wave, NGW = G * NWAVES;
        LAS float* scr = (LAS float*)(lds + wave * 16384);
        const float* x = args.in[0];
        for (int it = gw; it < M * DM / 512; it += NGW) {
            const f32x4 a = *(const f32x4*)(x + (size_t)it * 512 + lane * 8), b = *(const f32x4*)(x + (size_t)it * 512 + lane * 8 + 4);
            u32x4 o; o.x = pk2(a[0], a[1]); o.y = pk2(a[2], a[3]); o.z = pk2(b[0], b[1]); o.w = pk2(b[2], b[3]);
            *(u32x4*)(XB + (size_t)it * 512 + lane * 8) = o;
        }
        constexpr int I_IN = (DM / 64) * (NP / 32), I_OUT = (DM / 64) * (DM / 32), I_UV = (DC / 64) * (DHA / 32);
        for (int it = gw; it < I_IN + I_OUT + HA * I_UV; it += NGW) {
            int r = it;
            if (r < I_IN) { p0_transpose_item(args.in[1], DM, NCOLS, NP / 32, WINT, 0, scr, r, lane, MapWin()); continue; } r -= I_IN;
            if (r < I_OUT) { p0_transpose_item(args.in[13], DM, DM, DM / 32, WOUTT, 0, scr, r, lane, MapIdent()); continue; } r -= I_OUT;
            { const int h = r / I_UV; p0_transpose_item(args.in[6] + (size_t)h * DC * DHA, DC, DHA, DHA / 32, WKVT, 1024 + h * DHA, scr, r % I_UV, lane, MapIdent()); }
        }
        {
            const int gt = vcu * NTHREADS + tid, NGT = G * NTHREADS;
            for (int i = gt; i < P_TOTAL; i += NGT) { float v = 0.f;
                if (i < P_LNG) v = args.in[4][i - P_KVG]; else if (i < P_LNB) v = args.in[7][i - P_LNG]; else if (i < P_RB) v = args.in[8][i - P_LNB];
                else if (i < P_CW) v = args.in[9][i - P_RB]; else if (i < P_CB) v = args.in[10][i - P_CW]; else if (i < P_MHG) v = args.in[11][i - P_CB];
                else if (i < P_BI) v = args.in[12][i - P_MHG]; else if (i < P_BI + 4) v = args.in[2][i - P_BI]; else if (i < P_BF + 4) v = args.in[3][i - P_BF];
                else if (i >= P_LG && i < P_LB) v = args.in[14][i - P_LG]; else if (i >= P_LB) v = args.in[15][i - P_LB];
                PARF[i] = v; }
        }
        const float* wuk = args.in[5];
        for (int it = gw; it < 1024 * 256 / 512; it += NGW) {
            const f32x4 a = *(const f32x4*)(wuk + (size_t)it * 512 + lane * 8), b = *(const f32x4*)(wuk + (size_t)it * 512 + lane * 8 + 4);
            u32x4 o; o.x = pk2(a[0], a[1]); o.y = pk2(a[2], a[3]); o.z = pk2(b[0], b[1]); o.w = pk2(b[2], b[3]);
            *(u32x4*)(WKVT + (size_t)it * 512 + lane * 8) = o;
        }
        __syncthreads();
      }
        if (BOTH(0)) GRID_BAR();
    }
    if (IN(1)) {
        pg8::Gemm g{XB, WINT, M, NP, DM}; pg8::StaticOrder S; S.init(M, NP, G, bx);
        Epi1 E{ws};
        _Pragma("unroll 1") for (int rep = 0; rep < REP(1); ++rep) pg8::gemm_phase<Epi1, pg8::StaticOrder>(lds, g, S, E, wave);
        if (BOTH(1)) GRID_BAR();
    }
    if (IN(2)) {
        {
            const int lane = FRESH_TID() & 63, b = vcu >> 5, j = vcu & 31;
#pragma unroll 1
            for (int u = 0; u < 4 * REP(2); ++u) { const int gi = (u & 1) ? ((u & 2) ? j : 64 + j) : ((u & 2) ? 63 - j : 127 - j);
                topk_unit((const bf16_t*)(ws + WS_QI), (const bf16_t*)(ws + WS_KI), (const float*)(ws + WS_WI), (unsigned long long*)(ws + WS_MASK), b, gi, wave, lane, (LAS unsigned long long*)(lds + 131072 + 4096 + wave * 256), lds); }
        }
        pg8::Gemm g{(bf16_t*)(ws + WS_C), WKVT, M, 2048, DC}; pg8::StaticOrder S; S.init(M, 2048, G, bx);
        EpiKV E{(bf16_t*)((unsigned char*)args.out + OUT_K), (bf16_t*)((unsigned char*)args.out + OUT_V)};
        _Pragma("unroll 1") for (int rep = 0; rep < REP(3); ++rep) pg8::gemm_phase<EpiKV, pg8::StaticOrder>(lds, g, S, E, wave);
        _Pragma("unroll 1") for (int rep = 0; rep < REP(4); ++rep) ml::state_phase(ws, (unsigned char*)args.out, lds, wave, vcu);
        if (BOTH(2)) GRID_BAR();
    }
    if (IN(3)) {
        const int b = vcu >> 5, h = (vcu >> 2) & 7, x = vcu & 3;
        const bf16_t* Qh = (const bf16_t*)(ws + WS_Q) + (size_t)b * SEQ * 1024 + h * DHA;
        const bf16_t* Kh = (const bf16_t*)((unsigned char*)args.out + OUT_K) + (size_t)b * SEQ * 1024 + h * DHA;
        const bf16_t* Vh = (const bf16_t*)((unsigned char*)args.out + OUT_V) + (size_t)b * SEQ * 1024 + h * DHA;
        bf16_t* Yh = (bf16_t*)(ws + WS_Y) + (size_t)b * SEQ * 2048 + h * DHA;
        const bf16_t* Zh = (const bf16_t*)(ws + WS_SZA) + (size_t)b * SEQ * 1024 + h * DHA;
        const unsigned long long* MKb = (const unsigned long long*)(ws + WS_MASK) + (size_t)b * 32 * SEQ;
        const int q0 = x * 256, q1 = (7 - x) * 256;
        att::BlockRef r0{Qh + (size_t)q0 * 1024, Kh, Vh, Yh + (size_t)q0 * 2048, Zh + (size_t)q0 * 1024, MKb + q0, q0};
        att::BlockRef r1{Qh + (size_t)q1 * 1024, Kh, Vh, Yh + (size_t)q1 * 2048, Zh + (size_t)q1 * 1024, MKb + q1, q1};
        att::Seam S;
      _Pragma("unroll 1") for (int rep = 0; rep < REP(5); ++rep) {
        att::prime(r0, (char*)lds_raw, S, PARF + P_RB, h, wave);
#pragma unroll 1
        for (int pass = 0; pass < 2; ++pass) { const att::BlockRef cur = pass ? r1 : r0; att::block(cur, r1, (char*)lds_raw, S, wave); }
      }
#pragma unroll 1
        for (int i = 0; i < 4 * REP(6); ++i) { const int u = vcu * 4 + (i & 3); ml::out_unit(ws, (unsigned char*)args.out, lds, wave, u >> 7, (u >> 5) & 3, u & 31); }
        if (BOTH(3)) GRID_BAR();
    }
    if (IN(4)) {
        pg8::Gemm g{(bf16_t*)(ws + WS_Y), WOUTT, M, DM, DM}; pg8::StaticOrder S; S.init(M, DM, G, bx);
        EpiOut E{args.in[0], args.out};
        _Pragma("unroll 1") for (int rep = 0; rep < REP(7); ++rep) pg8::gemm_phase<EpiOut, pg8::StaticOrder>(lds, g, S, E, wave);
        if (BOTH(4)) GRID_BAR();
    }
    if (IN(5)) {
        const int lane = FRESH_TID() & 63;
        const int gw = vcu * NWAVES + wave, NGW = G * NWAVES;
        const float* lg = PARF + P_LG; const float* lb = PARF + P_LB;
        for (int r = gw; r < M; r += NGW) {
            f32x4* p = (f32x4*)(args.out + (size_t)r * DM) + lane;
            f32x4 v[8]; float s = 0.f;
#pragma unroll
            for (int j = 0; j < 8; ++j) { v[j] = p[64 * j]; s += (v[j][0] + v[j][1]) + (v[j][2] + v[j][3]); }
#pragma unroll
            for (int o = 1; o < 64; o <<= 1) s += __shfl_xor(s, o);
            const float mu = s * (1.f / DM); float q = 0.f;
#pragma unroll
            for (int j = 0; j < 8; ++j) { v[j] = v[j] - mu; q += (v[j][0] * v[j][0] + v[j][1] * v[j][1]) + (v[j][2] * v[j][2] + v[j][3] * v[j][3]); }
#pragma unroll
            for (int o = 1; o < 64; o <<= 1) q += __shfl_xor(q, o);
            const float rstd = rsqrtf(q * (1.f / DM) + LN_EPS);
#pragma unroll
            for (int j = 0; j < 8; ++j) { const f32x4 gg = *((const f32x4*)lg + lane + 64 * j), bb = *((const f32x4*)lb + lane + 64 * j); p[64 * j] = v[j] * rstd * gg + bb; }
        }
    }
#undef IN
#undef BOTH
}


__global__ void __launch_bounds__(256) naive_topk(const bf16_t* __restrict__ QI, const bf16_t* __restrict__ KI, const float* __restrict__ WI, unsigned long long* __restrict__ mask) {
    __shared__ float qi[HIDX * DIDX]; __shared__ float w[HIDX]; __shared__ unsigned keys[SEQ]; __shared__ unsigned cnt; __shared__ unsigned Tsh;
    const int row = blockIdx.x, b = row / SEQ, t = row % SEQ, tid = threadIdx.x;
    for (int i = tid; i < HIDX * DIDX; i += 256) qi[i] = bf2f(QI[(size_t)row * 1024 + i]);
    if (tid < HIDX) w[tid] = WI[(size_t)row * 16 + tid];
    __syncthreads();
    for (int s = tid; s < SEQ; s += 256) {
        unsigned key = 0u;
        if (s <= t) {
            const bf16_t* kr = KI + ((size_t)b * SEQ + s) * DIDX; float kf[DIDX];
#pragma unroll
            for (int d = 0; d < DIDX; ++d) kf[d] = bf2f(kr[d]);
            float sc = 0.f;
            for (int h = 0; h < HIDX; ++h) { float a = 0.f;
#pragma unroll
                for (int d = 0; d < DIDX; ++d) a = fmaf(qi[h * DIDX + d], kf[d], a);
                sc = fmaf(fmaxf(a, 0.f), w[h], sc); }
            key = mono_key(sc);
        }
        keys[s] = key;
    }
    __syncthreads();
    if (t >= NSEL) {
        unsigned T = 0u;
        for (int bit = 31; bit >= 0; --bit) {
            const unsigned cand = T | (1u << bit);
            if (tid == 0) cnt = 0u;
            __syncthreads();
            unsigned c = 0u;
            for (int s = tid; s < SEQ; s += 256) c += keys[s] >= cand ? 1u : 0u;
            atomicAdd(&cnt, c);
            __syncthreads();
            if (cnt >= (unsigned)NSEL) T = cand;
            __syncthreads();
        }
        if (tid == 0) {
            unsigned gt = 0u; for (int s = 0; s < SEQ; ++s) gt += keys[s] > T ? 1u : 0u;
            unsigned need = NSEL - gt;
            for (int s = 0; s < SEQ; ++s) if (keys[s] == T) { if (need > 0u) --need; else keys[s] = 0u; }
            Tsh = T;
        }
        __syncthreads();
    } else { if (tid == 0) Tsh = 1u; __syncthreads(); }
    if (tid < 32) {
        const unsigned T = Tsh; unsigned long long wv = 0ull;
        for (int l = 0; l < 64; ++l) if (keys[tid * 64 + l] >= T) wv |= 1ull << l;
        mask[((size_t)b * 32 + tid) * SEQ + t] = wv;
    }
}

__global__ void __launch_bounds__(256) naive_attn(const bf16_t* __restrict__ Qb, const bf16_t* __restrict__ Kb, const bf16_t* __restrict__ Vb, const bf16_t* __restrict__ SZA,
                                                  const unsigned long long* __restrict__ mask, const float* __restrict__ rel_bias, bf16_t* __restrict__ Y) {
    __shared__ int sel[NSEL]; __shared__ int nsel_s; __shared__ float q[1024]; __shared__ float p[NSEL]; __shared__ float red[8]; __shared__ int pre[33];
    const int row = blockIdx.x, b = row / SEQ, t = row % SEQ, tid = threadIdx.x;
    for (int i = tid; i < 1024; i += 256) q[i] = bf2f(Qb[(size_t)row * 1024 + i]);
    if (tid == 0) { int a = 0; for (int g = 0; g < 32; ++g) { pre[g] = a; a += __popcll(mask[((size_t)b * 32 + g) * SEQ + t]); } pre[32] = a; nsel_s = a; }
    __syncthreads();
    if (tid < 32) { unsigned long long wv = mask[((size_t)b * 32 + tid) * SEQ + t]; int o = pre[tid]; while (wv) { const int l = __ffsll((long long)wv) - 1; wv &= wv - 1; if (o < NSEL) sel[o] = tid * 64 + l; ++o; } }
    __syncthreads();
    const int nsel = nsel_s < NSEL ? nsel_s : NSEL;
    for (int h = 0; h < HA; ++h) {
        float lg = -1e30f;
        if (tid < nsel) { const int s = sel[tid]; const bf16_t* kr = Kb + ((size_t)b * SEQ + s) * 1024 + h * DHA; float a = 0.f;
            for (int d = 0; d < DHA; ++d) a = fmaf(q[h * DHA + d], bf2f(kr[d]), a);
            lg = (t - s >= 0) ? a + rel_bias[t5_bucket(t - s) * HA + h] * LOG2E : -1e30f; }
        float mx = lg;
        for (int o = 1; o < 64; o <<= 1) mx = fmaxf(mx, __shfl_xor(mx, o));
        if ((tid & 63) == 0) red[tid >> 6] = mx;
        __syncthreads();
        mx = fmaxf(fmaxf(red[0], red[1]), fmaxf(red[2], red[3]));
        const float pe = tid < nsel ? exp2f(lg - mx) : 0.f;
        p[tid] = pe;
        float sm = pe;
        for (int o = 1; o < 64; o <<= 1) sm += __shfl_xor(sm, o);
        if ((tid & 63) == 0) red[4 + (tid >> 6)] = sm;
        __syncthreads();
        const float l = (red[4] + red[5]) + (red[6] + red[7]);
        if (tid < DHA) { float o = 0.f;
            for (int j = 0; j < nsel; ++j) o = fmaf(p[j], bf2f(Vb[((size_t)b * SEQ + sel[j]) * 1024 + h * DHA + tid]), o);
            const float y = o / l * bf2f(SZA[(size_t)row * 1024 + h * DHA + tid]);
            Y[(size_t)row * 2048 + h * DHA + tid] = (bf16_t)f2bf(y); }
        __syncthreads();
    }
}

__global__ void __launch_bounds__(512) naive_mlstm(const bf16_t* __restrict__ QKM, const bf16_t* __restrict__ VM, const bf16_t* __restrict__ GM, const float* __restrict__ IFG,
                                                   const float* __restrict__ conv_w, const float* __restrict__ conv_b, const float* __restrict__ b_i, const float* __restrict__ b_f,
                                                   const float* __restrict__ mhg, float* __restrict__ Cst, float* __restrict__ hbuf, bf16_t* __restrict__ Y) {
    extern __shared__ float dsm[]; float* qs = dsm; float* ks = dsm + CHUNK * DKM; float* Ss = dsm + 2 * CHUNK * DKM;
    __shared__ float bcs[CHUNK], ii[CHUNK], mt[CHUNK], inter[CHUNK], den[CHUNK], wgt[CHUNK], nvec[DKM], qn[CHUNK]; __shared__ float m_s, decay_s;
    const int bh = blockIdx.x, b = bh / HM, h = bh % HM, tid = threadIdx.x;
    float* C = Cst + (size_t)bh * DVM * DKM; float* hb = hbuf + (size_t)bh * CHUNK * DVM;
    for (int i = tid; i < DVM * DKM; i += 512) C[i] = 0.f;
    if (tid < DKM) nvec[tid] = 0.f;
    if (tid == 0) m_s = 0.f;
    __syncthreads();
    for (int kc = 0; kc < NCHUNK; ++kc) {
        const int t0 = kc * CHUNK; const size_t rb = (size_t)b * SEQ;
        _Pragma("unroll 1") for (int i = tid; i < CHUNK * DKM * 2; i += 512) {
            const int isk = i >= CHUNK * DKM, e = isk ? i - CHUNK * DKM : i, l = e / DKM, d = e % DKM, c = (isk ? 512 : 0) + h * DKM + d, t = t0 + l;
            float a = conv_b[c];
            for (int j = 0; j < 4; ++j) { const int tt = t - 3 + j; if (tt >= 0) a = fmaf(conv_w[j * 1024 + c], bf2f(QKM[(rb + tt) * 1024 + c]), a); }
            a = silu_f(a);
            if (isk) ks[e] = a * 0.08838834764831845f; else qs[e] = a;
        }
        if (tid == 0) { float cs = 0.f;
            _Pragma("unroll 1") for (int l = 0; l < CHUNK; ++l) { const float* g = IFG + (rb + t0 + l) * 8; cs += log_sigmoid_f(g[4 + h] + b_f[h]); bcs[l] = cs; ii[l] = g[h] + b_i[h]; }
            float rm = -1e30f; const float mp = m_s;
            _Pragma("unroll 1") for (int l = 0; l < CHUNK; ++l) { rm = fmaxf(rm, ii[l] - bcs[l]); const float gl = bcs[l] + mp; const float m = fmaxf(bcs[l] + rm, gl); mt[l] = m; inter[l] = expf(gl - m); } }
        __syncthreads();
        _Pragma("unroll 1") for (int i = tid; i < CHUNK * CHUNK; i += 512) { const int l = i / CHUNK, s = i % CHUNK; float v = 0.f;
            if (s <= l) { float a = 0.f; _Pragma("unroll 4") for (int d = 0; d < DKM; ++d) a = fmaf(qs[l * DKM + d], ks[s * DKM + d], a); v = a * expf(bcs[l] - bcs[s] + ii[s] - mt[l]); }
            Ss[i] = v; }
        if (tid < CHUNK) { float a = 0.f; _Pragma("unroll 4") for (int d = 0; d < DKM; ++d) a = fmaf(qs[tid * DKM + d], nvec[d], a); qn[tid] = a; }
        __syncthreads();
        if (tid < CHUNK) { float a = 0.f; _Pragma("unroll 4") for (int s = 0; s < CHUNK; ++s) a += Ss[tid * CHUNK + s]; den[tid] = a + inter[tid] * qn[tid]; }
        __syncthreads();
        { const int v = tid % DVM, lh = tid / DVM;
            _Pragma("unroll 1") for (int lq = 0; lq < 2; ++lq) { float acc[16]; const int l0 = lh * 32 + lq * 16;
#pragma unroll
                for (int l = 0; l < 16; ++l) acc[l] = 0.f;
_Pragma("unroll 2")
                for (int d = 0; d < DKM; ++d) { const float c = C[v * DKM + d];
#pragma unroll
                    for (int l = 0; l < 16; ++l) acc[l] = fmaf(qs[(l0 + l) * DKM + d], c, acc[l]); }
#pragma unroll
                for (int l = 0; l < 16; ++l) acc[l] *= inter[l0 + l];
_Pragma("unroll 2")
                for (int s = 0; s < CHUNK; ++s) { const float vv = bf2f(VM[(rb + t0 + s) * 1024 + h * DVM + v]);
#pragma unroll
                    for (int l = 0; l < 16; ++l) acc[l] = fmaf(Ss[(l0 + l) * CHUNK + s], vv, acc[l]); }
#pragma unroll
                for (int l = 0; l < 16; ++l) { const int L = l0 + l; hb[L * DVM + v] = acc[l] / fmaxf(fabsf(den[L]), expf(-mt[L])); } } }
        __syncthreads();
        { const int wv = tid >> 6, ln = tid & 63;
            _Pragma("unroll 1") for (int l = wv; l < CHUNK; l += 8) { float x[4]; float s = 0.f;
                for (int j = 0; j < 4; ++j) { x[j] = hb[l * DVM + ln + 64 * j]; s += x[j]; }
                for (int o = 1; o < 64; o <<= 1) s += __shfl_xor(s, o);
                const float mu = s * (1.f / DVM); float q = 0.f;
                for (int j = 0; j < 4; ++j) { x[j] -= mu; q += x[j] * x[j]; }
                for (int o = 1; o < 64; o <<= 1) q += __shfl_xor(q, o);
                const float rstd = rsqrtf(q * (1.f / DVM) + LN_EPS);
                for (int j = 0; j < 4; ++j) { const int c = h * DVM + ln + 64 * j; const float y = x[j] * rstd * mhg[c] * bf2f(GM[(rb + t0 + l) * 1024 + c]);
                    Y[(rb + t0 + l) * 2048 + 1024 + c] = (bf16_t)f2bf(y); } } }
        if (tid == 0) { const float bL = bcs[CHUNK - 1], mp = m_s; float ma = -1e30f;
            _Pragma("unroll 1") for (int l = 0; l < CHUNK; ++l) ma = fmaxf(ma, bL - bcs[l] + ii[l]);
            const float mn = fmaxf(bL + mp, ma); decay_s = expf(bL + mp - mn);
            _Pragma("unroll 1") for (int l = 0; l < CHUNK; ++l) wgt[l] = expf(bL - bcs[l] + ii[l] - mn);
            m_s = mn; }
        __syncthreads();
        { const int v = tid % DVM, dh = tid / DVM; const float dc = decay_s;
            _Pragma("unroll 1") for (int dq = 0; dq < 4; ++dq) { float acc[16]; const int d0 = dh * 64 + dq * 16;
#pragma unroll
                for (int d = 0; d < 16; ++d) acc[d] = C[v * DKM + d0 + d] * dc;
_Pragma("unroll 2")
                for (int l = 0; l < CHUNK; ++l) { const float wvv = wgt[l] * bf2f(VM[(rb + t0 + l) * 1024 + h * DVM + v]);
#pragma unroll
                    for (int d = 0; d < 16; ++d) acc[d] = fmaf(wvv, ks[l * DKM + d0 + d], acc[d]); }
#pragma unroll
                for (int d = 0; d < 16; ++d) C[v * DKM + d0 + d] = acc[d]; } }
        if (tid < DKM) { float a = nvec[tid] * decay_s; _Pragma("unroll 4") for (int l = 0; l < CHUNK; ++l) a = fmaf(wgt[l], ks[l * DKM + tid], a); nvec[tid] = a; }
        __syncthreads();
    }
}

constexpr int NAIVE_MLSTM_LDS = (2 * CHUNK * DKM + CHUNK * CHUNK) * 4;
extern "C" void kernel_launch(void* const* d_in, const int* in_sizes, int n_in, void* d_out, int out_size, void* d_ws, size_t ws_size, hipStream_t stream) {
    static int grid = 0;
    if (grid == 0) {
        if (n_in != 16 || in_sizes[0] != M * DM || out_size != M * DM || ws_size < WS_END) { fprintf(stderr, "kernel_launch: unexpected shapes (n_in %d, in0 %d, out %d, ws %zu)\n", n_in, n_in > 0 ? in_sizes[0] : -1, out_size, ws_size); grid = -1; return; }
        int dev = 0, cus = 0, per_cu = 0;
        if (hipGetDevice(&dev) != hipSuccess || hipDeviceGetAttribute(&cus, hipDeviceAttributeMultiprocessorCount, dev) != hipSuccess) { grid = -1; return; }
        if (hipFuncSetAttribute((const void*)skel_fwd, hipFuncAttributeMaxDynamicSharedMemorySize, LDS_BYTES) != hipSuccess) { fprintf(stderr, "kernel_launch: hipFuncSetAttribute failed\n"); grid = -1; return; }
        if (hipOccupancyMaxActiveBlocksPerMultiprocessor(&per_cu, (const void*)skel_fwd, NTHREADS, LDS_BYTES) != hipSuccess || per_cu < 1) fprintf(stderr, "kernel_launch: occupancy query says %d\n", per_cu);
        (void)hipFuncSetAttribute((const void*)naive_mlstm, hipFuncAttributeMaxDynamicSharedMemorySize, NAIVE_MLSTM_LDS);
        (void)hipGetLastError();
        grid = cus;
    }
    if (grid < 0) return;
    Args a{};
    for (int i = 0; i < 16; ++i) a.in[i] = (const float*)d_in[i];
    a.out = (float*)d_out; a.ws = (unsigned char*)d_ws;
    unsigned char* ws = (unsigned char*)d_ws;
    if (hipMemsetAsync((char*)d_ws + WS_CTL, 0, CTL_ZERO_BYTES, stream) != hipSuccess) { fprintf(stderr, "kernel_launch: memset failed\n"); return; }
    int li = 0;
    auto launch = [&](int lo, int hi) { a.ph_lo = lo; a.ph_hi = hi; a.li = li++; hipLaunchKernelGGL(skel_fwd, dim3(grid), dim3(NTHREADS), LDS_BYTES, stream, a); };
    launch(0, 6);
}
```

```cpp
#include <hip/hip_runtime.h>
#include <cstdio>
#include <cstdint>

#define LAS __attribute__((address_space(3)))
#define GAS __attribute__((address_space(1)))
typedef unsigned short bf16_t;
typedef short bf16x8 __attribute__((ext_vector_type(8)));
typedef float f32x4 __attribute__((ext_vector_type(4)));
typedef float f32x2 __attribute__((ext_vector_type(2)));
typedef unsigned u32x4 __attribute__((ext_vector_type(4)));
typedef unsigned u32x2 __attribute__((ext_vector_type(2)));

#ifndef PROBE_ID
#define PROBE_ID -1
#endif
#define REP(id) ((PROBE_ID) == (id) ? 2 : 1)
constexpr int BATCH = 8, SEQ = 2048, DM = 2048, M = BATCH * SEQ;
constexpr int NCOLS = 7512, NP = 7680;
constexpr int HA = 8, DHA = 128, DC = 256, HIDX = 16, DIDX = 64, NSEL = 256;
constexpr int HM = 4, DVM = 256, DKM = 128, CHUNK = 64, NCHUNK = SEQ / CHUNK;
constexpr float LN_EPS = 1e-5f;
constexpr float ALPHA = 1.189207115002721f;
constexpr float LOG2E = 1.4426950408889634f;
constexpr float QSCALE = 0.08838834764831845f * LOG2E;
constexpr int O_QA = 0, O_CKV = 1024, O_ZA = 1280, O_QI = 2304, O_KI = 3328, O_WI = 3392, O_QM = 3408, O_KM = 3920, O_VM = 4432, O_IM = 5456, O_FM = 5460, O_OM = 5464, O_ZM = 6488;
__host__ __device__ __forceinline__ int win_src(int np) {
    const int t = np >> 8, lc = np & 255;
    if (t < 4) return O_QA + np;
    if (t == 4) return O_CKV + lc;
    if (t < 9) return O_ZA + (np - 5 * 256);
    if (t < 13) return O_QI + (np - 9 * 256);
    if (t == 13) {
        if (lc < 32) return O_KI + lc;
        if (lc >= 128 && lc < 160) return O_KI + 32 + (lc - 128);
        if (lc >= 32 && lc < 48) return O_WI + (lc - 32);
        if (lc >= 48 && lc < 52) return O_IM + (lc - 48);
        if (lc >= 52 && lc < 56) return O_FM + (lc - 52);
        return -1;
    }
    if (t < 16) return O_QM + (np - 14 * 256);
    if (t < 18) return O_KM + (np - 16 * 256);
    if (t < 22) return O_VM + (np - 18 * 256);
    { const int j = t - 22; return lc < 128 ? O_OM + 128 * j + lc : O_ZM + 128 * j + (lc - 128); }
}

constexpr size_t MiB = 1u << 20;
constexpr size_t WS_CTL = 0, CTL_ZERO_BYTES = 1 * MiB;
constexpr size_t WS_XB = 1 * MiB;
constexpr size_t WS_Y = WS_XB;
constexpr size_t WS_WINT = 65 * MiB;
constexpr size_t WS_WOUTT = 95 * MiB;
constexpr size_t WS_WKVT = 103 * MiB;
constexpr size_t WS_Q = 104 * MiB;
constexpr size_t WS_C = 136 * MiB;
constexpr size_t WS_SZA = 144 * MiB;
constexpr size_t WS_QI = 176 * MiB;
constexpr size_t WS_KI = 208 * MiB;
constexpr size_t WS_WI = 210 * MiB;
constexpr size_t WS_IFG = 211 * MiB;
constexpr size_t WS_QKM = 212 * MiB;
constexpr size_t WS_VM = 244 * MiB;
constexpr size_t WS_GM = 276 * MiB;
constexpr size_t WS_MASK = 308 * MiB;
constexpr size_t WS_PAR = 312 * MiB;
constexpr int P_KVG = 0, P_LNG = 256, P_LNB = 320, P_RB = 384, P_CW = 640, P_CB = 4736, P_MHG = 5760, P_BI = 6784, P_BF = 6788, P_LG = 6800, P_LB = 8848, P_TOTAL = 10896;
constexpr size_t WS_NST = 313 * MiB;
constexpr size_t WS_DBG = 316 * MiB;
constexpr size_t WS_END = 324 * MiB;
constexpr size_t OUT_K = 64 * MiB, OUT_V = 96 * MiB;

__device__ __forceinline__ int lane_id_() { return (int)__builtin_amdgcn_mbcnt_hi(~0u, __builtin_amdgcn_mbcnt_lo(~0u, 0u)); }
namespace pg8 {
constexpr int BM = 256, BK = 64, HALF = 128, HTB = HALF * BK * 2, STAGE_BYTES = 8 * HTB, NXCD = 8, WGM = 8;
__host__ __device__ __forceinline__ int lds_byte(int r, int c) { const int st = (r >> 4) * 2 + (c >> 5), rr = r & 15, cc = c & 31, ob = rr * 64 + cc * 2; return st * 1024 + (ob ^ (((ob >> 9) & 1) << 5)); }
__host__ __device__ __forceinline__ void stage_rc(int b, int& R, int& C) { const int st = b / 1024, sb = b % 1024, swz = sb ^ (((sb >> 9) & 1) << 5); R = (st >> 1) * 16 + swz / 64; C = (st & 1) * 32 + (swz % 64) / 2; }
__host__ __device__ __forceinline__ int perm32(int rho) { const int n = rho >> 4, i = rho & 15; return 8 * (i >> 2) + 4 * n + (i & 3); }
struct Unit { int pm, pn; };
struct Gemm { const bf16_t* A; const bf16_t* Bt; int M, N, K; };
struct StaticOrder {
    int nM, nN, nwg, G, c;
    __host__ __device__ void init(int M_, int N_, int G_, int c_) { nM = M_ / BM; nN = N_ / BM; nwg = nM * nN; G = G_; c = c_; }
    __host__ __device__ bool next(int i, Unit& u) const {
        const long L = (long)i * G + c; if (L >= nwg) return false;
        int wgid = (int)L; { const int q = nwg / NXCD, r = nwg % NXCD, xcd = wgid % NXCD, off = wgid / NXCD; wgid = (xcd < r ? xcd * (q + 1) : r * (q + 1) + (xcd - r) * q) + off; }
        const int nig = WGM * nN, gid = wgid / nig, fm = gid * WGM, gsz = (nM - fm) < WGM ? (nM - fm) : WGM;
        u.pm = fm + ((wgid % nig) % gsz); u.pn = (wgid % nig) / gsz; return true;
    }
};
typedef float f32x2_t_ __attribute__((ext_vector_type(2))); typedef __bf16 bf16x2_t_ __attribute__((ext_vector_type(2)));
__device__ __forceinline__ unsigned cvt_pk_bf16(float lo, float hi) { f32x2_t_ v = {lo, hi}; bf16x2_t_ b = __builtin_convertvector(v, bf16x2_t_); return __builtin_bit_cast(unsigned, b); }

template <class Epi, class Sched, bool ALIGN_EPI = true, bool SP2 = true>
__device__ __forceinline__ void gemm_phase(LAS unsigned char* lds, const Gemm g, const Sched& S, const Epi& E, int wave_) {
    int tid = wave_ * 64 + lane_id_(); asm volatile("" : "+v"(tid));
    const int wid = __builtin_amdgcn_readfirstlane(tid >> 6), lane = tid & 63, wr = wid >> 2, wc = wid & 3, fr = lane & 15, fq = lane >> 4;
    const int K = g.K, nt = K / BK;
    unsigned voffA[2], voffB[2];
#pragma unroll
    for (int i = 0; i < 2; ++i) { int R, C; stage_rc(tid * 16 + i * 8192, R, C); const int Rb = Epi::PERM ? ((R & ~31) + perm32(R & 31)) : R;
        voffA[i] = (unsigned)(R * K + C) * 2u; voffB[i] = (unsigned)(Rb * K + C) * 2u; }
    const size_t kstep = (size_t)(BK * 2);
    const size_t hstep = (size_t)HALF * K * 2;
    const size_t tstep = 2 * hstep;
    const unsigned ldsw = (unsigned)wid * 1024u;
    const int aoff = lds_byte(wr * 64 + fr, fq * 8), boff = lds_byte(wc * 32 + fr, fq * 8);
#define PG8_SA(b, h) (((b) * 2 + (h)) * HTB)
#define PG8_SB(b, h) ((4 + (b) * 2 + (h)) * HTB)
#define PG8_STAGE(bufoff, gbase, voff) do { _Pragma("unroll") for (int _i = 0; _i < 2; ++_i) \
        __builtin_amdgcn_global_load_lds((const unsigned*)((const char*)(gbase) + (voff)[_i]), (LAS unsigned*)(lds + (bufoff) + ldsw + _i * 8192), 16, 0, 0); } while (0)
#define PG8_LDA(dst, b, h) do { _Pragma("unroll") for (int m = 0; m < 4; ++m) _Pragma("unroll") for (int k = 0; k < 2; ++k) dst[m][k] = *(const LAS bf16x8*)(lds + PG8_SA(b, h) + aoff + m * 2048 + k * 1024); } while (0)
#define PG8_LDB(dst, b, h) do { _Pragma("unroll") for (int n = 0; n < 2; ++n) _Pragma("unroll") for (int k = 0; k < 2; ++k) dst[n][k] = *(const LAS bf16x8*)(lds + PG8_SB(b, h) + boff + n * 2048 + k * 1024); } while (0)
#define PG8_MMA(ai, bj, At, Bt) do { __builtin_amdgcn_s_setprio(1); _Pragma("unroll") for (int m = 0; m < 4; ++m) _Pragma("unroll") for (int n = 0; n < 2; ++n) _Pragma("unroll") for (int k = 0; k < 2; ++k) \
        acc[ai][bj][m][n] = __builtin_amdgcn_mfma_f32_16x16x32_bf16(Bt[n][k], At[m][k], acc[ai][bj][m][n], 0, 0, 0); __builtin_amdgcn_s_setprio(0); } while (0)
#define PG8_WAIT_V(n) asm volatile("s_waitcnt vmcnt(" #n ")" ::: "memory")
#define PG8_WAIT_L(n) asm volatile("s_waitcnt lgkmcnt(" #n ")" ::: "memory")
#define PG8_BAR __builtin_amdgcn_s_barrier()
#define PG8_SCHED __builtin_amdgcn_sched_barrier(0)
    Unit cur, nxt; int ui = 0;
    if (!S.next(0, cur)) return;
    f32x4 acc[2][2][4][2];
#pragma unroll
    for (int a = 0; a < 2; ++a)
#pragma unroll
        for (int b = 0; b < 2; ++b)
#pragma unroll
            for (int m = 0; m < 4; ++m)
#pragma unroll
                for (int n = 0; n < 2; ++n) acc[a][b][m][n] = (f32x4){0.f, 0.f, 0.f, 0.f};
    bf16x8 At[4][2], B0[2][2], B1[2][2];
    const char* cA = (const char*)g.A + (size_t)cur.pm * tstep; const char* cB = (const char*)g.Bt + (size_t)cur.pn * tstep;
    if constexpr (SP2) {
        PG8_STAGE(PG8_SB(0, 0), cB, voffB); PG8_STAGE(PG8_SB(0, 1), cB + hstep, voffB); PG8_STAGE(PG8_SA(0, 0), cA, voffA); PG8_STAGE(PG8_SA(0, 1), cA + hstep, voffA);
        if (wr == 1) PG8_BAR;
        PG8_WAIT_V(2); PG8_BAR;
        PG8_STAGE(PG8_SB(1, 0), cB + kstep, voffB); PG8_STAGE(PG8_SA(1, 0), cA + kstep, voffA); PG8_STAGE(PG8_SB(1, 1), cB + hstep + kstep, voffB);
        PG8_WAIT_V(6); PG8_BAR;
    } else {
        PG8_STAGE(PG8_SB(0, 0), cB, voffB); PG8_STAGE(PG8_SA(0, 0), cA, voffA); PG8_STAGE(PG8_SB(0, 1), cB + hstep, voffB); PG8_STAGE(PG8_SA(0, 1), cA + hstep, voffA);
        if (wr == 1) PG8_BAR;
        PG8_WAIT_V(4); PG8_BAR;
        PG8_STAGE(PG8_SB(1, 0), cB + kstep, voffB); PG8_STAGE(PG8_SA(1, 0), cA + kstep, voffA); PG8_STAGE(PG8_SB(1, 1), cB + hstep + kstep, voffB);
        PG8_WAIT_V(6); PG8_BAR;
    }
    for (;;) {
        const bool has_next = S.next(ui + 1, nxt);
        const char* nA = has_next ? (const char*)g.A + (size_t)nxt.pm * tstep : cA; const char* nB = has_next ? (const char*)g.Bt + (size_t)nxt.pn * tstep : cB;
#pragma unroll 1
        for (int t = 0; t < nt; t += 2) {
            const bool last = (t == nt - 2);
            const char* a1 = cA + (size_t)(t + 1) * kstep;
            const char* a2 = last ? nA : cA + (size_t)(t + 2) * kstep; const char* b2 = last ? nB : cB + (size_t)(t + 2) * kstep;
            const char* a3 = a2 + kstep; const char* b3 = b2 + kstep;
            if constexpr (SP2) {
            PG8_LDB(B0, 0, 0); PG8_LDB(B1, 0, 1); PG8_SCHED; PG8_LDA(At, 0, 0); PG8_STAGE(PG8_SA(1, 1), a1 + hstep, voffA);
            PG8_WAIT_V(8); PG8_WAIT_L(0); PG8_BAR; PG8_MMA(0, 0, At, B0); PG8_MMA(0, 1, At, B1); PG8_BAR; PG8_SCHED;
            PG8_LDA(At, 0, 1); PG8_STAGE(PG8_SB(0, 0), b2, voffB); PG8_STAGE(PG8_SB(0, 1), b2 + hstep, voffB); PG8_STAGE(PG8_SA(0, 0), a2, voffA);
            PG8_WAIT_V(8); PG8_WAIT_L(0); PG8_BAR; PG8_MMA(1, 0, At, B0); PG8_MMA(1, 1, At, B1); PG8_BAR; PG8_SCHED;
            PG8_LDB(B0, 1, 0); PG8_LDB(B1, 1, 1); PG8_SCHED; PG8_LDA(At, 1, 0); PG8_STAGE(PG8_SA(0, 1), a2 + hstep, voffA);
            PG8_WAIT_V(8); PG8_WAIT_L(0); PG8_BAR; PG8_MMA(0, 0, At, B0); PG8_MMA(0, 1, At, B1); PG8_BAR; PG8_SCHED;
            PG8_LDA(At, 1, 1); PG8_STAGE(PG8_SB(1, 0), b3, voffB); PG8_STAGE(PG8_SB(1, 1), b3 + hstep, voffB); PG8_STAGE(PG8_SA(1, 0), a3, voffA);
            PG8_WAIT_V(8); PG8_WAIT_L(0); PG8_BAR; PG8_MMA(1, 0, At, B0); PG8_MMA(1, 1, At, B1); PG8_BAR; PG8_SCHED;
            } else {
            PG8_LDB(B0, 0, 0); PG8_SCHED; PG8_LDA(At, 0, 0); PG8_STAGE(PG8_SA(1, 1), a1 + hstep, voffA);
            PG8_WAIT_L(8); PG8_BAR; PG8_WAIT_L(0); PG8_MMA(0, 0, At, B0); PG8_BAR; PG8_SCHED;
            PG8_LDB(B1, 0, 1); PG8_STAGE(PG8_SB(0, 0), b2, voffB);
            PG8_BAR; PG8_WAIT_L(0); PG8_MMA(0, 1, At, B1); PG8_BAR;
            PG8_LDA(At, 0, 1); PG8_STAGE(PG8_SA(0, 0), a2, voffA);
            PG8_BAR; PG8_WAIT_L(0); PG8_MMA(1, 0, At, B0); PG8_BAR; PG8_SCHED;
            PG8_STAGE(PG8_SB(0, 1), b2 + hstep, voffB);
            PG8_WAIT_V(6); PG8_BAR; PG8_MMA(1, 1, At, B1); PG8_BAR;
            PG8_LDB(B0, 1, 0); PG8_SCHED; PG8_LDA(At, 1, 0); PG8_STAGE(PG8_SA(0, 1), a2 + hstep, voffA);
            PG8_WAIT_L(8); PG8_BAR; PG8_WAIT_L(0); PG8_MMA(0, 0, At, B0); PG8_BAR; PG8_SCHED;
            PG8_LDB(B1, 1, 1); PG8_STAGE(PG8_SB(1, 0), b3, voffB);
            PG8_BAR; PG8_WAIT_L(0); PG8_MMA(0, 1, At, B1); PG8_BAR;
            PG8_LDA(At, 1, 1); PG8_STAGE(PG8_SA(1, 0), a3, voffA);
            PG8_BAR; PG8_WAIT_L(0); PG8_MMA(1, 0, At, B0); PG8_BAR; PG8_SCHED;
            PG8_STAGE(PG8_SB(1, 1), b3 + hstep, voffB);
            PG8_WAIT_V(6); PG8_BAR; PG8_MMA(1, 1, At, B1); PG8_BAR;
            }
        }
        if constexpr (ALIGN_EPI) { if (wr == 0) PG8_BAR; }
        E(acc, cur, wr, wc, fr, fq, lds + STAGE_BYTES);
        if (!has_next) break;
#pragma unroll
        for (int a = 0; a < 2; ++a)
#pragma unroll
            for (int b = 0; b < 2; ++b)
#pragma unroll
                for (int m = 0; m < 4; ++m)
#pragma unroll
                    for (int n = 0; n < 2; ++n) acc[a][b][m][n] = (f32x4){0.f, 0.f, 0.f, 0.f};
        cur = nxt; cA = nA; cB = nB; ++ui;
        if constexpr (ALIGN_EPI) { if (wr == 1) PG8_BAR; }
    }
    PG8_WAIT_V(0);
    if constexpr (!ALIGN_EPI) { if (wr == 0) PG8_BAR; }
    PG8_BAR;
    asm volatile("" ::: "memory");
#undef PG8_SA
#undef PG8_SB
#undef PG8_STAGE
#undef PG8_LDA
#undef PG8_LDB
#undef PG8_MMA
#undef PG8_WAIT_V
#undef PG8_WAIT_L
#undef PG8_BAR
#undef PG8_SCHED
}
}

__device__ __forceinline__ int lane_id() { return (int)__builtin_amdgcn_mbcnt_hi(~0u, __builtin_amdgcn_mbcnt_lo(~0u, 0u)); }
__device__ __forceinline__ float sigmoid_f(float v) { return __builtin_amdgcn_rcpf(1.f + __expf(-v)); }
__device__ __forceinline__ float silu_f(float v) { return v * sigmoid_f(v); }
__device__ __forceinline__ unsigned f2bf(float f) { unsigned u = __builtin_bit_cast(unsigned, f); return (u + 0x7fffu + ((u >> 16) & 1u)) >> 16; }
__device__ __forceinline__ unsigned pk2(float lo, float hi) { return f2bf(lo) | (f2bf(hi) << 16); }
__device__ __forceinline__ float bf2f(bf16_t b) { return __builtin_bit_cast(float, ((unsigned)b) << 16); }
__device__ __forceinline__ int t5_bucket(int n) {
    if (n < 16) return n;
    const int l = 16 + (int)(logf((float)n * (1.f / 16.f)) * (16.f / 2.0794415416798357f));
    return l < 31 ? l : 31;
}
__device__ __forceinline__ float log_sigmoid_f(float x) { return fminf(x, 0.f) - log1pf(expf(-fabsf(x))); }

using pg8::Unit; using pg8::cvt_pk_bf16;
template <int ACT  > __device__ __forceinline__ void store_tile_bf16(const f32x4 (&acc)[2][2][4][2], bf16_t* base, int ld, float sc, int wr, int wc, int fr, int fq) {
    bf16_t* p0 = base + (size_t)(wr * 64 + fr) * ld + wc * 32 + 8 * fq;
#pragma unroll
    for (int ai = 0; ai < 2; ++ai)
#pragma unroll
        for (int m = 0; m < 4; ++m) { bf16_t* rowp = p0 + (size_t)(ai * 128 + m * 16) * ld;
#pragma unroll
            for (int bj = 0; bj < 2; ++bj) { f32x4 v0 = acc[ai][bj][m][0], v1 = acc[ai][bj][m][1];
                if (ACT == 1) {
#pragma unroll
                    for (int j = 0; j < 4; ++j) { v0[j] = silu_f(v0[j]); v1[j] = silu_f(v1[j]); } }
                else { v0 = v0 * sc; v1 = v1 * sc; }
                u32x4 w; w.x = cvt_pk_bf16(v0[0], v0[1]); w.y = cvt_pk_bf16(v0[2], v0[3]); w.z = cvt_pk_bf16(v1[0], v1[1]); w.w = cvt_pk_bf16(v1[2], v1[3]);
                *(u32x4*)(rowp + bj * 128) = w; } }
}

struct Epi1 {
    static constexpr bool PERM = true;
    unsigned char* ws;
    __device__ __forceinline__ void operator()(const f32x4 (&acc)[2][2][4][2], const Unit& u, int wr, int wc, int fr, int fq, LAS unsigned char* xl) const {
        { int l_ = lane_id(); asm volatile("" : "+v"(l_)); fr = l_ & 15; fq = (l_ >> 4) & 3; }
        const int pn = u.pn; const size_t r0 = (size_t)u.pm * 256;
        bf16_t* const Q = (bf16_t*)(ws + WS_Q); bf16_t* const C = (bf16_t*)(ws + WS_C); bf16_t* const SZA = (bf16_t*)(ws + WS_SZA); bf16_t* const QI = (bf16_t*)(ws + WS_QI);
        bf16_t* const KI = (bf16_t*)(ws + WS_KI); bf16_t* const QKM = (bf16_t*)(ws + WS_QKM); bf16_t* const VM = (bf16_t*)(ws + WS_VM); bf16_t* const GM = (bf16_t*)(ws + WS_GM);
        float* const WI = (float*)(ws + WS_WI); float* const IFG = (float*)(ws + WS_IFG);
        const float* const kvg = (const float*)(ws + WS_PAR) + P_KVG; const float* const lng = (const float*)(ws + WS_PAR) + P_LNG; const float* const lnb = (const float*)(ws + WS_PAR) + P_LNB;
        if (pn < 4) { store_tile_bf16<0>(acc, Q + r0 * 1024 + pn * 256, 1024, QSCALE, wr, wc, fr, fq); return; }
        if (pn == 4) {
            LAS float* P = (LAS float*)xl;
#pragma unroll
            for (int ai = 0; ai < 2; ++ai)
#pragma unroll
                for (int m = 0; m < 4; ++m) { float s = 0.f;
#pragma unroll
                    for (int bj = 0; bj < 2; ++bj)
#pragma unroll
                        for (int n = 0; n < 2; ++n) { const f32x4 x = acc[ai][bj][m][n]; s += (x[0] * x[0] + x[1] * x[1]) + (x[2] * x[2] + x[3] * x[3]); }
                    s += __shfl_xor(s, 16); s += __shfl_xor(s, 32);
                    if (fq == 0) P[(ai * 128 + wr * 64 + m * 16 + fr) * 4 + wc] = s; }
            asm volatile("s_waitcnt lgkmcnt(0)" ::: "memory"); __builtin_amdgcn_s_barrier(); asm volatile("" ::: "memory");
            const int c0 = wc * 32 + 8 * fq;
            f32x4 g[2][2];
#pragma unroll
            for (int bj = 0; bj < 2; ++bj) { g[bj][0] = *(const f32x4*)(kvg + bj * 128 + c0); g[bj][1] = *(const f32x4*)(kvg + bj * 128 + c0 + 4); }
#pragma unroll
            for (int ai = 0; ai < 2; ++ai)
#pragma unroll
                for (int m = 0; m < 4; ++m) { const int r = ai * 128 + wr * 64 + m * 16 + fr;
                    const f32x4 pp = *(const LAS f32x4*)(P + r * 4);
                    const float rstd = rsqrtf(((pp[0] + pp[1]) + (pp[2] + pp[3])) * (1.f / 256.f) + LN_EPS);
                    bf16_t* rowp = C + (r0 + r) * 256 + c0;
#pragma unroll
                    for (int bj = 0; bj < 2; ++bj) { const f32x4 v0 = acc[ai][bj][m][0] * rstd * g[bj][0], v1 = acc[ai][bj][m][1] * rstd * g[bj][1];
                        u32x4 w; w.x = cvt_pk_bf16(v0[0], v0[1]); w.y = cvt_pk_bf16(v0[2], v0[3]); w.z = cvt_pk_bf16(v1[0], v1[1]); w.w = cvt_pk_bf16(v1[2], v1[3]);
                        *(u32x4*)(rowp + bj * 128) = w; } }
            asm volatile("s_waitcnt lgkmcnt(0)" ::: "memory"); __builtin_amdgcn_s_barrier(); asm volatile("" ::: "memory");
            return;
        }
        if (pn < 9) { store_tile_bf16<1>(acc, SZA + r0 * 1024 + (pn - 5) * 256, 1024, 1.f, wr, wc, fr, fq); return; }
        if (pn < 13) { store_tile_bf16<0>(acc, QI + r0 * 1024 + (pn - 9) * 256, 1024, 0.125f, wr, wc, fr, fq); return; }
        if (pn == 13) {
            if (wc == 0) {
                f32x4 g[2][2], bb[2][2];
#pragma unroll
                for (int bj = 0; bj < 2; ++bj)
#pragma unroll
                    for (int n = 0; n < 2; ++n) { g[bj][n] = *(const f32x4*)(lng + 32 * bj + 8 * fq + 4 * n); bb[bj][n] = *(const f32x4*)(lnb + 32 * bj + 8 * fq + 4 * n); }
#pragma unroll
                for (int ai = 0; ai < 2; ++ai)
#pragma unroll
                    for (int m = 0; m < 4; ++m) { float s = 0.f;
#pragma unroll
                        for (int bj = 0; bj < 2; ++bj)
#pragma unroll
                            for (int n = 0; n < 2; ++n) { const f32x4 x = acc[ai][bj][m][n]; s += (x[0] + x[1]) + (x[2] + x[3]); }
                        s += __shfl_xor(s, 16); s += __shfl_xor(s, 32);
                        const float mu = s * (1.f / 64.f); float q = 0.f;
#pragma unroll
                        for (int bj = 0; bj < 2; ++bj)
#pragma unroll
                            for (int n = 0; n < 2; ++n) { const f32x4 d = acc[ai][bj][m][n] - mu; q += (d[0] * d[0] + d[1] * d[1]) + (d[2] * d[2] + d[3] * d[3]); }
                        q += __shfl_xor(q, 16); q += __shfl_xor(q, 32);
                        const float rstd = rsqrtf(q * (1.f / 64.f) + LN_EPS);
                        bf16_t* rowp = KI + (r0 + ai * 128 + wr * 64 + m * 16 + fr) * 64 + 8 * fq;
#pragma unroll
                        for (int bj = 0; bj < 2; ++bj) { const f32x4 v0 = (acc[ai][bj][m][0] - mu) * rstd * g[bj][0] + bb[bj][0], v1 = (acc[ai][bj][m][1] - mu) * rstd * g[bj][1] + bb[bj][1];
                            u32x4 w; w.x = cvt_pk_bf16(v0[0], v0[1]); w.y = cvt_pk_bf16(v0[2], v0[3]); w.z = cvt_pk_bf16(v1[0], v1[1]); w.w = cvt_pk_bf16(v1[2], v1[3]);
                            *(u32x4*)(rowp + bj * 32) = w; } }
            } else if (wc == 1) {
#pragma unroll
                for (int ai = 0; ai < 2; ++ai)
#pragma unroll
                    for (int m = 0; m < 4; ++m) { const size_t r = r0 + ai * 128 + wr * 64 + m * 16 + fr;
                        if (fq < 2) { *(f32x4*)(WI + r * 16 + 8 * fq) = acc[ai][0][m][0] * 0.25f; *(f32x4*)(WI + r * 16 + 8 * fq + 4) = acc[ai][0][m][1] * 0.25f; }
                        else if (fq == 2) { *(f32x4*)(IFG + r * 8) = acc[ai][0][m][0]; *(f32x4*)(IFG + r * 8 + 4) = acc[ai][0][m][1]; } }
            }
            return;
        }
        if (pn < 18) { store_tile_bf16<0>(acc, QKM + r0 * 1024 + (pn - 14) * 256, 1024, 1.f, wr, wc, fr, fq); return; }
        if (pn < 22) { store_tile_bf16<0>(acc, VM + r0 * 1024 + (pn - 18) * 256, 1024, 1.f, wr, wc, fr, fq); return; }
        {
            bf16_t* p0 = GM + (r0 + wr * 64 + fr) * 1024 + (pn - 22) * 128 + wc * 32 + 8 * fq;
#pragma unroll
            for (int ai = 0; ai < 2; ++ai)
#pragma unroll
                for (int m = 0; m < 4; ++m) { f32x4 v0, v1;
#pragma unroll
                    for (int j = 0; j < 4; ++j) { v0[j] = sigmoid_f(acc[ai][0][m][0][j]) * silu_f(acc[ai][1][m][0][j]); v1[j] = sigmoid_f(acc[ai][0][m][1][j]) * silu_f(acc[ai][1][m][1][j]); }
                    u32x4 w; w.x = cvt_pk_bf16(v0[0], v0[1]); w.y = cvt_pk_bf16(v0[2], v0[3]); w.z = cvt_pk_bf16(v1[0], v1[1]); w.w = cvt_pk_bf16(v1[2], v1[3]);
                    *(u32x4*)(p0 + (size_t)(ai * 128 + m * 16) * 1024) = w; }
        }
    }
};
struct EpiKV {
    static constexpr bool PERM = true;
    bf16_t *Kb, *Vb;
    __device__ __forceinline__ void operator()(const f32x4 (&acc)[2][2][4][2], const Unit& u, int wr, int wc, int fr, int fq, LAS unsigned char*) const {
        { int l_ = lane_id(); asm volatile("" : "+v"(l_)); fr = l_ & 15; fq = (l_ >> 4) & 3; }
        bf16_t* base = (u.pn < 4 ? Kb + u.pn * 256 : Vb + (u.pn - 4) * 256) + (size_t)u.pm * 256 * 1024;
        store_tile_bf16<0>(acc, base, 1024, 1.f, wr, wc, fr, fq);
    }
};
struct EpiOut {
    static constexpr bool PERM = false;
    const float* x; float* out;
    __device__ __forceinline__ void operator()(const f32x4 (&acc)[2][2][4][2], const Unit& u, int wr, int wc, int fr, int fq, LAS unsigned char*) const {
        { int l_ = lane_id(); asm volatile("" : "+v"(l_)); fr = l_ & 15; fq = (l_ >> 4) & 3; }
        const size_t off0 = ((size_t)u.pm * 256 + wr * 64 + fr) * DM + u.pn * 256 + wc * 32 + 4 * fq;
#pragma unroll
        for (int ai = 0; ai < 2; ++ai)
#pragma unroll
            for (int m = 0; m < 4; ++m) { const size_t off = off0 + (size_t)(ai * 128 + m * 16) * DM;
#pragma unroll
                for (int bj = 0; bj < 2; ++bj)
#pragma unroll
                    for (int n = 0; n < 2; ++n) { const f32x4 xv = *(const f32x4*)(x + off + bj * 128 + n * 16);
                        *(f32x4*)(out + off + bj * 128 + n * 16) = xv * ALPHA + acc[ai][bj][m][n]; } }
    }
};


#define XB_TMO      128
#define XB_XCNT(j)  (256  + 64 * (j))
#define XB_XSUB(j)  (1280 + 64 * (j))
#define XB_XGEN(j)  (2304 + 64 * (j))
#define XB_TOP      3328
#define XB_TOPGEN   3392
#define XCD_BAR_WORDS 3456
#define XB_SPIN_CAP (1u << 18)
__device__ __forceinline__ unsigned xb_ld(unsigned* p)              { return __hip_atomic_load(p, __ATOMIC_RELAXED, __HIP_MEMORY_SCOPE_AGENT); }
__device__ __forceinline__ unsigned xb_add(unsigned* p, unsigned v) { return __hip_atomic_fetch_add(p, v, __ATOMIC_RELAXED, __HIP_MEMORY_SCOPE_AGENT); }
__device__ __forceinline__ unsigned xb_xcc_id() { return (unsigned)__builtin_amdgcn_s_getreg((3 << 11) | 20) & 0xFu; }
#define XB_SPIN(cond, bar) do { unsigned _sp = 0; while (cond) { __builtin_amdgcn_s_sleep(1); \
    if ((++_sp & 255u) == 0u) { if (xb_ld(&(bar)[XB_TMO])) break; if (_sp > XB_SPIN_CAP) { atomicAdd(&(bar)[XB_TMO], 1u); break; } } } } while (0)
struct XcdBarrier { unsigned* bar; unsigned x; volatile LAS unsigned* st; };
__device__ __forceinline__ XcdBarrier xcd_barrier_post(unsigned* bar, volatile LAS unsigned* st) {
    XcdBarrier b; b.bar = bar; b.x = xb_xcc_id(); b.st = st;
    if (threadIdx.x == 0) (void)xb_add(&bar[XB_XCNT(b.x)], 1u);
    return b;
}
__device__ __forceinline__ void xcd_barrier_complete(unsigned* bar, unsigned x, unsigned& nloc, unsigned& nx) {
    const unsigned G = gridDim.x * gridDim.y * gridDim.z;
    unsigned sum, cnt, mine, sp = 0u;
    for (;;) {
        sum = 0u; cnt = 0u; mine = 0u;
#pragma unroll
        for (unsigned j = 0; j < 16; ++j) { const unsigned c = xb_ld(&bar[XB_XCNT(j)]); sum += c; cnt += (c > 0u) ? 1u : 0u; mine = (j == x) ? c : mine; }
        if (sum == G) break;
        __builtin_amdgcn_s_sleep(1);
        if ((++sp & 255u) == 0u) { if (xb_ld(&bar[XB_TMO])) break; if (sp > XB_SPIN_CAP) { atomicAdd(&bar[XB_TMO], 1u); break; } }
    }
    nloc = mine > 0u ? mine : 1u; nx = cnt > 0u ? cnt : 1u;
}
__device__ __forceinline__ void xcd_barrier(const XcdBarrier& b, int wave_) {
    asm volatile("s_waitcnt vmcnt(0)" ::: "memory");
    __syncthreads();
    if (wave_ == 0 && lane_id() == 0) {
        unsigned* bar = b.bar;
        __builtin_amdgcn_s_waitcnt(0);
        unsigned nloc = b.st[0], nx = b.st[1];
        if (nloc == 0u) { xcd_barrier_complete(bar, b.x, nloc, nx); b.st[0] = nloc; b.st[1] = nx; }
        const unsigned old = xb_add(&bar[XB_XSUB(b.x)], 1u);
        const unsigned gen = old / nloc;
        if (old + 1u == (gen + 1u) * nloc) {
            __builtin_amdgcn_fence(__ATOMIC_RELEASE, "agent");
            asm volatile("s_waitcnt vmcnt(0)" ::: "memory");
            const unsigned og = xb_add(&bar[XB_TOP], 1u);
            const unsigned tg = og / nx;
            if (og + 1u == (tg + 1u) * nx) xb_add(&bar[XB_TOPGEN], 1u);
            else XB_SPIN(xb_ld(&bar[XB_TOPGEN]) == tg, bar);
            __builtin_amdgcn_fence(__ATOMIC_ACQUIRE, "agent");
            xb_add(&bar[XB_XGEN(b.x)], 1u);
            asm volatile("s_waitcnt vmcnt(0)" ::: "memory");
        } else {
            XB_SPIN(xb_ld(&bar[XB_XGEN(b.x)]) == gen, bar);
            __builtin_amdgcn_fence(__ATOMIC_ACQUIRE, "agent");
            asm volatile("s_waitcnt vmcnt(0)" ::: "memory");
        }
    }
    __syncthreads();
}

typedef float f32x16 __attribute__((ext_vector_type(16)));
__device__ __forceinline__ unsigned mono_key(float s) { s = s + 0.0f; const unsigned u = __builtin_bit_cast(unsigned, s); return (u & 0x80000000u) ? ~u : (u | 0x80000000u); }
__device__ __forceinline__ float swap_add(float a, float b) {
    auto rr = __builtin_amdgcn_permlane32_swap(__builtin_bit_cast(unsigned, a), __builtin_bit_cast(unsigned, b), false, false);
    return __builtin_bit_cast(float, (unsigned)rr[0]) + __builtin_bit_cast(float, (unsigned)rr[1]);
}
#define WRITELANE(dst, sval, ln) asm volatile("v_writelane_b32 %0, %1, %2" : "+v"(dst) : "s"(__builtin_amdgcn_readfirstlane((int)(sval))), "i"(ln))
__device__ __forceinline__ unsigned wave_sum_u32(unsigned v) {
    v += (unsigned)__builtin_amdgcn_update_dpp(0, (int)v, 0xB1, 0xF, 0xF, true);
    v += (unsigned)__builtin_amdgcn_update_dpp(0, (int)v, 0x4E, 0xF, 0xF, true);
    v += (unsigned)__builtin_amdgcn_update_dpp(0, (int)v, 0x141, 0xF, 0xF, true);
    v += (unsigned)__builtin_amdgcn_update_dpp(0, (int)v, 0x140, 0xF, 0xF, true);
    return (unsigned)__builtin_amdgcn_readlane((int)v, 0) + (unsigned)__builtin_amdgcn_readlane((int)v, 16) + (unsigned)__builtin_amdgcn_readlane((int)v, 32) + (unsigned)__builtin_amdgcn_readlane((int)v, 48);
}
__device__ __forceinline__ void emit_mask(const unsigned (&K)[32], unsigned T, bool exact, int ng, int t, unsigned long long* mrow, int lane, LAS unsigned long long* wl) {
    if (lane < 32) wl[lane] = 0ull;
    asm volatile("s_waitcnt lgkmcnt(0)" ::: "memory");
    if (exact) {
#pragma unroll
        for (int g = 0; g < 32; ++g) if (g < ng) { const unsigned long long w = __ballot(K[g] >= T); if (lane == 0) wl[g] = w; }
    } else {
        int gt = 0;
#pragma unroll
        for (int g = 0; g < 32; ++g) gt += __popcll(__ballot(K[g] > T));
        int need = NSEL - gt;
#pragma unroll
        for (int g = 0; g < 32; ++g) {
            const unsigned long long gtm = __ballot(K[g] > T); unsigned long long m = __ballot(K[g] == T);
            const int c = __popcll(m), take = c < need ? c : need;
            while (__popcll(m) > take) m &= ~(1ull << (63 - __clzll((long long)m)));
            need -= take;
            const unsigned long long w = gtm | m;
            if (lane == 0) wl[g] = w;
        }
    }
    asm volatile("s_waitcnt lgkmcnt(0)" ::: "memory");
    if (lane < 32) mrow[(size_t)lane * SEQ + t] = wl[lane];
    asm volatile("s_waitcnt lgkmcnt(0)" ::: "memory");
}
__device__ __forceinline__ void select2_store(const unsigned (&K0)[32], const unsigned (&K1)[32], int ng, int t, unsigned long long* mrow, int lane, LAS unsigned long long* wl) {
    unsigned T0 = 0u, T1 = 0u; bool ex0 = false, ex1 = false;
#pragma unroll 1
    for (int bit = 31; bit >= 0; --bit) {
        const unsigned cand0 = ex0 ? 0xffffffffu : (T0 | (1u << bit)), cand1 = ex1 ? 0xffffffffu : (T1 | (1u << bit));
        unsigned c0 = 0u, c1 = 0u;
#pragma unroll
        for (int gg = 0; gg < 8; ++gg) if (4 * gg < ng) {
#pragma unroll
            for (int j = 0; j < 4; ++j) { c0 += K0[4 * gg + j] >= cand0 ? 1u : 0u; c1 += K1[4 * gg + j] >= cand1 ? 1u : 0u; } }
        const unsigned tot = wave_sum_u32(c0 + (c1 << 16)); const int n0 = (int)(tot & 0xffffu), n1 = (int)(tot >> 16);
        if (!ex0) { if (n0 >= NSEL) T0 = cand0; if (n0 == NSEL) ex0 = true; }
        if (!ex1) { if (n1 >= NSEL) T1 = cand1; if (n1 == NSEL) ex1 = true; }
        if (ex0 && ex1) break;
    }
    emit_mask(K0, T0, ex0, ng, t, mrow, lane, wl);
    emit_mask(K1, T1, ex1, ng, t + 1, mrow, lane, wl);
}
__device__ __forceinline__ void topk_unit(const bf16_t* __restrict__ QI, const bf16_t* __restrict__ KI, const float* __restrict__ WI, unsigned long long* mask, int b, int i, int wave, int lane, LAS unsigned long long* wl, LAS unsigned char* kt) {
    const int t0 = i * 16, tq = t0 + 2 * wave;
    const size_t rb = (size_t)b * SEQ;
    unsigned long long* mrow = mask + (size_t)b * 32 * SEQ;
    if (t0 + 15 < NSEL) {
        const int g = lane & 31, t = tq + (lane >> 5), n = t - 64 * g + 1;
        mrow[(size_t)g * SEQ + t] = n >= 64 ? ~0ull : (n <= 0 ? 0ull : ((1ull << n) - 1ull));
        return;
    }
    const int r = lane & 31, hi = lane >> 5;
    bf16x8 A[4];
    { const bf16_t* qp = QI + (rb + tq + (r >> 4)) * 1024 + (r & 15) * 64 + hi * 8;
#pragma unroll
      for (int ks = 0; ks < 4; ++ks) A[ks] = *(const bf16x8*)(qp + ks * 16); }
    float wv[16];
#pragma unroll
    for (int reg = 0; reg < 16; ++reg) { const int hh = (reg & 3) + 8 * ((reg >> 2) & 1) + 4 * hi; wv[reg] = WI[(rb + tq + (reg >> 3)) * 16 + hh]; }
    const int ng = (t0 + 15) / 64 + 1;
    unsigned K0[32], K1[32];
    const int tid = wave * 64 + lane, skey = tid >> 3, sch = tid & 7;
    const GAS bf16_t* kp;
    const int swr = skey * 128 + ((sch ^ ((skey >> 1) & 7)) << 4);
    int rdo[2][2];
#pragma unroll
    for (int th = 0; th < 2; ++th) { const int row = 32 * th + r; rdo[th][0] = row * 128; rdo[th][1] = (row >> 1) & 7; }
  _Pragma("unroll 1") for (int rep_ = 0; rep_ < REP(8); ++rep_) {
    kp = (const GAS bf16_t*)KI + (rb + skey) * 64 + sch * 8;
    u32x4 stg;
    asm volatile("" : "+v"(kp)); stg = *(const GAS u32x4*)kp; kp += 64 * 64;
    *(LAS u32x4*)(kt + swr) = stg;
    __syncthreads();
#pragma unroll
    for (int g = 0; g < 32; ++g) {
        if (g < ng) {
            if (g + 1 < ng) { asm volatile("" : "+v"(kp)); stg = *(const GAS u32x4*)kp; kp += 64 * 64; }
            const LAS unsigned char* kb = kt + (g & 1) * 8192;
            bf16x8 B0[4], B1[4];
#pragma unroll
            for (int ks = 0; ks < 4; ++ks) { B0[ks] = *(const LAS bf16x8*)(kb + rdo[0][0] + (((2 * ks + hi) ^ rdo[0][1]) << 4)); B1[ks] = *(const LAS bf16x8*)(kb + rdo[1][0] + (((2 * ks + hi) ^ rdo[1][1]) << 4)); }
            f32x16 a0 = {}, a1 = {};
#pragma unroll
            for (int ks = 0; ks < 4; ++ks) { a0 = __builtin_amdgcn_mfma_f32_32x32x16_bf16(A[ks], B0[ks], a0, 0, 0, 0); a1 = __builtin_amdgcn_mfma_f32_32x32x16_bf16(A[ks], B1[ks], a1, 0, 0, 0); }
            float p00 = 0.f, p01 = 0.f, p10 = 0.f, p11 = 0.f;
#pragma unroll
            for (int reg = 0; reg < 8; ++reg) { p00 = fmaf(fmaxf(a0[reg], 0.f), wv[reg], p00); p10 = fmaf(fmaxf(a1[reg], 0.f), wv[reg], p10);
                                                p01 = fmaf(fmaxf(a0[reg + 8], 0.f), wv[reg + 8], p01); p11 = fmaf(fmaxf(a1[reg + 8], 0.f), wv[reg + 8], p11); }
            const float sA = swap_add(p00, p01), sB = swap_add(p10, p11);
            auto rr = __builtin_amdgcn_permlane32_swap(__builtin_bit_cast(unsigned, sA), __builtin_bit_cast(unsigned, sB), false, false);
            const float s0 = __builtin_bit_cast(float, (unsigned)rr[0]), s1 = __builtin_bit_cast(float, (unsigned)rr[1]);
            const int lim = tq - 64 * g;
            K0[g] = lane <= lim ? mono_key(s0) : 0u; K1[g] = lane <= lim + 1 ? mono_key(s1) : 0u;
            if (g + 1 < ng) *(LAS u32x4*)(kt + ((g + 1) & 1) * 8192 + swr) = stg;
            __syncthreads();
        } else { K0[g] = 0u; K1[g] = 0u; }
    }
  }
  _Pragma("unroll 1") for (int rep_ = 0; rep_ < REP(9); ++rep_)
    select2_store(K0, K1, ng, tq, mrow, lane, wl);
}

namespace att {
constexpr int NW = 8, QBLK = 32, KVBLK = 64, QB = NW * QBLK, D = 128, RS = 1024, OS = 2048;
constexpr int SHM_V = KVBLK * D * 2, SHM_K = KVBLK * D * 2;
constexpr int LDS_WS = 2 * SHM_V + 2 * SHM_K, LDS_LUT = LDS_WS + NW * 64 * 4, LDS_TOTAL = LDS_LUT + 512;
constexpr float THRL = 11.5f;
typedef short s16x4 __attribute__((ext_vector_type(4)));
#define KSWZ(row, colB) ((row) * 256 + ((colB) ^ (((row) & 7) << 4)))
#define SBAR() __builtin_amdgcn_sched_barrier(0)
__device__ __forceinline__ int v_st(int k, int c) { const int kk = (k & ~0xC) | ((k & 4) << 1) | ((k & 8) >> 1); return ((kk >> 3) * 4 + (c >> 5)) * 512 + ((kk & 7) * 32 + (c & 31)) * 2; }
__device__ __forceinline__ int v_rd_base(int lane) { return ((lane & 3) << 3) | (((lane >> 2) & 3) << 6) | (((lane >> 4) & 1) << 5) | (((lane >> 5) & 1) << 8); }
constexpr int v_rd_off(int d0, int ks, int half) { return d0 * 512 + ks * 4096 + half * 2048; }
__device__ __forceinline__ int crow(int r, int hi) { return (r & 3) + 8 * (r >> 2) + 4 * hi; }
__device__ __forceinline__ unsigned cvtpk(float lo, float hi) { return pg8::cvt_pk_bf16(lo, hi); }
__device__ __forceinline__ bf16x8 ld8(const bf16_t* p) { return *reinterpret_cast<const bf16x8*>(p); }
__device__ __forceinline__ void apply_mask(f32x16& p0, f32x16& p1, unsigned long long mw, int hi) {
    const unsigned a = (unsigned)mw >> (4 * hi), b = (unsigned)(mw >> 32) >> (4 * hi);
#pragma unroll
    for (int r = 0; r < 16; ++r) { const int c = (r & 3) + 8 * (r >> 2);
        p0[r] = (a & (1u << c)) ? p0[r] : -__builtin_inff();
        p1[r] = (b & (1u << c)) ? p1[r] : -__builtin_inff(); }
}
__device__ __forceinline__ void add_bias(f32x16& p0, f32x16& p1, const float* lut, int dq) {
#pragma unroll
    for (int r = 0; r < 16; ++r) { const int c = (r & 3) + 8 * (r >> 2);
        int i0 = dq - c, i1 = dq - c - 32; i0 = i0 < 0 ? 0 : (i0 > 127 ? 127 : i0); i1 = i1 < 0 ? 0 : (i1 > 127 ? 127 : i1);
        p0[r] += lut[i0]; p1[r] += lut[i1]; }
}
__device__ __forceinline__ void partialSM(f32x16& p0, f32x16& p1, float& m_reg, float& mn, float& alpha) {
    float pmax = p0[0];
#pragma unroll
    for (int r = 1; r < 16; ++r) pmax = fmaxf(pmax, p0[r]);
#pragma unroll
    for (int r = 0; r < 16; ++r) pmax = fmaxf(pmax, p1[r]);
    { auto rr = __builtin_amdgcn_permlane32_swap(__float_as_uint(pmax), __float_as_uint(pmax), false, false);
      pmax = fmaxf(__uint_as_float(rr[0]), __uint_as_float(rr[1])); }
    if (__builtin_expect(__all(pmax - m_reg <= THRL), 1)) { mn = m_reg; alpha = 1.f; }
    else { mn = fmaxf(m_reg, pmax); alpha = __builtin_amdgcn_exp2f(m_reg - mn); m_reg = mn; }
#pragma unroll
    for (int r = 0; r < 16; ++r) { p0[r] = p0[r] - mn; p1[r] = p1[r] - mn; }
#pragma unroll
    for (int r = 0; r < 16; ++r) p0[r] = __builtin_amdgcn_exp2f(p0[r]);
}
__device__ __forceinline__ void finishSM(f32x16& p0, f32x16& p1, float alpha, float& l_reg, bf16x8& pa0, bf16x8& pa1, bf16x8& pa2, bf16x8& pa3) {
#pragma unroll
    for (int r = 0; r < 16; ++r) p1[r] = __builtin_amdgcn_exp2f(p1[r]);
    float ps = 0;
#pragma unroll
    for (int r = 0; r < 16; ++r) ps += p0[r];
#pragma unroll
    for (int r = 0; r < 16; ++r) ps += p1[r];
    { auto rr = __builtin_amdgcn_permlane32_swap(__float_as_uint(ps), __float_as_uint(ps), false, false);
      ps = __uint_as_float(rr[0]) + __uint_as_float(rr[1]); }
    l_reg = l_reg * alpha + ps;
#define PK4(P, B_, OUT) do { unsigned a0 = cvtpk(P[B_+0], P[B_+1]), a1 = cvtpk(P[B_+2], P[B_+3]);                          \
        unsigned b0 = cvtpk(P[B_+4], P[B_+5]), b1 = cvtpk(P[B_+6], P[B_+7]);                                             \
        auto r0 = __builtin_amdgcn_permlane32_swap(a0, b0, false, false); auto r1 = __builtin_amdgcn_permlane32_swap(a1, b1, false, false); \
        u32x4 w = {r0[0], r1[0], r0[1], r1[1]}; OUT = *reinterpret_cast<bf16x8*>(&w); } while (0)
    PK4(p0, 0, pa0); PK4(p0, 8, pa1); PK4(p1, 0, pa2); PK4(p1, 8, pa3);
#undef PK4
}
template <int KB>
__device__ __forceinline__ void qkt(f32x16& p0, f32x16& p1, const char* K_lds, int r32, int hi, const bf16x8* qr) {
    p0 = f32x16{}; p1 = f32x16{};
    const char* kb[4];
#pragma unroll
    for (int dd = 0; dd < 4; ++dd) kb[dd] = K_lds + KB * SHM_K + KSWZ(r32, (dd * 16 + hi * 8) * 2);
#pragma unroll
    for (int d0 = 0; d0 < 8; ++d0) { const char* a = kb[d0 & 3] + (d0 >> 2) * 128;
        bf16x8 b0 = *reinterpret_cast<const bf16x8*>(a);
        bf16x8 b1 = *reinterpret_cast<const bf16x8*>(a + 32 * 256);
        p0 = __builtin_amdgcn_mfma_f32_32x32x16_bf16(b0, qr[d0], p0, 0, 0, 0);
        p1 = __builtin_amdgcn_mfma_f32_32x32x16_bf16(b1, qr[d0], p1, 0, 0, 0); }
}
template <int VB>
__device__ __forceinline__ void pv_tile(f32x16* o, int vb0, bf16x8 pa0, bf16x8 pa1, bf16x8 pa2, bf16x8 pa3) {
#define TRRD(dst, off) asm volatile("ds_read_b64_tr_b16 %0, %1 offset:%2" : "=&v"(dst) : "v"(vb0), "i"(off) : "memory")
#define PV_D0(d0) do { s16x4 l0, l1, l2, l3, h0, h1, h2, h3; constexpr int b_ = VB * SHM_V + v_rd_off(d0, 0, 0); \
        TRRD(l0, b_); TRRD(h0, b_ + 2048); TRRD(l1, b_ + 4096); TRRD(h1, b_ + 6144); TRRD(l2, b_ + 8192); TRRD(h2, b_ + 10240); TRRD(l3, b_ + 12288); TRRD(h3, b_ + 14336); \
        asm volatile("s_waitcnt lgkmcnt(0)" ::: "memory"); SBAR();   \
        o[d0] = __builtin_amdgcn_mfma_f32_32x32x16_bf16(pa0, (bf16x8){l0[0], l0[1], l0[2], l0[3], h0[0], h0[1], h0[2], h0[3]}, o[d0], 0, 0, 0);   \
        o[d0] = __builtin_amdgcn_mfma_f32_32x32x16_bf16(pa1, (bf16x8){l1[0], l1[1], l1[2], l1[3], h1[0], h1[1], h1[2], h1[3]}, o[d0], 0, 0, 0);   \
        o[d0] = __builtin_amdgcn_mfma_f32_32x32x16_bf16(pa2, (bf16x8){l2[0], l2[1], l2[2], l2[3], h2[0], h2[1], h2[2], h2[3]}, o[d0], 0, 0, 0);   \
        o[d0] = __builtin_amdgcn_mfma_f32_32x32x16_bf16(pa3, (bf16x8){l3[0], l3[1], l3[2], l3[3], h3[0], h3[1], h3[2], h3[3]}, o[d0], 0, 0, 0); } while (0)
    PV_D0(0); PV_D0(1); PV_D0(2); PV_D0(3);
#undef PV_D0
#undef TRRD
}
struct BlockRef { const bf16_t* Q; const bf16_t* K; const bf16_t* V; bf16_t* O; const bf16_t* Z; const unsigned long long* MK; int P0; };
struct Seam { bf16x8 qr[8]; bf16x8 st_v0, st_v1, st_k0, st_k1; };
#define ROW(p, k0, rr) ((p) + (size_t)((k0) + (rr)) * RS + sc)
#define VMW() asm volatile("s_waitcnt vmcnt(0)" ::: "memory")
#define VMWN(n) asm volatile("s_waitcnt vmcnt(%0)" :: "i"(n) : "memory")
#define SLOAD_H(Kp, Vp, k0) do { unsigned o_ = soff; asm volatile("" : "+v"(o_)); const char* kp_ = (const char*)(Kp) + (size_t)(k0) * (RS * 2); const char* vp_ = (const char*)(Vp) + (size_t)(k0) * (RS * 2); \
        S.st_v0 = *(const bf16x8*)(vp_ + o_); S.st_v1 = *(const bf16x8*)(vp_ + o_ + 32 * RS * 2); S.st_k0 = *(const bf16x8*)(kp_ + o_); S.st_k1 = *(const bf16x8*)(kp_ + o_ + 32 * RS * 2); } while (0)
#define QLOAD(Qp) do { unsigned o_ = qoff; asm volatile("" : "+v"(o_)); const char* qp_ = (const char*)(Qp); _Pragma("unroll") for (int d0 = 0; d0 < 8; ++d0) S.qr[d0] = *(const bf16x8*)(qp_ + o_ + d0 * 32); } while (0)
#define MLOAD(t) ({ unsigned o_ = moff; asm volatile("" : "+v"(o_)); *(const unsigned long long*)((const char*)cur.MK + (size_t)(t) * (SEQ * 8) + o_); })
#define SWRITE_HK(bf) do { *(bf16x8*)(K_lds + (bf) * SHM_K + kws) = S.st_k0; *(bf16x8*)(K_lds + (bf) * SHM_K + kws + 32 * 256) = S.st_k1; } while (0)
#define SWRITE_HV(bf) do { *(bf16x8*)(V_lds + (bf) * SHM_V + vst0) = S.st_v0; *(bf16x8*)(V_lds + (bf) * SHM_V + vst1) = S.st_v1; } while (0)
#define SWRITE_H(bf) do { SWRITE_HV(bf); SWRITE_HK(bf); } while (0)
__device__ __forceinline__ void prime(const BlockRef& cur, char* lds, Seam& S, const float* rel_bias, int h, int wid) {
    const int lane = lane_id(), tid = wid * 64 + lane, r32 = lane & 31, hi = lane >> 5;
    const int sr = tid >> 4, sc = (tid & 15) * 8, kws = KSWZ(sr, sc * 2); char* K_lds = lds + 2 * SHM_V;
    const unsigned soff = (unsigned)(sr * RS + sc) * 2u, qoff = (unsigned)((wid * QBLK + r32) * RS + hi * 8) * 2u;
    if (tid < 128) ((float*)(lds + LDS_LUT))[tid] = (rel_bias[t5_bucket(tid) * HA + h] - rel_bias[31 * HA + h]) * LOG2E;
    QLOAD(cur.Q);
    SLOAD_H(cur.K, cur.V, 0); VMW(); SWRITE_HK(0);
    __syncthreads();
}
__device__ __forceinline__ void block(const BlockRef& cur, const BlockRef& nxt, char* lds, Seam& S, int wid) {
    int tid = wid * 64 + lane_id(); asm volatile("" : "+v"(tid));
    const int lane = tid & 63, r32 = lane & 31, hi = lane >> 5;
    const int NT = cur.P0 / KVBLK + 4;
    const int qlo = cur.P0 + wid * QBLK, qrow = qlo + r32, qm = qrow - 4 * hi;
    char* V_lds = lds; char* K_lds = lds + 2 * SHM_V;
    float* ws = (float*)(lds + LDS_WS) + wid * 64; float* li_l = ws, * al_l = ws + 32;
    const float* lut = (const float*)(lds + LDS_LUT);
    float m_reg = -1e30f, l_reg = 0; f32x16 o[4] = {};
    const int sr = tid >> 4, sc = (tid & 15) * 8, vst0 = v_st(sr, sc), vst1 = v_st(32 + sr, sc), kws = KSWZ(sr, sc * 2);
    const int vb0 = (int)(uintptr_t)V_lds + v_rd_base(lane);
    const bf16_t* Kh = cur.K; const bf16_t* Vh = cur.V;
    const unsigned soff = (unsigned)(sr * RS + sc) * 2u, qoff = (unsigned)((wid * QBLK + r32) * RS + hi * 8) * 2u, moff = (unsigned)(wid * QBLK + r32) * 8u;
#define RESC(a) do { if (__any((a) < 1.f)) { if (hi == 0) al_l[r32] = (a); asm volatile("s_waitcnt lgkmcnt(0)" ::: "memory");              \
                     for (int d_ = 0; d_ < 4; ++d_) for (int r = 0; r < 16; ++r) o[d_][r] *= al_l[crow(r, hi)]; } } while (0)
#define KBASE(t) ((t) * KVBLK)
#define MASKT(P0_, P1_, mw, t) do { const int kb_ = KBASE(t); if (kb_ + 176 > qlo) add_bias(P0_, P1_, lut, qm - kb_); apply_mask(P0_, P1_, mw, hi); } while (0)
#define SEAM_K0() do { VMWN(8); SWRITE_HK(0); SBAR(); } while (0)
    f32x16 pA0, pA1, pB0, pB1; float mnA, mnB, alA, alB; bf16x8 pa0, pa1, pa2, pa3; unsigned long long mwA, mwB;
    SWRITE_HV(0); SBAR();
    mwA = MLOAD(0);
    if (NT > 1) SLOAD_H(Kh, Vh, KBASE(1));
    SBAR(); qkt<0>(pA0, pA1, K_lds, r32, hi, S.qr);
    MASKT(pA0, pA1, mwA, 0); partialSM(pA0, pA1, m_reg, mnA, alA);
    if (NT > 1) { VMW(); SWRITE_H(1); }
    __syncthreads();
#define HALF_STEP(PX0, PX1, mnX, alX, mwX, PY0, PY1, alY, t, KB, VB, SB) do {                                                 \
        SBAR(); mwX = MLOAD(t); qkt<KB>(PX0, PX1, K_lds, r32, hi, S.qr);                                          \
        finishSM(PY0, PY1, alY, l_reg, pa0, pa1, pa2, pa3); SBAR();                                                           \
        if ((t) + 1 < NT) { SLOAD_H(Kh, Vh, KBASE((t) + 1)); SBAR(); }                                                        \
        pv_tile<VB>(o, vb0, pa0, pa1, pa2, pa3); MASKT(PX0, PX1, mwX, (t)); partialSM(PX0, PX1, m_reg, mnX, alX);             \
        __syncthreads();                                                                                                      \
        if ((t) + 1 < NT) { VMW(); SWRITE_H(SB); }                                                                            \
        RESC(alX); __syncthreads(); } while (0)
    for (int t = 1; t + 1 < NT; t += 2) {
        HALF_STEP(pB0, pB1, mnB, alB, mwB, pA0, pA1, alA, t, 1, 0, 0);
        HALF_STEP(pA0, pA1, mnA, alA, mwA, pB0, pB1, alB, t + 1, 0, 1, 1);
    }
    SBAR(); mwB = MLOAD(NT - 1); qkt<1>(pB0, pB1, K_lds, r32, hi, S.qr); SBAR();
    SLOAD_H(nxt.K, nxt.V, 0); SBAR();
    QLOAD(nxt.Q);
    SBAR();
    finishSM(pA0, pA1, alA, l_reg, pa0, pa1, pa2, pa3); SBAR();
    pv_tile<0>(o, vb0, pa0, pa1, pa2, pa3);
    MASKT(pB0, pB1, mwB, NT - 1); partialSM(pB0, pB1, m_reg, mnB, alB); __syncthreads(); RESC(alB);
    finishSM(pB0, pB1, alB, l_reg, pa0, pa1, pa2, pa3); SBAR(); pv_tile<1>(o, vb0, pa0, pa1, pa2, pa3);
    SBAR(); SEAM_K0();
    if (hi == 0) li_l[r32] = l_reg; asm volatile("s_waitcnt lgkmcnt(0)" ::: "memory");
    float rli[16];
#pragma unroll
    for (int r = 0; r < 16; ++r) rli[r] = __builtin_amdgcn_rcpf(li_l[crow(r, hi)]);
    { int l2 = lane_id(); asm volatile("" : "+v"(l2)); const int e32 = l2 & 31, ehi = (l2 >> 5) & 1;
      const char* Zw = (const char*)cur.Z + (size_t)(wid * QBLK) * (RS * 2); char* Ow = (char*)cur.O + (size_t)(wid * QBLK) * (OS * 2);
      const unsigned zo = (unsigned)(4 * ehi * RS + e32) * 2u, oo = (unsigned)(4 * ehi * OS + e32) * 2u;
#pragma unroll
      for (int r = 0; r < 16; ++r) { const int c = (r & 3) + 8 * (r >> 2);
#pragma unroll
        for (int d0 = 0; d0 < 4; ++d0) { float v = o[d0][r] * rli[r]; float vn = __builtin_bit_cast(float, __builtin_amdgcn_mov_dpp(__builtin_bit_cast(int, v), 0xB1, 0xF, 0xF, true));
            if ((e32 & 1) == 0) { const unsigned zz = *(const unsigned*)(Zw + zo + (c * RS + d0 * 32) * 2);
                v *= __uint_as_float(zz << 16); vn *= __uint_as_float(zz & 0xffff0000u);
                *(unsigned*)(Ow + oo + (c * OS + d0 * 32) * 2) = cvtpk(v, vn); } } } }
    __syncthreads();
#undef RESC
#undef KBASE
#undef MASKT
#undef SEAM_K0
#undef HALF_STEP
}
#undef ROW
#undef VMW
#undef VMWN
#undef SLOAD_H
#undef QLOAD
#undef MLOAD
#undef SWRITE_HK
#undef SWRITE_HV
#undef SWRITE_H
#undef KSWZ
#undef SBAR
}

namespace ml {
constexpr int RSK = 272, RSV = 80, RSS = 144;
typedef short v4i16 __attribute__((ext_vector_type(4)));
__device__ __forceinline__ v4i16 trd(const LAS unsigned char* p) { return __builtin_amdgcn_ds_read_tr16_b64_v4i16((LAS v4i16*)p); }
__device__ __forceinline__ bf16x8 frag_tr(const LAS unsigned char* img, int rs, int kbase, int col0, int lane) {
    const int i = lane & 15, q = i >> 2, p = i & 3, grp = lane >> 4;
    const LAS unsigned char* a = img + (kbase + 8 * grp + q) * rs + (col0 + 4 * p) * 2;
    const v4i16 lo = trd(a), hi = trd(a + 4 * rs);
    return (bf16x8){lo[0], lo[1], lo[2], lo[3], hi[0], hi[1], hi[2], hi[3]};
}
__device__ __forceinline__ float wave_incl_sum(float v, int lane) {
#pragma unroll
    for (int o = 1; o < 64; o <<= 1) { const float t = __shfl_up(v, o); if (lane >= o) v += t; }
    return v;
}
__device__ __forceinline__ float wave_incl_max(float v, int lane) {
#pragma unroll
    for (int o = 1; o < 64; o <<= 1) { const float t = __shfl_up(v, o); if (lane >= o) v = fmaxf(v, t); }
    return v;
}
__device__ __forceinline__ float wave_max(float v) {
#pragma unroll
    for (int o = 1; o < 64; o <<= 1) v = fmaxf(v, __shfl_xor(v, o));
    return v;
}
__device__ __forceinline__ void conv2(const u32x4 (&X)[5], const float (&cw)[4][8], const float (&cb)[8], float (&y0)[8], float (&y1)[8]) {
#pragma unroll
    for (int c = 0; c < 8; ++c) { float x[5];
#pragma unroll
        for (int j = 0; j < 5; ++j) { const unsigned w = X[j][c >> 1]; x[j] = __builtin_bit_cast(float, (c & 1) ? (w & 0xffff0000u) : (w << 16)); }
        float a0 = cb[c], a1 = cb[c];
#pragma unroll
        for (int j = 0; j < 4; ++j) { a0 = fmaf(cw[j][c], x[j], a0); a1 = fmaf(cw[j][c], x[j + 1], a1); }
        y0[c] = silu_f(a0); y1[c] = silu_f(a1); }
}
__device__ __forceinline__ u32x4 pack8f(const float (&y)[8]) { u32x4 w; w.x = pg8::cvt_pk_bf16(y[0], y[1]); w.y = pg8::cvt_pk_bf16(y[2], y[3]); w.z = pg8::cvt_pk_bf16(y[4], y[5]); w.w = pg8::cvt_pk_bf16(y[6], y[7]); return w; }
__device__ __forceinline__ void load5(u32x4 (&X)[5], const bf16_t* QKM, size_t rb, int t, int c) {
#pragma unroll
    for (int j = 0; j < 5; ++j) { const int tt = t - 3 + j; X[j] = tt >= 0 ? *(const u32x4*)(QKM + (rb + tt) * 1024 + c) : (u32x4){0u, 0u, 0u, 0u}; }
}

__device__ __forceinline__ void state_phase(unsigned char* ws, unsigned char* outb, LAS unsigned char* lds, int wave, int vcu) {
    const int lane = lane_id(), tid = wave * 64 + lane, fr = lane & 15, fq = lane >> 4;
    const int b = vcu >> 5, h = (vcu >> 3) & 3, vs = vcu & 7, bh = b * 4 + h;
    const size_t rb = (size_t)b * SEQ;
    const bf16_t* QKM = (const bf16_t*)(ws + WS_QKM); const bf16_t* VM = (const bf16_t*)(ws + WS_VM); const float* IFG = (const float*)(ws + WS_IFG);
    const float* par = (const float*)(ws + WS_PAR);
    bf16_t* CstT = (bf16_t*)outb; float* nst = (float*)(ws + WS_NST + 65536); float* mst = (float*)(ws + WS_NST);
    LAS float* AG = (LAS float*)lds; LAS float* BL = (LAS float*)(lds + 8192); LAS float* ML = BL + 32; LAS float* MM = BL + 64; LAS float* DEC = BL + 96;
    LAS unsigned char* Kimg = lds + 16384; LAS unsigned char* Vimg = lds + 16384 + 64 * RSK;
    const float bi = par[P_BI + h], bfg = par[P_BF + h];
#pragma unroll 1
    for (int j = 0; j < 4; ++j) { const int k = wave + 8 * j; const float* g = IFG + (rb + 64 * k + lane) * 8;
        const float lf = log_sigmoid_f(g[4 + h] + bfg), ii = g[h] + bi;
        const float bcs = wave_incl_sum(lf, lane), bL = __shfl(bcs, 63), a = bL - bcs + ii, mloc = wave_max(a);
        AG[k * 64 + lane] = a; if (lane == 0) { BL[k] = bL; ML[k] = mloc; } }
    __syncthreads();
    if (tid == 0) { float m = 0.f; if (vs == 0) mst[bh * 32] = 0.f;
        for (int k = 0; k < 32; ++k) { const float mn = fmaxf(BL[k] + m, ML[k]); DEC[k] = __expf(BL[k] + m - mn); MM[k] = mn; m = mn; if (vs == 0 && k < 31) mst[bh * 32 + k + 1] = mn; } }
    __syncthreads();
    for (int i = tid; i < 2048; i += 512) AG[i] = __expf(AG[i] - MM[i >> 6]);
    { bf16_t* c0 = CstT + ((size_t)(bh * 32) * 256 + vs * 32) * 128; *(u32x4*)(c0 + tid * 8) = (u32x4){0u, 0u, 0u, 0u};
      if (vs == 0 && tid < 128) nst[(size_t)(bh * 32) * 128 + tid] = 0.f; }
    __syncthreads();
    const int dg = tid & 15, lg = tid >> 4, ck = 512 + h * 128 + 8 * dg;
    float cw[4][8], cb[8];
#pragma unroll
    for (int c = 0; c < 8; ++c) { cb[c] = par[P_CB + ck + c];
#pragma unroll
        for (int j = 0; j < 4; ++j) cw[j][c] = par[P_CW + j * 1024 + ck + c]; }
    f32x4 acc[2] = {{0.f, 0.f, 0.f, 0.f}, {0.f, 0.f, 0.f, 0.f}}, accn = {0.f, 0.f, 0.f, 0.f};
    const bf16x8 ones = {0x3F80, 0x3F80, 0x3F80, 0x3F80, 0x3F80, 0x3F80, 0x3F80, 0x3F80};
    u32x4 X[5], Vr;
    load5(X, QKM, rb, 2 * lg, ck);
    Vr = tid < 256 ? *(const u32x4*)(VM + (rb + (tid >> 2)) * 1024 + h * 256 + vs * 32 + (tid & 3) * 8) : (u32x4){0u, 0u, 0u, 0u};
#pragma unroll 1
    for (int k = 0; k < 31; ++k) {
        const int t0 = 64 * k;
        { float y0[8], y1[8]; conv2(X, cw, cb, y0, y1);
          const float w0 = AG[k * 64 + 2 * lg] * 0.08838834764831845f, w1 = AG[k * 64 + 2 * lg + 1] * 0.08838834764831845f;
#pragma unroll
          for (int c = 0; c < 8; ++c) { y0[c] *= w0; y1[c] *= w1; }
          *(LAS u32x4*)(Kimg + (2 * lg) * RSK + dg * 16) = pack8f(y0); *(LAS u32x4*)(Kimg + (2 * lg + 1) * RSK + dg * 16) = pack8f(y1);
          if (tid < 256) *(LAS u32x4*)(Vimg + (tid >> 2) * RSV + (tid & 3) * 16) = Vr; }
        __syncthreads();
        if (k + 1 < 31) { load5(X, QKM, rb, t0 + 64 + 2 * lg, ck);
            if (tid < 256) Vr = *(const u32x4*)(VM + (rb + t0 + 64 + (tid >> 2)) * 1024 + h * 256 + vs * 32 + (tid & 3) * 8); }
        const float dec = DEC[k];
        acc[0] = acc[0] * dec; acc[1] = acc[1] * dec; accn = accn * dec;
#pragma unroll
        for (int ks = 0; ks < 2; ++ks) { const bf16x8 ak = frag_tr(Kimg, RSK, 32 * ks, 16 * wave, lane);
            const bf16x8 v0 = frag_tr(Vimg, RSV, 32 * ks, 0, lane), v1 = frag_tr(Vimg, RSV, 32 * ks, 16, lane);
            acc[0] = __builtin_amdgcn_mfma_f32_16x16x32_bf16(ak, v0, acc[0], 0, 0, 0);
            acc[1] = __builtin_amdgcn_mfma_f32_16x16x32_bf16(ak, v1, acc[1], 0, 0, 0);
            accn = __builtin_amdgcn_mfma_f32_16x16x32_bf16(ak, ones, accn, 0, 0, 0); }
        { bf16_t* cst = CstT + ((size_t)(bh * 32 + k + 1) * 256 + vs * 32) * 128;
#pragma unroll
          for (int vt = 0; vt < 2; ++vt) { u32x2 w; w.x = pg8::cvt_pk_bf16(acc[vt][0], acc[vt][1]); w.y = pg8::cvt_pk_bf16(acc[vt][2], acc[vt][3]);
              *(u32x2*)(cst + (size_t)(16 * vt + fr) * 128 + 16 * wave + 4 * fq) = w; }
          if (vs == 0 && fr == 0) *(f32x4*)(nst + (size_t)(bh * 32 + k + 1) * 128 + 16 * wave + 4 * fq) = accn; }
        __syncthreads();
    }
}

__device__ __forceinline__ void out_unit(unsigned char* ws, unsigned char* outb, LAS unsigned char* lds, int wave, int b, int h, int k) {
    const int lane = lane_id(), tid = wave * 64 + lane, fr = lane & 15, fq = lane >> 4;
    const int bh = b * 4 + h, t0 = 64 * k; const size_t rb = (size_t)b * SEQ;
    const bf16_t* QKM = (const bf16_t*)(ws + WS_QKM); const bf16_t* VM = (const bf16_t*)(ws + WS_VM); const bf16_t* GM = (const bf16_t*)(ws + WS_GM); const float* IFG = (const float*)(ws + WS_IFG);
    const float* par = (const float*)(ws + WS_PAR);
    const bf16_t* CstT = (const bf16_t*)outb + (size_t)(bh * 32 + k) * 256 * 128; const float* nst = (const float*)(ws + WS_NST + 65536) + (size_t)(bh * 32 + k) * 128; const float* mst = (const float*)(ws + WS_NST);
    bf16_t* Y = (bf16_t*)(ws + WS_Y);
    LAS unsigned char* Qimg = lds; LAS unsigned char* Qs = lds + 64 * RSK; LAS unsigned char* Kimg = lds + 2 * 64 * RSK; LAS unsigned char* Simg = lds + 3 * 64 * RSK;
    LAS unsigned char* Vw = lds + 3 * 64 * RSK + 64 * RSS + wave * (64 * RSV);
    LAS float* SC = (LAS float*)(lds + 3 * 64 * RSK + 64 * RSS + 8 * 64 * RSV);
    LAS float* PART = SC + 256;
    float inter;
    { const float* g = IFG + (rb + t0 + lane) * 8;
      const float lf = log_sigmoid_f(g[4 + h] + par[P_BF + h]), ii = g[h] + par[P_BI + h];
      const float bcs = wave_incl_sum(lf, lane), u = ii - bcs, pm = wave_incl_max(u, lane), mp = mst[bh * 32 + k];
      const float gl = bcs + mp, mt = fmaxf(bcs + pm, gl);
      inter = __expf(gl - mt);
      if (wave == 0) { SC[lane] = bcs - mt; SC[64 + lane] = u; SC[128 + lane] = __expf(-mt); } }
    { const int dg = tid & 15, lg = tid >> 4, r0 = 2 * lg;
      const float in0 = __shfl(inter, r0), in1 = __shfl(inter, r0 + 1);
#pragma unroll 1
      for (int isk = 0; isk < 2; ++isk) { const int cc = (isk ? 512 : 0) + h * 128 + 8 * dg;
          float cw[4][8], cb[8];
#pragma unroll
          for (int c = 0; c < 8; ++c) { cb[c] = par[P_CB + cc + c];
#pragma unroll
              for (int j = 0; j < 4; ++j) cw[j][c] = par[P_CW + j * 1024 + cc + c]; }
          u32x4 X[5]; load5(X, QKM, rb, t0 + r0, cc);
          float y0[8], y1[8]; conv2(X, cw, cb, y0, y1);
          if (isk) {
#pragma unroll
              for (int c = 0; c < 8; ++c) { y0[c] *= 0.08838834764831845f; y1[c] *= 0.08838834764831845f; }
              *(LAS u32x4*)(Kimg + r0 * RSK + dg * 16) = pack8f(y0); *(LAS u32x4*)(Kimg + (r0 + 1) * RSK + dg * 16) = pack8f(y1);
          } else {
              *(LAS u32x4*)(Qimg + r0 * RSK + dg * 16) = pack8f(y0); *(LAS u32x4*)(Qimg + (r0 + 1) * RSK + dg * 16) = pack8f(y1);
#pragma unroll
              for (int c = 0; c < 8; ++c) { y0[c] *= in0; y1[c] *= in1; }
              *(LAS u32x4*)(Qs + r0 * RSK + dg * 16) = pack8f(y0); *(LAS u32x4*)(Qs + (r0 + 1) * RSK + dg * 16) = pack8f(y1);
          } }
#pragma unroll
      for (int i = 0; i < 4; ++i) { const int l = 16 * i + (lane >> 2), pc = lane & 3;
          *(LAS u32x4*)(Vw + l * RSV + pc * 16) = *(const u32x4*)(VM + (rb + t0 + l) * 1024 + h * 256 + 32 * wave + pc * 8); } }
    __syncthreads();
    { const int lt = wave >> 1; const float rt = SC[16 * lt + fr];
#pragma unroll
      for (int si = 0; si < 2; ++si) { const int st = 2 * (wave & 1) + si; u32x2 w = {0u, 0u};
          if (st <= lt) { f32x4 sacc = {0.f, 0.f, 0.f, 0.f};
#pragma unroll
              for (int ks = 0; ks < 4; ++ks) { const bf16x8 kf = *(const LAS bf16x8*)(Kimg + (16 * st + fr) * RSK + (32 * ks + 8 * fq) * 2), qf = *(const LAS bf16x8*)(Qimg + (16 * lt + fr) * RSK + (32 * ks + 8 * fq) * 2);
                  sacc = __builtin_amdgcn_mfma_f32_16x16x32_bf16(kf, qf, sacc, 0, 0, 0); }
              const int l = 16 * lt + fr; float e[4];
#pragma unroll
              for (int j = 0; j < 4; ++j) { const int sidx = 16 * st + 4 * fq + j; e[j] = sidx <= l ? sacc[j] * __expf(rt + SC[64 + sidx]) : 0.f; }
              w.x = pg8::cvt_pk_bf16(e[0], e[1]); w.y = pg8::cvt_pk_bf16(e[2], e[3]); }
          *(LAS u32x2*)(Simg + (16 * lt + fr) * RSS + (16 * st + 4 * fq) * 2) = w; } }
    __syncthreads();
    const bf16x8 ones = {0x3F80, 0x3F80, 0x3F80, 0x3F80, 0x3F80, 0x3F80, 0x3F80, 0x3F80};
    if (wave < 4) { f32x4 dacc = {0.f, 0.f, 0.f, 0.f};
#pragma unroll
        for (int ks = 0; ks < 2; ++ks) { const bf16x8 sf = *(const LAS bf16x8*)(Simg + (16 * wave + fr) * RSS + (32 * ks + 8 * fq) * 2); dacc = __builtin_amdgcn_mfma_f32_16x16x32_bf16(ones, sf, dacc, 0, 0, 0); }
#pragma unroll
        for (int ks = 0; ks < 4; ++ks) { const f32x4 n0 = *(const f32x4*)(nst + 32 * ks + 8 * fq), n1 = *(const f32x4*)(nst + 32 * ks + 8 * fq + 4);
            u32x4 nw; nw.x = pg8::cvt_pk_bf16(n0[0], n0[1]); nw.y = pg8::cvt_pk_bf16(n0[2], n0[3]); nw.z = pg8::cvt_pk_bf16(n1[0], n1[1]); nw.w = pg8::cvt_pk_bf16(n1[2], n1[3]);
            const bf16x8 qf = *(const LAS bf16x8*)(Qs + (16 * wave + fr) * RSK + (32 * ks + 8 * fq) * 2);
            dacc = __builtin_amdgcn_mfma_f32_16x16x32_bf16(__builtin_bit_cast(bf16x8, nw), qf, dacc, 0, 0, 0); }
        if (fq == 0) SC[192 + 16 * wave + fr] = dacc[0]; }
    f32x4 acc[4][2];
#pragma unroll
    for (int lt = 0; lt < 4; ++lt) { acc[lt][0] = (f32x4){0.f, 0.f, 0.f, 0.f}; acc[lt][1] = (f32x4){0.f, 0.f, 0.f, 0.f}; }
#pragma unroll
    for (int ks = 0; ks < 2; ++ks) { const bf16x8 v0 = frag_tr(Vw, RSV, 32 * ks, 0, lane), v1 = frag_tr(Vw, RSV, 32 * ks, 16, lane);
#pragma unroll
        for (int lt = 0; lt < 4; ++lt) { const bf16x8 sf = *(const LAS bf16x8*)(Simg + (16 * lt + fr) * RSS + (32 * ks + 8 * fq) * 2);
            acc[lt][0] = __builtin_amdgcn_mfma_f32_16x16x32_bf16(v0, sf, acc[lt][0], 0, 0, 0); acc[lt][1] = __builtin_amdgcn_mfma_f32_16x16x32_bf16(v1, sf, acc[lt][1], 0, 0, 0); } }
#pragma unroll
    for (int ks = 0; ks < 4; ++ks) { const bf16x8 c0 = *(const bf16x8*)(CstT + (size_t)(32 * wave + fr) * 128 + 32 * ks + 8 * fq), c1 = *(const bf16x8*)(CstT + (size_t)(32 * wave + 16 + fr) * 128 + 32 * ks + 8 * fq);
#pragma unroll
        for (int lt = 0; lt < 4; ++lt) { const bf16x8 qf = *(const LAS bf16x8*)(Qs + (16 * lt + fr) * RSK + (32 * ks + 8 * fq) * 2);
            acc[lt][0] = __builtin_amdgcn_mfma_f32_16x16x32_bf16(c0, qf, acc[lt][0], 0, 0, 0); acc[lt][1] = __builtin_amdgcn_mfma_f32_16x16x32_bf16(c1, qf, acc[lt][1], 0, 0, 0); } }
    __syncthreads();
#pragma unroll
    for (int lt = 0; lt < 4; ++lt) { const int l = 16 * lt + fr; const float sc = 1.f / fmaxf(fabsf(SC[192 + l]), SC[128 + l]);
        acc[lt][0] = acc[lt][0] * sc; acc[lt][1] = acc[lt][1] * sc;
        float s1 = 0.f, s2 = 0.f;
#pragma unroll
        for (int vt = 0; vt < 2; ++vt)
#pragma unroll
            for (int j = 0; j < 4; ++j) { const float x = acc[lt][vt][j]; s1 += x; s2 = fmaf(x, x, s2); }
        s1 += __shfl_xor(s1, 16); s1 += __shfl_xor(s1, 32); s2 += __shfl_xor(s2, 16); s2 += __shfl_xor(s2, 32);
        if (fq == 0) { PART[(l * 8 + wave) * 2] = s1; PART[(l * 8 + wave) * 2 + 1] = s2; } }
    __syncthreads();
#pragma unroll
    for (int lt = 0; lt < 4; ++lt) { const int l = 16 * lt + fr; float s1 = 0.f, s2 = 0.f;
#pragma unroll
        for (int w = 0; w < 8; ++w) { s1 += PART[(l * 8 + w) * 2]; s2 += PART[(l * 8 + w) * 2 + 1]; }
        const float mu = s1 * (1.f / DVM), var = fmaxf(s2 * (1.f / DVM) - mu * mu, 0.f), rstd = rsqrtf(var + LN_EPS);
#pragma unroll
        for (int vt = 0; vt < 2; ++vt) { const int c = h * 256 + 32 * wave + 16 * vt + 4 * fq; const size_t row = rb + t0 + l;
            const f32x4 gg = *(const f32x4*)(par + P_MHG + c); const u32x2 gm = *(const u32x2*)(GM + row * 1024 + c);
            const float g0 = __builtin_bit_cast(float, gm.x << 16), g1 = __builtin_bit_cast(float, gm.x & 0xffff0000u), g2 = __builtin_bit_cast(float, gm.y << 16), g3 = __builtin_bit_cast(float, gm.y & 0xffff0000u);
            const f32x4 x = acc[lt][vt];
            u32x2 w; w.x = pg8::cvt_pk_bf16((x[0] - mu) * rstd * gg[0] * g0, (x[1] - mu) * rstd * gg[1] * g1); w.y = pg8::cvt_pk_bf16((x[2] - mu) * rstd * gg[2] * g2, (x[3] - mu) * rstd * gg[3] * g3);
            *(u32x2*)(Y + row * 2048 + 1024 + c) = w; } }
    __syncthreads();
}
}

constexpr int NWAVES = 8, NTHREADS = 512;

constexpr int LDS_BYTES = 147456;
constexpr int MISC_OFF = 131072 + 8192;
constexpr int CW_BAR = 4096;
struct Args {
    const float* in[16]; float* out; unsigned char* ws; int ph_lo, ph_hi, li, pad;
};

template <class SrcMap>
__device__ __forceinline__ void p0_transpose_item(const float* W, int K, int Nsrc, int nblk, bf16_t* WT, int row_off, int item, int lane, SrcMap smap) {
    const int kb = item / nblk, nb = item % nblk, n = 64 * nb + 4 * (lane & 15), k = 32 * kb + 8 * (lane >> 4);
    const int src = smap(n);
    f32x4 v[8];
#pragma unroll
    for (int i = 0; i < 8; ++i) v[i] = src >= 0 ? *(const f32x4*)(W + (size_t)(k + i) * Nsrc + src) : (f32x4){0.f, 0.f, 0.f, 0.f};
#pragma unroll
    for (int j = 0; j < 4; ++j) { u32x4 o; o.x = pg8::cvt_pk_bf16(v[0][j], v[1][j]); o.y = pg8::cvt_pk_bf16(v[2][j], v[3][j]); o.z = pg8::cvt_pk_bf16(v[4][j], v[5][j]); o.w = pg8::cvt_pk_bf16(v[6][j], v[7][j]);
        *(u32x4*)(WT + (size_t)(row_off + n + j) * K + k) = o; }
}
struct MapIdent { __device__ __forceinline__ int operator()(int n) const { return n; } };
struct MapWin { __device__ __forceinline__ int operator()(int n) const { return win_src(n); } };

__global__ void __launch_bounds__(NTHREADS, 2) skel_fwd(Args args) {
    extern __shared__ __attribute__((aligned(16))) unsigned char lds_raw[];
    LAS unsigned char* lds = (LAS unsigned char*)lds_raw;
#define FRESH_TID() ({ int t_ = wave * 64 + lane_id(); asm volatile("" : "+v"(t_)); t_; })
    const int wave = __builtin_amdgcn_readfirstlane(threadIdx.x >> 6);
    const int G = gridDim.x, bx = blockIdx.x;
    const int vcu = (G % 8 == 0) ? (bx % 8) * (G / 8) + bx / 8 : bx;
    unsigned char* ws = args.ws;
    const int lo = args.ph_lo, hi = args.ph_hi;
#define IN(k) (lo <= (k) && (k) < hi)
#define BOTH(k) (IN(k) && IN((k) + 1))
    volatile LAS unsigned* MISC = (volatile LAS unsigned*)(lds + MISC_OFF);
    if (threadIdx.x < 32) MISC[threadIdx.x] = 0u;
    __syncthreads();
    XcdBarrier bar = xcd_barrier_post((unsigned*)(ws + WS_CTL) + CW_BAR + args.li * XCD_BAR_WORDS, MISC + 8);
#define GRID_BAR() xcd_barrier(bar, wave)
#define XB ((bf16_t*)(ws + WS_XB))
#define WINT ((bf16_t*)(ws + WS_WINT))
#define WOUTT ((bf16_t*)(ws + WS_WOUTT))
#define WKVT ((bf16_t*)(ws + WS_WKVT))
#define PARF ((float*)(ws + WS_PAR))

    if (IN(0)) {
      _Pragma("unroll 1") for (int rep = 0; rep < REP(0); ++rep) {
        const int tid = FRESH_TID(), lane = tid & 63;
        const int gw = vcu * NWAVES + wave, NGW = G * NWAVES;
        const float* x = args.in[0];
        for (int it = gw; it < M * DM / 2048; it += NGW) {
            const float* xp = x + (size_t)it * 2048 + lane * 8; bf16_t* op = XB + (size_t)it * 2048 + lane * 8;
            f32x4 a[4][2];
#pragma unroll
            for (int j = 0; j < 4; ++j) { a[j][0] = *(const f32x4*)(xp + j * 512); a[j][1] = *(const f32x4*)(xp + j * 512 + 4); }
#pragma unroll
            for (int j = 0; j < 4; ++j) { u32x4 o; o.x = pg8::cvt_pk_bf16(a[j][0][0], a[j][0][1]); o.y = pg8::cvt_pk_bf16(a[j][0][2], a[j][0][3]); o.z = pg8::cvt_pk_bf16(a[j][1][0], a[j][1][1]); o.w = pg8::cvt_pk_bf16(a[j][1][2], a[j][1][3]);
                *(u32x4*)(op + j * 512) = o; }
        }
        constexpr int I_IN = (DM / 32) * (NP / 64), I_OUT = (DM / 32) * (DM / 64), I_UV = (DC / 32) * (DHA / 64);
        for (int it = gw; it < I_IN + I_OUT + HA * I_UV; it += NGW) {
            int r = it;
            if (r < I_IN) { p0_transpose_item(args.in[1], DM, NCOLS, NP / 64, WINT, 0, r, lane, MapWin()); continue; } r -= I_IN;
            if (r < I_OUT) { p0_transpose_item(args.in[13], DM, DM, DM / 64, WOUTT, 0, r, lane, MapIdent()); continue; } r -= I_OUT;
            { const int h = r / I_UV; p0_transpose_item(args.in[6] + (size_t)h * DC * DHA, DC, DHA, DHA / 64, WKVT, 1024 + h * DHA, r % I_UV, lane, MapIdent()); }
        }
        {
            const int gt = vcu * NTHREADS + tid, NGT = G * NTHREADS;
            for (int i = gt; i < P_TOTAL; i += NGT) { float v = 0.f;
                if (i < P_LNG) v = args.in[4][i - P_KVG]; else if (i < P_LNB) v = args.in[7][i - P_LNG]; else if (i < P_RB) v = args.in[8][i - P_LNB];
                else if (i < P_CW) v = args.in[9][i - P_RB]; else if (i < P_CB) v = args.in[10][i - P_CW]; else if (i < P_MHG) v = args.in[11][i - P_CB];
                else if (i < P_BI) v = args.in[12][i - P_MHG]; else if (i < P_BI + 4) v = args.in[2][i - P_BI]; else if (i < P_BF + 4) v = args.in[3][i - P_BF];
                else if (i >= P_LG && i < P_LB) v = args.in[14][i - P_LG]; else if (i >= P_LB) v = args.in[15][i - P_LB];
                PARF[i] = v; }
        }
        const float* wuk = args.in[5];
        for (int it = gw; it < 1024 * 256 / 512; it += NGW) {
            const f32x4 a = *(const f32x4*)(wuk + (size_t)it * 512 + lane * 8), b = *(const f32x4*)(wuk + (size_t)it * 512 + lane * 8 + 4);
            u32x4 o; o.x = pg8::cvt_pk_bf16(a[0], a[1]); o.y = pg8::cvt_pk_bf16(a[2], a[3]); o.z = pg8::cvt_pk_bf16(b[0], b[1]); o.w = pg8::cvt_pk_bf16(b[2], b[3]);
            *(u32x4*)(WKVT + (size_t)it * 512 + lane * 8) = o;
        }
        __syncthreads();
      }
        if (BOTH(0)) GRID_BAR();
    }
    if (IN(1)) {
        pg8::Gemm g{XB, WINT, M, NP, DM}; pg8::StaticOrder S; S.init(M, NP, G, bx);
        Epi1 E{ws};
        _Pragma("unroll 1") for (int rep = 0; rep < REP(1); ++rep) pg8::gemm_phase<Epi1, pg8::StaticOrder>(lds, g, S, E, wave);
        if (BOTH(1)) GRID_BAR();
    }
    if (IN(2)) {
        {
            const int lane = FRESH_TID() & 63, b = vcu >> 5, j = vcu & 31;
#pragma unroll 1
            for (int u = 0; u < 4 * REP(2); ++u) { const int gi = (u & 1) ? ((u & 2) ? j : 64 + j) : ((u & 2) ? 63 - j : 127 - j);
                topk_unit((const bf16_t*)(ws + WS_QI), (const bf16_t*)(ws + WS_KI), (const float*)(ws + WS_WI), (unsigned long long*)(ws + WS_MASK), b, gi, wave, lane, (LAS unsigned long long*)(lds + 131072 + 4096 + wave * 256), lds); }
        }
        pg8::Gemm g{(bf16_t*)(ws + WS_C), WKVT, M, 2048, DC}; pg8::StaticOrder S; S.init(M, 2048, G, bx);
        EpiKV E{(bf16_t*)((unsigned char*)args.out + OUT_K), (bf16_t*)((unsigned char*)args.out + OUT_V)};
        _Pragma("unroll 1") for (int rep = 0; rep < REP(3); ++rep) pg8::gemm_phase<EpiKV, pg8::StaticOrder>(lds, g, S, E, wave);
        _Pragma("unroll 1") for (int rep = 0; rep < REP(4); ++rep) ml::state_phase(ws, (unsigned char*)args.out, lds, wave, vcu);
        if (BOTH(2)) GRID_BAR();
    }
    if (IN(3)) {
        const int b = vcu >> 5, h = (vcu >> 2) & 7, x = vcu & 3;
        const bf16_t* Qh = (const bf16_t*)(ws + WS_Q) + (size_t)b * SEQ * 1024 + h * DHA;
        const bf16_t* Kh = (const bf16_t*)((unsigned char*)args.out + OUT_K) + (size_t)b * SEQ * 1024 + h * DHA;
        const bf16_t* Vh = (const bf16_t*)((unsigned char*)args.out + OUT_V) + (size_t)b * SEQ * 1024 + h * DHA;
        bf16_t* Yh = (bf16_t*)(ws + WS_Y) + (size_t)b * SEQ * 2048 + h * DHA;
        const bf16_t* Zh = (const bf16_t*)(ws + WS_SZA) + (size_t)b * SEQ * 1024 + h * DHA;
        const unsigned long long* MKb = (const unsigned long long*)(ws + WS_MASK) + (size_t)b * 32 * SEQ;
        const int q0 = x * 256, q1 = (7 - x) * 256;
        att::BlockRef r0{Qh + (size_t)q0 * 1024, Kh, Vh, Yh + (size_t)q0 * 2048, Zh + (size_t)q0 * 1024, MKb + q0, q0};
        att::BlockRef r1{Qh + (size_t)q1 * 1024, Kh, Vh, Yh + (size_t)q1 * 2048, Zh + (size_t)q1 * 1024, MKb + q1, q1};
        att::Seam S;
      _Pragma("unroll 1") for (int rep = 0; rep < REP(5); ++rep) {
        att::prime(r0, (char*)lds_raw, S, PARF + P_RB, h, wave);
#pragma unroll 1
        for (int pass = 0; pass < 2; ++pass) { const att::BlockRef cur = pass ? r1 : r0; att::block(cur, r1, (char*)lds_raw, S, wave); }
      }
#pragma unroll 1
        for (int i = 0; i < 4 * REP(6); ++i) { const int u = vcu * 4 + (i & 3); ml::out_unit(ws, (unsigned char*)args.out, lds, wave, u >> 7, (u >> 5) & 3, u & 31); }
        if (BOTH(3)) GRID_BAR();
    }
    if (IN(4)) {
        pg8::Gemm g{(bf16_t*)(ws + WS_Y), WOUTT, M, DM, DM}; pg8::StaticOrder S; S.init(M, DM, G, bx);
        EpiOut E{args.in[0], args.out};
        _Pragma("unroll 1") for (int rep = 0; rep < REP(7); ++rep) pg8::gemm_phase<EpiOut, pg8::StaticOrder>(lds, g, S, E, wave);
        if (BOTH(4)) GRID_BAR();
    }
    if (IN(5)) {
        const int lane = FRESH_TID() & 63;
        const int gw = vcu * NWAVES + wave, NGW = G * NWAVES;
        const float* lg = PARF + P_LG; const float* lb = PARF + P_LB;
        for (int r = gw; r < M; r += NGW) {
            f32x4* p = (f32x4*)(args.out + (size_t)r * DM) + lane;
            f32x4 v[8]; float s = 0.f;
#pragma unroll
            for (int j = 0; j < 8; ++j) { v[j] = p[64 * j]; s += (v[j][0] + v[j][1]) + (v[j][2] + v[j][3]); }
#pragma unroll
            for (int o = 1; o < 64; o <<= 1) s += __shfl_xor(s, o);
            const float mu = s * (1.f / DM); float q = 0.f;
#pragma unroll
            for (int j = 0; j < 8; ++j) { v[j] = v[j] - mu; q += (v[j][0] * v[j][0] + v[j][1] * v[j][1]) + (v[j][2] * v[j][2] + v[j][3] * v[j][3]); }
#pragma unroll
            for (int o = 1; o < 64; o <<= 1) q += __shfl_xor(q, o);
            const float rstd = rsqrtf(q * (1.f / DM) + LN_EPS);
#pragma unroll
            for (int j = 0; j < 8; ++j) { const f32x4 gg = *((const f32x4*)lg + lane + 64 * j), bb = *((const f32x4*)lb + lane + 64 * j); p[64 * j] = v[j] * rstd * gg + bb; }
        }
    }
#undef IN
#undef BOTH
}


__global__ void __launch_bounds__(256) naive_topk(const bf16_t* __restrict__ QI, const bf16_t* __restrict__ KI, const float* __restrict__ WI, unsigned long long* __restrict__ mask) {
    __shared__ float qi[HIDX * DIDX]; __shared__ float w[HIDX]; __shared__ unsigned keys[SEQ]; __shared__ unsigned cnt; __shared__ unsigned Tsh;
    const int row = blockIdx.x, b = row / SEQ, t = row % SEQ, tid = threadIdx.x;
    for (int i = tid; i < HIDX * DIDX; i += 256) qi[i] = bf2f(QI[(size_t)row * 1024 + i]);
    if (tid < HIDX) w[tid] = WI[(size_t)row * 16 + tid];
    __syncthreads();
    for (int s = tid; s < SEQ; s += 256) {
        unsigned key = 0u;
        if (s <= t) {
            const bf16_t* kr = KI + ((size_t)b * SEQ + s) * DIDX; float kf[DIDX];
#pragma unroll
            for (int d = 0; d < DIDX; ++d) kf[d] = bf2f(kr[d]);
            float sc = 0.f;
            for (int h = 0; h < HIDX; ++h) { float a = 0.f;
#pragma unroll
                for (int d = 0; d < DIDX; ++d) a = fmaf(qi[h * DIDX + d], kf[d], a);
                sc = fmaf(fmaxf(a, 0.f), w[h], sc); }
            key = mono_key(sc);
        }
        keys[s] = key;
    }
    __syncthreads();
    if (t >= NSEL) {
        unsigned T = 0u;
        for (int bit = 31; bit >= 0; --bit) {
            const unsigned cand = T | (1u << bit);
            if (tid == 0) cnt = 0u;
            __syncthreads();
            unsigned c = 0u;
            for (int s = tid; s < SEQ; s += 256) c += keys[s] >= cand ? 1u : 0u;
            atomicAdd(&cnt, c);
            __syncthreads();
            if (cnt >= (unsigned)NSEL) T = cand;
            __syncthreads();
        }
        if (tid == 0) {
            unsigned gt = 0u; for (int s = 0; s < SEQ; ++s) gt += keys[s] > T ? 1u : 0u;
            unsigned need = NSEL - gt;
            for (int s = 0; s < SEQ; ++s) if (keys[s] == T) { if (need > 0u) --need; else keys[s] = 0u; }
            Tsh = T;
        }
        __syncthreads();
    } else { if (tid == 0) Tsh = 1u; __syncthreads(); }
    if (tid < 32) {
        const unsigned T = Tsh; unsigned long long wv = 0ull;
        for (int l = 0; l < 64; ++l) if (keys[tid * 64 + l] >= T) wv |= 1ull << l;
        mask[((size_t)b * 32 + tid) * SEQ + t] = wv;
    }
}

__global__ void __launch_bounds__(256) naive_attn(const bf16_t* __restrict__ Qb, const bf16_t* __restrict__ Kb, const bf16_t* __restrict__ Vb, const bf16_t* __restrict__ SZA,
                                                  const unsigned long long* __restrict__ mask, const float* __restrict__ rel_bias, bf16_t* __restrict__ Y) {
    __shared__ int sel[NSEL]; __shared__ int nsel_s; __shared__ float q[1024]; __shared__ float p[NSEL]; __shared__ float red[8]; __shared__ int pre[33];
    const int row = blockIdx.x, b = row / SEQ, t = row % SEQ, tid = threadIdx.x;
    for (int i = tid; i < 1024; i += 256) q[i] = bf2f(Qb[(size_t)row * 1024 + i]);
    if (tid == 0) { int a = 0; for (int g = 0; g < 32; ++g) { pre[g] = a; a += __popcll(mask[((size_t)b * 32 + g) * SEQ + t]); } pre[32] = a; nsel_s = a; }
    __syncthreads();
    if (tid < 32) { unsigned long long wv = mask[((size_t)b * 32 + tid) * SEQ + t]; int o = pre[tid]; while (wv) { const int l = __ffsll((long long)wv) - 1; wv &= wv - 1; if (o < NSEL) sel[o] = tid * 64 + l; ++o; } }
    __syncthreads();
    const int nsel = nsel_s < NSEL ? nsel_s : NSEL;
    for (int h = 0; h < HA; ++h) {
        float lg = -1e30f;
        if (tid < nsel) { const int s = sel[tid]; const bf16_t* kr = Kb + ((size_t)b * SEQ + s) * 1024 + h * DHA; float a = 0.f;
            for (int d = 0; d < DHA; ++d) a = fmaf(q[h * DHA + d], bf2f(kr[d]), a);
            lg = (t - s >= 0) ? a + rel_bias[t5_bucket(t - s) * HA + h] * LOG2E : -1e30f; }
        float mx = lg;
        for (int o = 1; o < 64; o <<= 1) mx = fmaxf(mx, __shfl_xor(mx, o));
        if ((tid & 63) == 0) red[tid >> 6] = mx;
        __syncthreads();
        mx = fmaxf(fmaxf(red[0], red[1]), fmaxf(red[2], red[3]));
        const float pe = tid < nsel ? exp2f(lg - mx) : 0.f;
        p[tid] = pe;
        float sm = pe;
        for (int o = 1; o < 64; o <<= 1) sm += __shfl_xor(sm, o);
        if ((tid & 63) == 0) red[4 + (tid >> 6)] = sm;
        __syncthreads();
        const float l = (red[4] + red[5]) + (red[6] + red[7]);
        if (tid < DHA) { float o = 0.f;
            for (int j = 0; j < nsel; ++j) o = fmaf(p[j], bf2f(Vb[((size_t)b * SEQ + sel[j]) * 1024 + h * DHA + tid]), o);
            const float y = o / l * bf2f(SZA[(size_t)row * 1024 + h * DHA + tid]);
            Y[(size_t)row * 2048 + h * DHA + tid] = (bf16_t)f2bf(y); }
        __syncthreads();
    }
}

__global__ void __launch_bounds__(512) naive_mlstm(const bf16_t* __restrict__ QKM, const bf16_t* __restrict__ VM, const bf16_t* __restrict__ GM, const float* __restrict__ IFG,
                                                   const float* __restrict__ conv_w, const float* __restrict__ conv_b, const float* __restrict__ b_i, const float* __restrict__ b_f,
                                                   const float* __restrict__ mhg, float* __restrict__ Cst, float* __restrict__ hbuf, bf16_t* __restrict__ Y) {
    extern __shared__ float dsm[]; float* qs = dsm; float* ks = dsm + CHUNK * DKM; float* Ss = dsm + 2 * CHUNK * DKM;
    __shared__ float bcs[CHUNK], ii[CHUNK], mt[CHUNK], inter[CHUNK], den[CHUNK], wgt[CHUNK], nvec[DKM], qn[CHUNK]; __shared__ float m_s, decay_s;
    const int bh = blockIdx.x, b = bh / HM, h = bh % HM, tid = threadIdx.x;
    float* C = Cst + (size_t)bh * DVM * DKM; float* hb = hbuf + (size_t)bh * CHUNK * DVM;
    for (int i = tid; i < DVM * DKM; i += 512) C[i] = 0.f;
    if (tid < DKM) nvec[tid] = 0.f;
    if (tid == 0) m_s = 0.f;
    __syncthreads();
    for (int kc = 0; kc < NCHUNK; ++kc) {
        const int t0 = kc * CHUNK; const size_t rb = (size_t)b * SEQ;
        _Pragma("unroll 1") for (int i = tid; i < CHUNK * DKM * 2; i += 512) {
            const int isk = i >= CHUNK * DKM, e = isk ? i - CHUNK * DKM : i, l = e / DKM, d = e % DKM, c = (isk ? 512 : 0) + h * DKM + d, t = t0 + l;
            float a = conv_b[c];
            for (int j = 0; j < 4; ++j) { const int tt = t - 3 + j; if (tt >= 0) a = fmaf(conv_w[j * 1024 + c], bf2f(QKM[(rb + tt) * 1024 + c]), a); }
            a = silu_f(a);
            if (isk) ks[e] = a * 0.08838834764831845f; else qs[e] = a;
        }
        if (tid == 0) { float cs = 0.f;
            _Pragma("unroll 1") for (int l = 0; l < CHUNK; ++l) { const float* g = IFG + (rb + t0 + l) * 8; cs += log_sigmoid_f(g[4 + h] + b_f[h]); bcs[l] = cs; ii[l] = g[h] + b_i[h]; }
            float rm = -1e30f; const float mp = m_s;
            _Pragma("unroll 1") for (int l = 0; l < CHUNK; ++l) { rm = fmaxf(rm, ii[l] - bcs[l]); const float gl = bcs[l] + mp; const float m = fmaxf(bcs[l] + rm, gl); mt[l] = m; inter[l] = expf(gl - m); } }
        __syncthreads();
        _Pragma("unroll 1") for (int i = tid; i < CHUNK * CHUNK; i += 512) { const int l = i / CHUNK, s = i % CHUNK; float v = 0.f;
            if (s <= l) { float a = 0.f; _Pragma("unroll 4") for (int d = 0; d < DKM; ++d) a = fmaf(qs[l * DKM + d], ks[s * DKM + d], a); v = a * expf(bcs[l] - bcs[s] + ii[s] - mt[l]); }
            Ss[i] = v; }
        if (tid < CHUNK) { float a = 0.f; _Pragma("unroll 4") for (int d = 0; d < DKM; ++d) a = fmaf(qs[tid * DKM + d], nvec[d], a); qn[tid] = a; }
        __syncthreads();
        if (tid < CHUNK) { float a = 0.f; _Pragma("unroll 4") for (int s = 0; s < CHUNK; ++s) a += Ss[tid * CHUNK + s]; den[tid] = a + inter[tid] * qn[tid]; }
        __syncthreads();
        { const int v = tid % DVM, lh = tid / DVM;
            _Pragma("unroll 1") for (int lq = 0; lq < 2; ++lq) { float acc[16]; const int l0 = lh * 32 + lq * 16;
#pragma unroll
                for (int l = 0; l < 16; ++l) acc[l] = 0.f;
_Pragma("unroll 2")
                for (int d = 0; d < DKM; ++d) { const float c = C[v * DKM + d];
#pragma unroll
                    for (int l = 0; l < 16; ++l) acc[l] = fmaf(qs[(l0 + l) * DKM + d], c, acc[l]); }
#pragma unroll
                for (int l = 0; l < 16; ++l) acc[l] *= inter[l0 + l];
_Pragma("unroll 2")
                for (int s = 0; s < CHUNK; ++s) { const float vv = bf2f(VM[(rb + t0 + s) * 1024 + h * DVM + v]);
#pragma unroll
                    for (int l = 0; l < 16; ++l) acc[l] = fmaf(Ss[(l0 + l) * CHUNK + s], vv, acc[l]); }
#pragma unroll
                for (int l = 0; l < 16; ++l) { const int L = l0 + l; hb[L * DVM + v] = acc[l] / fmaxf(fabsf(den[L]), expf(-mt[L])); } } }
        __syncthreads();
        { const int wv = tid >> 6, ln = tid & 63;
            _Pragma("unroll 1") for (int l = wv; l < CHUNK; l += 8) { float x[4]; float s = 0.f;
                for (int j = 0; j < 4; ++j) { x[j] = hb[l * DVM + ln + 64 * j]; s += x[j]; }
                for (int o = 1; o < 64; o <<= 1) s += __shfl_xor(s, o);
                const float mu = s * (1.f / DVM); float q = 0.f;
                for (int j = 0; j < 4; ++j) { x[j] -= mu; q += x[j] * x[j]; }
                for (int o = 1; o < 64; o <<= 1) q += __shfl_xor(q, o);
                const float rstd = rsqrtf(q * (1.f / DVM) + LN_EPS);
                for (int j = 0; j < 4; ++j) { const int c = h * DVM + ln + 64 * j; const float y = x[j] * rstd * mhg[c] * bf2f(GM[(rb + t0 + l) * 1024 + c]);
                    Y[(rb + t0 + l) * 2048 + 1024 + c] = (bf16_t)f2bf(y); } } }
        if (tid == 0) { const float bL = bcs[CHUNK - 1], mp = m_s; float ma = -1e30f;
            _Pragma("unroll 1") for (int l = 0; l < CHUNK; ++l) ma = fmaxf(ma, bL - bcs[l] + ii[l]);
            const float mn = fmaxf(bL + mp, ma); decay_s = expf(bL + mp - mn);
            _Pragma("unroll 1") for (int l = 0; l < CHUNK; ++l) wgt[l] = expf(bL - bcs[l] + ii[l] - mn);
            m_s = mn; }
        __syncthreads();
        { const int v = tid % DVM, dh = tid / DVM; const float dc = decay_s;
            _Pragma("unroll 1") for (int dq = 0; dq < 4; ++dq) { float acc[16]; const int d0 = dh * 64 + dq * 16;
#pragma unroll
                for (int d = 0; d < 16; ++d) acc[d] = C[v * DKM + d0 + d] * dc;
_Pragma("unroll 2")
                for (int l = 0; l < CHUNK; ++l) { const float wvv = wgt[l] * bf2f(VM[(rb + t0 + l) * 1024 + h * DVM + v]);
#pragma unroll
                    for (int d = 0; d < 16; ++d) acc[d] = fmaf(wvv, ks[l * DKM + d0 + d], acc[d]); }
#pragma unroll
                for (int d = 0; d < 16; ++d) C[v * DKM + d0 + d] = acc[d]; } }
        if (tid < DKM) { float a = nvec[tid] * decay_s; _Pragma("unroll 4") for (int l = 0; l < CHUNK; ++l) a = fmaf(wgt[l], ks[l * DKM + tid], a); nvec[tid] = a; }
        __syncthreads();
    }
}

constexpr int NAIVE_MLSTM_LDS = (2 * CHUNK * DKM + CHUNK * CHUNK) * 4;
extern "C" void kernel_launch(void* const* d_in, const int* in_sizes, int n_in, void* d_out, int out_size, void* d_ws, size_t ws_size, hipStream_t stream) {
    static int grid = 0;
    if (grid == 0) {
        if (n_in != 16 || in_sizes[0] != M * DM || out_size != M * DM || ws_size < WS_END) { fprintf(stderr, "kernel_launch: unexpected shapes (n_in %d, in0 %d, out %d, ws %zu)\n", n_in, n_in > 0 ? in_sizes[0] : -1, out_size, ws_size); grid = -1; return; }
        int dev = 0, cus = 0, per_cu = 0;
        if (hipGetDevice(&dev) != hipSuccess || hipDeviceGetAttribute(&cus, hipDeviceAttributeMultiprocessorCount, dev) != hipSuccess) { grid = -1; return; }
        if (hipFuncSetAttribute((const void*)skel_fwd, hipFuncAttributeMaxDynamicSharedMemorySize, LDS_BYTES) != hipSuccess) { fprintf(stderr, "kernel_launch: hipFuncSetAttribute failed\n"); grid = -1; return; }
        if (hipOccupancyMaxActiveBlocksPerMultiprocessor(&per_cu, (const void*)skel_fwd, NTHREADS, LDS_BYTES) != hipSuccess || per_cu < 1) fprintf(stderr, "kernel_launch: occupancy query says %d\n", per_cu);
        (void)hipFuncSetAttribute((const void*)naive_mlstm, hipFuncAttributeMaxDynamicSharedMemorySize, NAIVE_MLSTM_LDS);
        (void)hipGetLastError();
        grid = cus;
    }
    if (grid < 0) return;
    Args a{};
    for (int i = 0; i < 16; ++i) a.in[i] = (const float*)d_in[i];
    a.out = (float*)d_out; a.ws = (unsigned char*)d_ws;
    unsigned char* ws = (unsigned char*)d_ws;
    if (hipMemsetAsync((char*)d_ws + WS_CTL, 0, CTL_ZERO_BYTES, stream) != hipSuccess) { fprintf(stderr, "kernel_launch: memset failed\n"); return; }
    int li = 0;
    auto launch = [&](int lo, int hi) { a.ph_lo = lo; a.ph_hi = hi; a.li = li++; hipLaunchKernelGGL(skel_fwd, dim3(grid), dim3(NTHREADS), LDS_BYTES, stream, a); };
    launch(0, 6);
}
```
